# Optimizing an MI355X kernel written in HIP

```python
import jax, jax.numpy as jnp
from jax import lax
import numpy as np

D_MODEL = 1024
BATCH = 16
SEQ = 4096
DEPTH = 2
DEC_BATCH = 8
DEC_SEQ = 64
PAST_LEN = 4096

CHUNK = 64
D_MIX = D_MODEL
POOL_WIDTH = D_MIX // 2
POOL_GROUPS = 4
POOL_GROUP_DIM = POOL_WIDTH // POOL_GROUPS
POOL_WINDOWS = (2, 4, 8, 16)
POOL_KEEP = max(POOL_WINDOWS) - 1
SGU_WIDTH = D_MIX - POOL_WIDTH
SGU_HEADS = 4
SGU_HEAD_DIM = SGU_WIDTH // SGU_HEADS
SGU_CHUNK = 128
D_IN = POOL_WIDTH + 2 * SGU_WIDTH
D_FF = 4 * D_MODEL
N_MOD = 6
EPS = 1e-6

kernel_name = "hybrid_pool_sgu_streaming_step"


def rms_norm(x, g):
    xf = x.astype(jnp.float32)
    y = xf * lax.rsqrt(jnp.mean(xf * xf, axis=-1, keepdims=True) + EPS)
    return (y * g.astype(jnp.float32)).astype(x.dtype)


def layer_norm(x, g, b):
    xf = x.astype(jnp.float32)
    mu = jnp.mean(xf, axis=-1, keepdims=True)
    var = jnp.mean(jnp.square(xf - mu), axis=-1, keepdims=True)
    y = (xf - mu) * lax.rsqrt(var + EPS)
    return (y * g.astype(jnp.float32) + b.astype(jnp.float32)).astype(x.dtype)


def pool_mixer(a, prev, pos0, w_pool, scale):
    B, L, _ = a.shape
    xp = jnp.concatenate([prev.astype(a.dtype), a], axis=1)
    xf = xp.astype(jnp.float32)
    csum = jnp.concatenate([jnp.zeros((B, 1, POOL_WIDTH), jnp.float32),
                            jnp.cumsum(xf, axis=1)], axis=1)
    pos = pos0 + jnp.arange(L, dtype=jnp.int32)
    means = []
    for g, w in enumerate(POOL_WINDOWS):
        sl = slice(g * POOL_GROUP_DIM, (g + 1) * POOL_GROUP_DIM)
        hi = csum[:, POOL_KEEP + 1:, sl]
        lo = csum[:, POOL_KEEP + 1 - w:POOL_KEEP + 1 - w + L, sl]
        cnt = jnp.minimum(pos + 1, w).astype(jnp.float32)
        means.append((hi - lo) / cnt[None, :, None])
    pooled = jnp.concatenate(means, axis=-1)
    d = (pooled - a.astype(jnp.float32)).astype(a.dtype)
    d = d.reshape(B, L, POOL_GROUPS, POOL_GROUP_DIM)
    out = jnp.einsum('blgc,gcd->blgd', d, w_pool).reshape(B, L, POOL_WIDTH) * scale
    new_prev = xp[:, -POOL_KEEP:]
    return out, new_prev


def spatial_gating(u, v, w_s, b_s):
    B, L, _ = v.shape
    T = min(L, SGU_CHUNK)
    n = L // T
    mask = jnp.tril(jnp.ones((T, T), dtype=bool))
    w = jnp.where(mask[None], w_s[:, :T, :T], jnp.zeros((), w_s.dtype))
    vh = v.reshape(B, n, T, SGU_HEADS, SGU_HEAD_DIM)
    mixed = jnp.einsum('hts,bnshc->bnthc', w, vh) + b_s[:, :T].T[None, None, :, :, None]
    return u * mixed.reshape(B, L, SGU_WIDTH)


def trunk_layer(x, c, prev_pool, pos0, w_ada, b_ada, norm_mix_g, w_in, w_pool, pool_scale,
                v_norm_g, v_norm_b, w_spatial, b_spatial, w_out, norm_ffn_g, w_ff1, w_ff2):
    mod = jax.nn.silu(c) @ w_ada + b_ada
    sh1, sc1, g1, sh2, sc2, g2 = jnp.split(mod, N_MOD, axis=-1)
    h = rms_norm(x, norm_mix_g) * (1.0 + sc1[:, None]) + sh1[:, None]
    z = h @ w_in
    a = z[..., :POOL_WIDTH]
    u = jax.nn.gelu(z[..., POOL_WIDTH:POOL_WIDTH + SGU_WIDTH], approximate=False)
    v = layer_norm(jax.nn.gelu(z[..., POOL_WIDTH + SGU_WIDTH:], approximate=False), v_norm_g, v_norm_b)
    ya, new_prev = pool_mixer(a, prev_pool, pos0, w_pool, pool_scale)
    yb = spatial_gating(u, v, w_spatial, b_spatial)
    x = x + g1[:, None] * (jnp.concatenate([ya, yb], axis=-1) @ w_out)
    h2 = rms_norm(x, norm_ffn_g) * (1.0 + sc2[:, None]) + sh2[:, None]
    f = jnp.square(jax.nn.relu(h2 @ w_ff1)) @ w_ff2
    x = x + g2[:, None] * f
    return x, new_prev, v


def setup_inputs(seed: int = 0) -> dict:
    key = jax.random.key(seed)
    ks = jax.random.split(key, 20)
    f32 = jnp.float32
    nrm = lambda k, shape: jax.random.normal(k, shape, f32)
    return {
        "x_prompt": nrm(ks[0], (BATCH, SEQ, D_MODEL)),
        "x_sample": nrm(ks[1], (DEC_BATCH, DEC_SEQ, D_MODEL)),
        "state_pool": nrm(ks[2], (DEPTH, DEC_BATCH, POOL_KEEP, POOL_WIDTH)),
        "c_prompt": nrm(ks[3], (BATCH, D_MODEL)),
        "c_sample": nrm(ks[4], (DEC_BATCH, D_MODEL)),
        "w_ada": nrm(ks[5], (DEPTH, D_MODEL, N_MOD * D_MODEL)) * (0.5 * D_MODEL ** -0.5),
        "b_ada": nrm(ks[6], (DEPTH, N_MOD * D_MODEL)) * 0.02,
        "norm_mix_g": 1.0 + 0.05 * nrm(ks[7], (DEPTH, D_MODEL)),
        "w_in": nrm(ks[8], (DEPTH, D_MODEL, D_IN)) * D_MODEL ** -0.5,
        "w_pool": nrm(ks[9], (DEPTH, POOL_GROUPS, POOL_GROUP_DIM, POOL_GROUP_DIM)) * POOL_GROUP_DIM ** -0.5,
        "pool_scale": 1.0 + 0.1 * nrm(ks[10], (DEPTH, POOL_WIDTH)),
        "v_norm_g": 1.0 + 0.05 * nrm(ks[11], (DEPTH, SGU_WIDTH)),
        "v_norm_b": 0.02 * nrm(ks[12], (DEPTH, SGU_WIDTH)),
        "w_spatial": nrm(ks[13], (DEPTH, SGU_HEADS, SGU_CHUNK, SGU_CHUNK)) * SGU_CHUNK ** -0.5,
        "b_spatial": 1.0 + 0.1 * nrm(ks[14], (DEPTH, SGU_HEADS, SGU_CHUNK)),
        "w_out": nrm(ks[15], (DEPTH, D_MIX, D_MODEL)) * D_MIX ** -0.5,
        "norm_ffn_g": 1.0 + 0.05 * nrm(ks[16], (DEPTH, D_MODEL)),
        "w_ff1": nrm(ks[17], (DEPTH, D_MODEL, D_FF)) * D_MODEL ** -0.5,
        "w_ff2": nrm(ks[18], (DEPTH, D_FF, D_MODEL)) * D_FF ** -0.5,
        "final_norm_g": 1.0 + 0.05 * nrm(ks[19], (D_MODEL,)),
    }


def reference(x_prompt, x_sample, state_pool, c_prompt, c_sample, w_ada, b_ada, norm_mix_g, w_in,
              w_pool, pool_scale, v_norm_g, v_norm_b, w_spatial, b_spatial, w_out, norm_ffn_g,
              w_ff1, w_ff2, final_norm_g):
    xp, xs = x_prompt, x_sample
    pool_p, pool_s, v_s = [], [], []
    for l in range(DEPTH):
        lw = (w_ada[l], b_ada[l], norm_mix_g[l], w_in[l], w_pool[l], pool_scale[l], v_norm_g[l],
              v_norm_b[l], w_spatial[l], b_spatial[l], w_out[l], norm_ffn_g[l], w_ff1[l], w_ff2[l])
        prev0 = jnp.zeros((xp.shape[0], POOL_KEEP, POOL_WIDTH), xp.dtype)
        xp, np_p, _ = trunk_layer(xp, c_prompt, prev0, 0, *lw)
        xs, np_s, vs = trunk_layer(xs, c_sample, state_pool[l], PAST_LEN, *lw)
        pool_p.append(np_p)
        pool_s.append(np_s)
        v_s.append(vs)
    y_prompt = rms_norm(xp, final_norm_g)
    y_sample = rms_norm(xs, final_norm_g)
    state_pool_prompt = jnp.stack(pool_p, axis=0)
    state_pool_sample = jnp.stack(pool_s, axis=0)
    state_sgu_v_sample = jnp.stack(v_s, axis=0)
    return (y_prompt, y_sample, state_pool_prompt, state_pool_sample, state_sgu_v_sample)
```

```cpp
#include <hip/hip_runtime.h>
#include <hip/hip_cooperative_groups.h>
#include <cstdio>
namespace cg = cooperative_groups;

#ifndef MK_SINGLE
#define MK_SINGLE 1
#endif

#define LAS __attribute__((address_space(3)))
typedef unsigned short bf16_t;
typedef short bf16x8 __attribute__((ext_vector_type(8)));
typedef short s16x4 __attribute__((ext_vector_type(4)));
typedef float f32x4 __attribute__((ext_vector_type(4)));
typedef float f32x2 __attribute__((ext_vector_type(2)));
typedef unsigned u32x4 __attribute__((ext_vector_type(4)));
typedef unsigned u32x2 __attribute__((ext_vector_type(2)));

constexpr int D = 1024, NBP = 16, SEQ = 4096, MP = NBP * SEQ, NBS = 8, DSEQ = 64, MS = NBS * DSEQ, MT = MP + MS;
constexpr int DIN = 1536, DFF = 4096, DEPTH = 2, NBT = NBP + NBS, PW = 512, SW = 512, NMOD = 6 * D;
constexpr float EPS = 1e-6f;
constexpr int NTHREADS = 512;
constexpr int LDX = D + 64, LDF = DFF + 64;

constexpr size_t WS_WIN_T = 0;
constexpr size_t WS_WOUT_T = WS_WIN_T + (size_t)DEPTH * DIN * LDX * 2;
constexpr size_t WS_W1_T = WS_WOUT_T + (size_t)DEPTH * D * LDX * 2;
constexpr size_t WS_W2_T = WS_W1_T + (size_t)DEPTH * DFF * LDX * 2;
constexpr size_t WS_WP_T = WS_W2_T + (size_t)DEPTH * D * LDF * 2;
constexpr size_t WS_WSP = WS_WP_T + (size_t)DEPTH * 4 * 128 * 128 * 2;
constexpr size_t WS_MOD = WS_WSP + (size_t)DEPTH * 4 * 128 * 128 * 2;
constexpr size_t WS_SHWIN = WS_MOD + (size_t)DEPTH * NBT * NMOD * 4;
constexpr size_t WS_SHW1 = WS_SHWIN + (size_t)DEPTH * NBT * DIN * 4;
constexpr size_t WS_SSQ1 = WS_SHW1 + (size_t)DEPTH * NBT * DFF * 4;
constexpr size_t WS_SSQ2 = WS_SSQ1 + (size_t)MT * 16 * 4;
constexpr size_t WS_STV = WS_SSQ2 + (size_t)MT * 16 * 4;
constexpr size_t WS_XG = WS_STV + (size_t)MT * 16 * 4;
constexpr size_t WS_F1 = WS_XG + (size_t)MT * LDX * 2;
constexpr size_t WS_A = WS_F1;
constexpr size_t WS_U = WS_A + (size_t)MT * PW * 2;
constexpr size_t WS_GV = WS_U + (size_t)MT * SW * 2;
constexpr size_t WS_CAT = WS_GV + (size_t)MT * SW * 2;
constexpr size_t WS_END = WS_F1 + (size_t)MT * LDF * 2;

constexpr size_t OUT_Y = 0;
constexpr size_t OUT_SPP = (size_t)MT * D;
constexpr size_t OUT_SPS = OUT_SPP + (size_t)DEPTH * NBP * 15 * PW;
constexpr size_t OUT_SV = OUT_SPS + (size_t)DEPTH * NBS * 15 * PW;

struct Params {
    const float* in[20];
    float* out;
    unsigned char* ws;
    int ph_lo, ph_hi;
};
enum { I_XP = 0, I_XS, I_SPOOL, I_CP, I_CS, I_WADA, I_BADA, I_GMIX, I_WIN, I_WPOOL, I_PSCALE, I_VG, I_VB, I_WSP, I_BSP, I_WOUT, I_GFFN, I_W1, I_W2, I_GFIN };

__device__ __forceinline__ unsigned cvt_pk_bf16(float lo, float hi) { unsigned r; asm volatile("v_cvt_pk_bf16_f32 %0, %1, %2" : "=v"(r) : "v"(lo), "v"(hi)); return r; }
__device__ __forceinline__ float bflo(unsigned w) { return __uint_as_float(w << 16); }
__device__ __forceinline__ float bfhi(unsigned w) { return __uint_as_float(w & 0xffff0000u); }
__device__ __forceinline__ int batch_of(int row) { return row < MP ? (row >> 12) : NBP + ((row - MP) >> 6); }
__device__ __forceinline__ f32x2 gelu_pk(f32x2 v) {
    const f32x2 av = __builtin_elementwise_abs(v), d = av * 0.2316418882f + 1.0f;
    f32x2 t; t.x = __builtin_amdgcn_rcpf(d.x); t.y = __builtin_amdgcn_rcpf(d.y);
    f32x2 q = t * 0.5307027145f + (-0.7265760135f); q = q * t + 0.7107068705f; q = q * t + (-0.142248368f); q = q * t + 0.127414796f; q = q * t;
    const f32x2 s = (v * v) * (-0.72134752044f);
    f32x2 e; e.x = __builtin_amdgcn_exp2f(s.x); e.y = __builtin_amdgcn_exp2f(s.y);
    const f32x2 m = v * (q * e), r = v - m;
    f32x2 o; o.x = v.x < 0.f ? m.x : r.x; o.y = v.y < 0.f ? m.y : r.y; return o;
}
__device__ __forceinline__ f32x4 gelu4(f32x4 v) { f32x2 a = gelu_pk((f32x2){v[0], v[1]}), b = gelu_pk((f32x2){v[2], v[3]}); return (f32x4){a.x, a.y, b.x, b.y}; }
__device__ __forceinline__ float wave_sum(float v) {
#pragma unroll
    for (int o = 32; o >= 1; o >>= 1) v += __shfl_xor(v, o);
    return v;
}
__device__ __forceinline__ float quad_row_sum(float v) { v += __shfl_xor(v, 16); v += __shfl_xor(v, 32); return v; }

namespace pg8 {
constexpr int BM = 256, BK = 64, HALF = 128, HTB = HALF * BK * 2, STAGE_BYTES = 8 * HTB, NXCD = 8, WGM = 8;
__device__ __forceinline__ int lds_byte(int r, int c) { const int st = (r >> 4) * 2 + (c >> 5), rr = r & 15, cc = c & 31, ob = rr * 64 + cc * 2; return st * 1024 + (ob ^ (((ob >> 9) & 1) << 5)); }
__device__ __forceinline__ void stage_rc(int b, int& R, int& C) { const int st = b / 1024, sb = b % 1024, swz = sb ^ (((sb >> 9) & 1) << 5); R = (st >> 1) * 16 + swz / 64; C = (st & 1) * 32 + (swz % 64) / 2; }
struct Unit { int pm, pn; };
struct Gemm { const bf16_t* A; const bf16_t* Bt; int M, N, K, lda, ldb; };
struct StaticOrder {
    int nM, nN, nwg, G, c;
    __device__ void init(int M, int N, int G_, int c_) { nM = M / BM; nN = N / BM; nwg = nM * nN; G = G_; c = c_; }
    __device__ bool next(int i, Unit& u) const {
        const long L = (long)i * G + c; if (L >= nwg) return false;
        int wgid = (int)L; { const int q = nwg / NXCD, r = nwg % NXCD, xcd = wgid % NXCD, off = wgid / NXCD; wgid = (xcd < r ? xcd * (q + 1) : r * (q + 1) + (xcd - r) * q) + off; }
        const int nig = WGM * nN, gid = wgid / nig, fm = gid * WGM, gsz = (nM - fm) < WGM ? (nM - fm) : WGM;
        u.pm = fm + ((wgid % nig) % gsz); u.pn = (wgid % nig) / gsz; return true;
    }
};

template <class Epi>
__device__ __forceinline__ void gemm_phase(LAS unsigned char* lds, const Gemm g, const StaticOrder& S, const Epi& E) {
    int tid_ = threadIdx.x; asm volatile("" : "+v"(tid_));
    const int tid = tid_, wid = __builtin_amdgcn_readfirstlane(tid >> 6), lane = tid & 63, wr = wid >> 2, wc = wid & 3, fr = lane & 15, fq = lane >> 4;
    const int K = g.K, nt = K / BK;
    unsigned voffA[2], voffB[2];
#pragma unroll
    for (int i = 0; i < 2; ++i) { int R, C; stage_rc(tid * 16 + i * 8192, R, C); voffA[i] = (unsigned)(R * g.lda + C) * 2u; voffB[i] = (unsigned)(R * g.ldb + C) * 2u; }
    const size_t kstep = (size_t)(BK * 2);
    const size_t hstepA = (size_t)HALF * g.lda * 2, hstepB = (size_t)HALF * g.ldb * 2;
    const size_t tstepA = 2 * hstepA, tstepB = 2 * hstepB;
    const unsigned ldsw = (unsigned)wid * 1024u;
    const int aoff = lds_byte(wr * 64 + fr, fq * 8), boff = lds_byte(wc * 32 + fr, fq * 8);
#define PG8_SA(b, h) (((b) * 2 + (h)) * HTB)
#define PG8_SB(b, h) ((4 + (b) * 2 + (h)) * HTB)
#define PG8_STAGE(bufoff, gbase, voff) do { _Pragma("unroll") for (int _i = 0; _i < 2; ++_i) \
        __builtin_amdgcn_global_load_lds((const unsigned*)((const char*)(gbase) + (voff)[_i]), (LAS unsigned*)(lds + (bufoff) + ldsw + _i * 8192), 16, 0, 0); } while (0)
#define PG8_LDA(dst, b, h) do { _Pragma("unroll") for (int m = 0; m < 4; ++m) _Pragma("unroll") for (int k = 0; k < 2; ++k) dst[m][k] = *(const LAS bf16x8*)(lds + PG8_SA(b, h) + aoff + m * 2048 + k * 1024); } while (0)
#define PG8_LDB(dst, b, h) do { _Pragma("unroll") for (int n = 0; n < 2; ++n) _Pragma("unroll") for (int k = 0; k < 2; ++k) dst[n][k] = *(const LAS bf16x8*)(lds + PG8_SB(b, h) + boff + n * 2048 + k * 1024); } while (0)
#define PG8_MMA(ai, bj, At, Bt) do { __builtin_amdgcn_s_setprio(1); _Pragma("unroll") for (int m = 0; m < 4; ++m) _Pragma("unroll") for (int n = 0; n < 2; ++n) _Pragma("unroll") for (int k = 0; k < 2; ++k) \
        acc[ai][bj][m][n] = __builtin_amdgcn_mfma_f32_16x16x32_bf16(Bt[n][k], At[m][k], acc[ai][bj][m][n], 0, 0, 0); __builtin_amdgcn_s_setprio(0); } while (0)
#define PG8_WAIT_V(n) asm volatile("s_waitcnt vmcnt(" #n ")" ::: "memory")
#define PG8_WAIT_L(n) asm volatile("s_waitcnt lgkmcnt(" #n ")" ::: "memory")
#define PG8_BAR __builtin_amdgcn_s_barrier()
#define PG8_SCHED __builtin_amdgcn_sched_barrier(0)
    Unit cur, nxt; int ui = 0;
    if (!S.next(0, cur)) return;
    f32x4 acc[2][2][4][2];
#pragma unroll
    for (int a = 0; a < 2; ++a)
#pragma unroll
        for (int b = 0; b < 2; ++b)
#pragma unroll
            for (int m = 0; m < 4; ++m)
#pragma unroll
                for (int n = 0; n < 2; ++n) acc[a][b][m][n] = (f32x4){0.f, 0.f, 0.f, 0.f};
    bf16x8 At[4][2], B0[2][2], B1[2][2];
    const char* cA = (const char*)g.A + (size_t)cur.pm * tstepA; const char* cB = (const char*)g.Bt + (size_t)cur.pn * tstepB;
    PG8_STAGE(PG8_SB(0, 0), cB, voffB); PG8_STAGE(PG8_SA(0, 0), cA, voffA); PG8_STAGE(PG8_SB(0, 1), cB + hstepB, voffB); PG8_STAGE(PG8_SA(0, 1), cA + hstepA, voffA);
    if (wr == 1) PG8_BAR;
    PG8_WAIT_V(4); PG8_BAR;
    PG8_STAGE(PG8_SB(1, 0), cB + kstep, voffB); PG8_STAGE(PG8_SA(1, 0), cA + kstep, voffA); PG8_STAGE(PG8_SB(1, 1), cB + hstepB + kstep, voffB);
    PG8_WAIT_V(6); PG8_BAR;
    for (;;) {
        const bool has_next = S.next(ui + 1, nxt);
        const char* nA = has_next ? (const char*)g.A + (size_t)nxt.pm * tstepA : cA; const char* nB = has_next ? (const char*)g.Bt + (size_t)nxt.pn * tstepB : cB;
        for (int t = 0; t < nt; t += 2) {
            const bool last = (t == nt - 2);
            const char* a1 = cA + (size_t)(t + 1) * kstep;
            const char* a2 = last ? nA : cA + (size_t)(t + 2) * kstep; const char* b2 = last ? nB : cB + (size_t)(t + 2) * kstep;
            const char* a3 = a2 + kstep; const char* b3 = b2 + kstep;
            PG8_LDB(B0, 0, 0); PG8_SCHED; PG8_LDA(At, 0, 0); PG8_STAGE(PG8_SA(1, 1), a1 + hstepA, voffA);
            PG8_WAIT_L(8); PG8_BAR; PG8_WAIT_L(0); PG8_MMA(0, 0, At, B0); PG8_BAR; PG8_SCHED;
            PG8_LDB(B1, 0, 1); PG8_STAGE(PG8_SB(0, 0), b2, voffB);
            PG8_BAR; PG8_WAIT_L(0); PG8_MMA(0, 1, At, B1); PG8_BAR;
            PG8_LDA(At, 0, 1); PG8_STAGE(PG8_SA(0, 0), a2, voffA);
            PG8_BAR; PG8_WAIT_L(0); PG8_MMA(1, 0, At, B0); PG8_BAR; PG8_SCHED;
            PG8_STAGE(PG8_SB(0, 1), b2 + hstepB, voffB);
            PG8_WAIT_V(6); PG8_BAR; PG8_MMA(1, 1, At, B1); PG8_BAR;
            PG8_LDB(B0, 1, 0); PG8_SCHED; PG8_LDA(At, 1, 0); PG8_STAGE(PG8_SA(0, 1), a2 + hstepA, voffA);
            PG8_WAIT_L(8); PG8_BAR; PG8_WAIT_L(0); PG8_MMA(0, 0, At, B0); PG8_BAR; PG8_SCHED;
            PG8_LDB(B1, 1, 1); PG8_STAGE(PG8_SB(1, 0), b3, voffB);
            PG8_BAR; PG8_WAIT_L(0); PG8_MMA(0, 1, At, B1); PG8_BAR;
            PG8_LDA(At, 1, 1); PG8_STAGE(PG8_SA(1, 0), a3, voffA);
            PG8_BAR; PG8_WAIT_L(0); PG8_MMA(1, 0, At, B0); PG8_BAR; PG8_SCHED;
            PG8_STAGE(PG8_SB(1, 1), b3 + hstepB, voffB);
            PG8_WAIT_V(6); PG8_BAR; PG8_MMA(1, 1, At, B1); PG8_BAR;
        }
        E(acc, cur, wr, wc, fr, fq);
        if (!has_next) break;
#pragma unroll
        for (int a = 0; a < 2; ++a)
#pragma unroll
            for (int b = 0; b < 2; ++b)
#pragma unroll
                for (int m = 0; m < 4; ++m)
#pragma unroll
                    for (int n = 0; n < 2; ++n) acc[a][b][m][n] = (f32x4){0.f, 0.f, 0.f, 0.f};
        cur = nxt; cA = nA; cB = nB; ++ui;
    }
    PG8_WAIT_V(0);
    if (wr == 0) PG8_BAR;
    PG8_BAR;
#undef PG8_SA
#undef PG8_SB
#undef PG8_STAGE
#undef PG8_LDA
#undef PG8_LDB
#undef PG8_MMA
#undef PG8_WAIT_V
#undef PG8_WAIT_L
#undef PG8_BAR
#undef PG8_SCHED
}
}

typedef f32x4 AccT[2][2][4][2];

__device__ __forceinline__ f32x4 ldg4(const void* base, unsigned off) { return *(const f32x4*)((const char*)base + off); }
__device__ __forceinline__ void stg4(void* base, unsigned off, f32x4 v) { *(f32x4*)((char*)base + off) = v; }
__device__ __forceinline__ void stg2(void* base, unsigned off, u32x2 v) { *(u32x2*)((char*)base + off) = v; }
__device__ __forceinline__ void stf2(void* base, unsigned off, f32x2 v) { *(f32x2*)((char*)base + off) = v; }
__device__ __forceinline__ void stf1(void* base, unsigned off, float v) { *(float*)((char*)base + off) = v; }
__device__ __forceinline__ u32x2 pack4(f32x4 z) { u32x2 w; w.x = cvt_pk_bf16(z[0], z[1]); w.y = cvt_pk_bf16(z[2], z[3]); return w; }
constexpr unsigned CO[2][2] = {{0u, 16u}, {128u, 144u}};

struct EpiIn {
    const float* ssq1; const float* shw; bf16_t* A; bf16_t* U; bf16_t* GV; float* stv;
    __device__ __forceinline__ void operator()(const AccT& acc, const pg8::Unit& u, int wr, int wc, int fr, int fq) const {
        const int rowu = u.pm * 256 + wr * 64;
        const unsigned colb = (unsigned)(u.pn * 256 + wc * 32 + 4 * fq), rowb = (unsigned)(rowu + fr);
        bf16_t* const dbase = u.pn < 2 ? A : (u.pn < 4 ? U - 512 : GV - 1024);
#pragma unroll
        for (int ai = 0; ai < 2; ++ai) {
            const float* bias = shw + (size_t)batch_of(rowu + ai * 128) * DIN;
            f32x4 pp[4], bv[2][2];
#pragma unroll
            for (int m = 0; m < 4; ++m) pp[m] = ldg4(ssq1, ((rowb + ai * 128 + m * 16) * 16 + fq * 4) * 4);
#pragma unroll
            for (int bj = 0; bj < 2; ++bj)
#pragma unroll
                for (int n = 0; n < 2; ++n) bv[bj][n] = ldg4(bias, (colb + CO[bj][n]) * 4);
            float rstd[4], s1[4], s2[4];
#pragma unroll
            for (int m = 0; m < 4; ++m) { const f32x4 p = pp[m]; rstd[m] = rsqrtf(quad_row_sum((p[0] + p[1]) + (p[2] + p[3])) * (1.0f / D) + EPS); }
#pragma unroll
            for (int m = 0; m < 4; ++m) {
                const unsigned row = rowb + ai * 128 + m * 16;
                float t1 = 0.f, t2 = 0.f;
#pragma unroll
                for (int bj = 0; bj < 2; ++bj)
#pragma unroll
                    for (int n = 0; n < 2; ++n) {
                        f32x4 z = acc[ai][bj][m][n] * rstd[m] + bv[bj][n];
                        if (u.pn >= 2) z = gelu4(z);
                        if (u.pn >= 4) { t1 += (z[0] + z[1]) + (z[2] + z[3]); t2 += (z[0] * z[0] + z[1] * z[1]) + (z[2] * z[2] + z[3] * z[3]); }
                        stg2(dbase, (row * 512 + colb + CO[bj][n]) * 2, pack4(z));
                    }
                s1[m] = t1; s2[m] = t2;
            }
            if (u.pn >= 4) {
#pragma unroll
                for (int m = 0; m < 4; ++m) {
                    const float a = quad_row_sum(s1[m]), b = quad_row_sum(s2[m]);
                    if (fq == 0) stf2(stv, ((rowb + ai * 128 + m * 16) * 16 + ((u.pn - 4) * 4 + wc) * 2) * 4, (f32x2){a, b});
                }
            }
        }
    }
};
struct EpiRes {
    const float* xp; const float* xs; const float* xres_in;
    float* xres; const float* gate;
    const float* gnext; const float* scnext;
    bf16_t* XG; float* ssq;
    __device__ __forceinline__ void operator()(const AccT& acc, const pg8::Unit& u, int wr, int wc, int fr, int fq) const {
        const int rowu = u.pm * 256 + wr * 64;
        const unsigned colb = (unsigned)(u.pn * 256 + wc * 32 + 4 * fq), rowb = (unsigned)(rowu + fr);
        const float* const xin = xres_in ? xres_in : (u.pm >= MP / 256 ? xs - (size_t)MP * D : xp);
        float ssr[8];
        f32x4 gt[2][2], gm[2][2];
        f32x4 ring[3][2][2];
        int bcur = -1;
#define ER_LOADROW(r_, slot_) do { const unsigned ro_ = (rowb + ((r_) >> 2) * 128 + ((r_) & 3) * 16) * D + colb; \
            _Pragma("unroll") for (int bj = 0; bj < 2; ++bj) _Pragma("unroll") for (int n = 0; n < 2; ++n) ring[slot_][bj][n] = ldg4(xin, (ro_ + CO[bj][n]) * 4); } while (0)
#pragma unroll
        for (int r = 0; r < 8; ++r) {
            const int ai = r >> 2, m = r & 3; const unsigned row = rowb + ai * 128 + m * 16;
            if (r == 0 || r == 4) {
                const int b = batch_of(rowu + ai * 128);
                if (b != bcur) {
                    bcur = b;
#pragma unroll
                    for (int bj = 0; bj < 2; ++bj)
#pragma unroll
                        for (int n = 0; n < 2; ++n) {
                            const unsigned co = (colb + CO[bj][n]) * 4;
                            gt[bj][n] = ldg4(gate + (size_t)b * NMOD, co);
                            if (gnext) gm[bj][n] = ldg4(gnext, co) * (ldg4(scnext + (size_t)b * NMOD, co) + 1.0f);
                            else gm[bj][n] = (f32x4){0.f, 0.f, 0.f, 0.f};
                        }
                }
            }
            if (r == 0) { ER_LOADROW(0, 0); ER_LOADROW(1, 1); }
            if (r + 2 < 8) ER_LOADROW(r + 2, (r + 2) % 3);
            float ss = 0.f;
#pragma unroll
            for (int bj = 0; bj < 2; ++bj)
#pragma unroll
                for (int n = 0; n < 2; ++n) {
                    const unsigned eo = row * D + colb + CO[bj][n];
                    const f32x4 x1 = ring[r % 3][bj][n] + gt[bj][n] * acc[ai][bj][m][n];
                    stg4(xres, eo * 4, x1);
                    ss += (x1[0] * x1[0] + x1[1] * x1[1]) + (x1[2] * x1[2] + x1[3] * x1[3]);
                    if (gnext) stg2(XG, (row * LDX + colb + CO[bj][n]) * 2, pack4(x1 * gm[bj][n]));
                }
            ssr[r] = ss;
        }
#undef ER_LOADROW
#pragma unroll
        for (int r = 0; r < 8; ++r) { const float t = quad_row_sum(ssr[r]); if (fq == 0) stf1(ssq, ((rowb + (r >> 2) * 128 + (r & 3) * 16) * 16 + u.pn * 4 + wc) * 4, t); }
    }
};
struct EpiFf1 {
    const float* ssq2; const float* shw; bf16_t* F1;
    __device__ __forceinline__ void operator()(const AccT& acc, const pg8::Unit& u, int wr, int wc, int fr, int fq) const {
        const int rowu = u.pm * 256 + wr * 64;
        const unsigned colb = (unsigned)(u.pn * 256 + wc * 32 + 4 * fq), rowb = (unsigned)(rowu + fr);
#pragma unroll
        for (int ai = 0; ai < 2; ++ai) {
            const float* bias = shw + (size_t)batch_of(rowu + ai * 128) * DFF;
            f32x4 pp[4], bv[2][2];
#pragma unroll
            for (int m = 0; m < 4; ++m) pp[m] = ldg4(ssq2, ((rowb + ai * 128 + m * 16) * 16 + fq * 4) * 4);
#pragma unroll
            for (int bj = 0; bj < 2; ++bj)
#pragma unroll
                for (int n = 0; n < 2; ++n) bv[bj][n] = ldg4(bias, (colb + CO[bj][n]) * 4);
            float rstd[4];
#pragma unroll
            for (int m = 0; m < 4; ++m) { const f32x4 p = pp[m]; rstd[m] = rsqrtf(quad_row_sum((p[0] + p[1]) + (p[2] + p[3])) * (1.0f / D) + EPS); }
#pragma unroll
            for (int m = 0; m < 4; ++m) {
                const unsigned row = rowb + ai * 128 + m * 16;
#pragma unroll
                for (int bj = 0; bj < 2; ++bj)
#pragma unroll
                    for (int n = 0; n < 2; ++n) {
                        f32x4 z = acc[ai][bj][m][n] * rstd[m] + bv[bj][n];
                        z = __builtin_elementwise_max(z, (f32x4){0.f, 0.f, 0.f, 0.f}); z = z * z;
                        stg2(F1, (row * LDF + colb + CO[bj][n]) * 2, pack4(z));
                    }
            }
        }
    }
};

typedef const __attribute__((address_space(4))) Params* KArgs;
__device__ __forceinline__ KArgs kargs() { KArgs k = (KArgs)__builtin_amdgcn_kernarg_segment_ptr(); asm volatile("" : "+s"(k)); return k; }
struct Ctx {
    KArgs k;
    LAS unsigned char* lds; int tid, lane, wid, G, bx;
};

__device__ __forceinline__ void gemv24_unit(const Ctx& c, int mode, const float* vsrc, int vstride, const float* W, int ldw, int n0, const float* bias, float* out, int ldo) {
    LAS float* tbl = (LAS float*)c.lds;
    __syncthreads();
    for (int i = c.tid; i < NBT * D; i += NTHREADS) {
        const int b = i >> 10, k = i & 1023; float v;
        if (mode == 0) { const float x = b < NBP ? c.k->in[I_CP][b * D + k] : c.k->in[I_CS][(b - NBP) * D + k]; v = x / (1.0f + __expf(-x)); }
        else v = vsrc[(size_t)b * vstride + k];
        tbl[k * NBT + b] = v;
    }
    __syncthreads();
    const int ks = c.tid >> 6, j = c.tid & 63;
    float acc[NBT];
#pragma unroll
    for (int b = 0; b < NBT; ++b) acc[b] = 0.f;
    const float* wp = W + (size_t)(ks * 128) * ldw + n0 + j;
#pragma unroll 4
    for (int kk = 0; kk < 128; ++kk) {
        const float w = wp[(size_t)kk * ldw];
        const LAS f32x4* t4 = (const LAS f32x4*)(tbl + (ks * 128 + kk) * NBT);
#pragma unroll
        for (int q = 0; q < 6; ++q) { const f32x4 t = t4[q]; acc[4 * q + 0] += t[0] * w; acc[4 * q + 1] += t[1] * w; acc[4 * q + 2] += t[2] * w; acc[4 * q + 3] += t[3] * w; }
    }
    __syncthreads();
    LAS float* red = (LAS float*)c.lds;
#pragma unroll
    for (int b = 0; b < NBT; ++b) red[(ks * NBT + b) * 64 + j] = acc[b];
    __syncthreads();
    for (int o = c.tid; o < NBT * 64; o += NTHREADS) {
        const int b = o >> 6, jj = o & 63; float s = bias ? bias[n0 + jj] : 0.f;
#pragma unroll
        for (int q = 0; q < 8; ++q) s += red[(q * NBT + b) * 64 + jj];
        out[(size_t)b * ldo + n0 + jj] = s;
    }
}
__device__ __forceinline__ void transpose_unit(const Ctx& c, const float* W, int ldt, int N, int k0, int n0, bf16_t* Wt, const float* nscale) {
    LAS float* tile = (LAS float*)c.lds;
    __syncthreads();
    { const int r = c.tid >> 4, c4 = c.tid & 15;
#pragma unroll
      for (int i = 0; i < 2; ++i) { const int kk = r + 32 * i; const f32x4 v = *(const f32x4*)(W + (size_t)(k0 + kk) * N + n0 + c4 * 4);
          tile[kk * 65 + c4 * 4 + 0] = v[0]; tile[kk * 65 + c4 * 4 + 1] = v[1]; tile[kk * 65 + c4 * 4 + 2] = v[2]; tile[kk * 65 + c4 * 4 + 3] = v[3]; } }
    __syncthreads();
    { const int nn = c.tid >> 3, k8 = c.tid & 7; const float s = nscale ? nscale[n0 + nn] : 1.0f; float f[8];
#pragma unroll
      for (int j = 0; j < 8; ++j) f[j] = tile[(k8 * 8 + j) * 65 + nn] * s;
      u32x4 w; w.x = cvt_pk_bf16(f[0], f[1]); w.y = cvt_pk_bf16(f[2], f[3]); w.z = cvt_pk_bf16(f[4], f[5]); w.w = cvt_pk_bf16(f[6], f[7]);
      *(u32x4*)(Wt + (size_t)(n0 + nn) * ldt + k0 + k8 * 8) = w; }
}

constexpr int NU_MOD = DEPTH * (NMOD / 64);
constexpr int T_IN = 16 * 24, T_OUT = 16 * 16, T_F1 = 16 * 64, T_F2 = 64 * 16, T_LAYER = T_IN + T_OUT + T_F1 + T_F2;
constexpr int NU_TR = DEPTH * T_LAYER, NU_WP = DEPTH * 4 * 4, NU_WS = DEPTH * 4 * 4;
constexpr int NU_I0 = NU_MOD + NU_TR + NU_WP + NU_WS;
__device__ void phase_init0(const Ctx& c) {
    float* mod = (float*)(c.k->ws + WS_MOD);
    for (int u = c.bx; u < NU_I0; u += c.G) {
        if (u < NU_MOD) {
            const int l = u / (NMOD / 64), nb = u % (NMOD / 64);
            gemv24_unit(c, 0, nullptr, 0, c.k->in[I_WADA] + (size_t)l * D * NMOD, NMOD, nb * 64, c.k->in[I_BADA] + (size_t)l * NMOD, mod + (size_t)l * NBT * NMOD, NMOD);
        } else if (u < NU_MOD + NU_TR) {
            const int v = u - NU_MOD, l = v / T_LAYER; int r = v % T_LAYER;
            if (r < T_IN) transpose_unit(c, c.k->in[I_WIN] + (size_t)l * D * DIN, LDX, DIN, (r / 24) * 64, (r % 24) * 64, (bf16_t*)(c.k->ws + WS_WIN_T) + (size_t)l * DIN * LDX, nullptr);
            else if ((r -= T_IN) < T_OUT) transpose_unit(c, c.k->in[I_WOUT] + (size_t)l * D * D, LDX, D, (r / 16) * 64, (r % 16) * 64, (bf16_t*)(c.k->ws + WS_WOUT_T) + (size_t)l * D * LDX, nullptr);
            else if ((r -= T_OUT) < T_F1) transpose_unit(c, c.k->in[I_W1] + (size_t)l * D * DFF, LDX, DFF, (r / 64) * 64, (r % 64) * 64, (bf16_t*)(c.k->ws + WS_W1_T) + (size_t)l * DFF * LDX, nullptr);
            else { r -= T_F1; transpose_unit(c, c.k->in[I_W2] + (size_t)l * DFF * D, LDF, D, (r / 16) * 64, (r % 16) * 64, (bf16_t*)(c.k->ws + WS_W2_T) + (size_t)l * D * LDF, nullptr); }
        } else if (u < NU_MOD + NU_TR + NU_WP) {
            const int v = u - NU_MOD - NU_TR, lg = v >> 2, t = v & 3, l = lg >> 2, g = lg & 3;
            transpose_unit(c, c.k->in[I_WPOOL] + (size_t)lg * 128 * 128, 128, 128, (t >> 1) * 64, (t & 1) * 64, (bf16_t*)(c.k->ws + WS_WP_T) + (size_t)lg * 128 * 128, c.k->in[I_PSCALE] + l * PW + g * 128);
        } else {
            const int v = u - NU_MOD - NU_TR - NU_WP, lh = v >> 2, t = v & 3, t0 = (t >> 1) * 64, s0 = (t & 1) * 64;
            const int tt = t0 + (c.tid >> 3), s8 = s0 + (c.tid & 7) * 8;
            const float* src = c.k->in[I_WSP] + ((size_t)lh * 128 + tt) * 128 + s8;
            const f32x4 a = *(const f32x4*)src, b = *(const f32x4*)(src + 4);
            float f[8] = {a[0], a[1], a[2], a[3], b[0], b[1], b[2], b[3]};
#pragma unroll
            for (int j = 0; j < 8; ++j) if (s8 + j > tt) f[j] = 0.f;
            u32x4 w; w.x = cvt_pk_bf16(f[0], f[1]); w.y = cvt_pk_bf16(f[2], f[3]); w.z = cvt_pk_bf16(f[4], f[5]); w.w = cvt_pk_bf16(f[6], f[7]);
            *(u32x4*)((bf16_t*)(c.k->ws + WS_WSP) + ((size_t)lh * 128 + tt) * 128 + s8) = w;
        }
    }
}
constexpr int NU_SH_L = DIN / 64 + DFF / 64;
__device__ void phase_init1(const Ctx& c) {
    const float* mod = (const float*)(c.k->ws + WS_MOD);
    for (int u = c.bx; u < DEPTH * NU_SH_L; u += c.G) {
        const int l = u / NU_SH_L, r = u % NU_SH_L;
        const float* ml = mod + (size_t)l * NBT * NMOD;
        if (r < DIN / 64) gemv24_unit(c, 1, ml + 0 * D, NMOD, c.k->in[I_WIN] + (size_t)l * D * DIN, DIN, r * 64, nullptr, (float*)(c.k->ws + WS_SHWIN) + (size_t)l * NBT * DIN, DIN);
        else gemv24_unit(c, 1, ml + 3 * D, NMOD, c.k->in[I_W1] + (size_t)l * D * DFF, DFF, (r - DIN / 64) * 64, nullptr, (float*)(c.k->ws + WS_SHW1) + (size_t)l * NBT * DFF, DFF);
    }
    bf16_t* XG = (bf16_t*)(c.k->ws + WS_XG); float* ssq1 = (float*)(c.k->ws + WS_SSQ1);
    const float* gm = c.k->in[I_GMIX];
    for (int rg = c.bx; rg < MT / 8; rg += c.G) {
        const int row = rg * 8 + c.wid, b = batch_of(row);
        const float* xr = row < MP ? c.k->in[I_XP] + (size_t)row * D : c.k->in[I_XS] + (size_t)(row - MP) * D;
        const float* sc = mod + (size_t)b * NMOD + 1 * D;
        float ss = 0.f;
#pragma unroll
        for (int i = 0; i < 4; ++i) {
            const int k = i * 256 + c.lane * 4;
            const f32x4 x = *(const f32x4*)(xr + k), g = *(const f32x4*)(gm + k), s = *(const f32x4*)(sc + k);
            ss += (x[0] * x[0] + x[1] * x[1]) + (x[2] * x[2] + x[3] * x[3]);
            const f32x4 xg = x * (g * (s + 1.0f));
            u32x2 w; w.x = cvt_pk_bf16(xg[0], xg[1]); w.y = cvt_pk_bf16(xg[2], xg[3]);
            *(u32x2*)(XG + (size_t)row * LDX + k) = w;
        }
        ss = wave_sum(ss);
        if (c.lane < 16) ssq1[(size_t)row * 16 + c.lane] = c.lane == 0 ? ss : 0.f;
    }
}
constexpr int TP = 272;
__device__ __forceinline__ void unpack8(u32x4 v, float* f) { f[0] = bflo(v.x); f[1] = bfhi(v.x); f[2] = bflo(v.y); f[3] = bfhi(v.y); f[4] = bflo(v.z); f[5] = bfhi(v.z); f[6] = bflo(v.w); f[7] = bfhi(v.w); }
__device__ __forceinline__ u32x4 pack8(const float* f) { u32x4 w; w.x = cvt_pk_bf16(f[0], f[1]); w.y = cvt_pk_bf16(f[2], f[3]); w.z = cvt_pk_bf16(f[4], f[5]); w.w = cvt_pk_bf16(f[6], f[7]); return w; }
__device__ void phase_mixer(const Ctx& c, int l) {
    LAS unsigned char* tA = c.lds; LAS unsigned char* tB = c.lds + 128 * TP; LAS unsigned char* tX = c.lds + 256 * TP;
    unsigned char* ws = c.k->ws; float* outp = c.k->out;
    const bf16_t* Ab = (const bf16_t*)(ws + WS_A); const bf16_t* Ub = (const bf16_t*)(ws + WS_U); const bf16_t* GVb = (const bf16_t*)(ws + WS_GV);
    bf16_t* CAT = (bf16_t*)(ws + WS_CAT); const float* stv = (const float*)(ws + WS_STV);
    const bf16_t* WpT = (const bf16_t*)(ws + WS_WP_T) + (size_t)l * 4 * 128 * 128;
    const bf16_t* Wsp = (const bf16_t*)(ws + WS_WSP) + (size_t)l * 4 * 128 * 128;
    const int lane = c.lane, wid = c.wid, i15 = lane & 15, kq = lane >> 4, c8 = c.tid & 15, r0 = c.tid >> 4;
    constexpr int NCH = MP / 128 + NBS;
    for (int u = c.bx; u < NCH * 8; u += c.G) {
        const int ct = u >> 3, j = u & 7;
        const bool samp = ct >= MP / 128;
        const int sb = ct - MP / 128;
        const int row0 = samp ? MP + sb * DSEQ : ct * 128, nrows = samp ? DSEQ : 128, bm = samp ? NBP + sb : (ct >> 5), tseq0 = samp ? SEQ : (ct & 31) * 128;
        const int ntb = nrows >> 4;
        bf16_t* const cbase = CAT + (size_t)row0 * LDX + (j < 4 ? j * 128 : 512 + (j - 4) * 128) + 16 * wid + 4 * kq;
        __syncthreads();
        if (j < 4) {
            const int g = j, w = 2 << g;
            {
                u32x4 wv[4], xv[5];
#pragma unroll
                for (int i = 0; i < 4; ++i) wv[i] = *(const u32x4*)(WpT + ((size_t)g * 128 + r0 + 32 * i) * 128 + c8 * 8);
                const bf16_t* ap = Ab + (size_t)row0 * PW + g * 128 + c8 * 8;
#pragma unroll
                for (int i = 0; i < 5; ++i) {
                    const int rr = r0 + 32 * i, t = rr - 15;
                    xv[i] = (u32x4){0u, 0u, 0u, 0u};
                    if (rr < 143 && t < nrows) {
                        if (t >= 0 || (!samp && tseq0 > 0)) xv[i] = *(const u32x4*)(ap + (ptrdiff_t)t * PW);
                        else if (samp) { const float* sp = c.k->in[I_SPOOL] + (((size_t)l * NBS + sb) * 15 + rr) * PW + g * 128 + c8 * 8;
                            const f32x4 p0 = *(const f32x4*)sp, p1 = *(const f32x4*)(sp + 4);
                            xv[i].x = cvt_pk_bf16(p0[0], p0[1]); xv[i].y = cvt_pk_bf16(p0[2], p0[3]); xv[i].z = cvt_pk_bf16(p1[0], p1[1]); xv[i].w = cvt_pk_bf16(p1[2], p1[3]); }
                    }
                }
#pragma unroll
                for (int i = 0; i < 4; ++i) *(LAS u32x4*)(tB + (r0 + 32 * i) * TP + c8 * 16) = wv[i];
#pragma unroll
                for (int i = 0; i < 5; ++i) { const int rr = r0 + 32 * i; if (rr < 143) *(LAS u32x4*)(tX + rr * TP + c8 * 16) = xv[i]; }
            }
            __syncthreads();
#pragma unroll 1
            for (int i = 0; i < 4; ++i) {
                const int t = r0 + 32 * i;
                if (t < nrows) {
                    const LAS unsigned char* xp0 = tX + (t + 15) * TP + c8 * 16;
                    float a0[8], s[8], tmp[8];
                    unpack8(*(const LAS u32x4*)xp0, a0);
#pragma unroll
                    for (int k = 0; k < 8; ++k) s[k] = a0[k];
#pragma unroll 2
                    for (int jj = 1; jj < w; ++jj) { unpack8(*(const LAS u32x4*)(xp0 - jj * TP), tmp);
#pragma unroll
                        for (int k = 0; k < 8; ++k) s[k] += tmp[k]; }
                    const int pos1 = tseq0 + t + 1; const float inv = 1.0f / (float)(pos1 < w ? pos1 : w);
                    float dd[8];
#pragma unroll
                    for (int k = 0; k < 8; ++k) dd[k] = s[k] * inv - a0[k];
                    *(LAS u32x4*)(tA + t * TP + c8 * 16) = pack8(dd);
                    float* so = nullptr;
                    if (!samp && (ct & 31) == 31 && t >= 113) so = outp + OUT_SPP + (((size_t)l * NBP + bm) * 15 + (t - 113)) * PW + g * 128 + c8 * 8;
                    if (samp && t >= 49) so = outp + OUT_SPS + (((size_t)l * NBS + sb) * 15 + (t - 49)) * PW + g * 128 + c8 * 8;
                    if (so) { *(f32x4*)so = (f32x4){a0[0], a0[1], a0[2], a0[3]}; *(f32x4*)(so + 4) = (f32x4){a0[4], a0[5], a0[6], a0[7]}; }
                }
            }
            __syncthreads();
            f32x4 acc[8];
#pragma unroll
            for (int tb = 0; tb < 8; ++tb) acc[tb] = (f32x4){0.f, 0.f, 0.f, 0.f};
#pragma unroll
            for (int kk = 0; kk < 4; ++kk) {
                const bf16x8 bf = *(const LAS bf16x8*)(tB + (16 * wid + i15) * TP + kk * 64 + kq * 16);
#pragma unroll
                for (int tb = 0; tb < 8; ++tb) if (tb < ntb) {
                    const bf16x8 af = *(const LAS bf16x8*)(tA + (16 * tb + i15) * TP + kk * 64 + kq * 16);
                    acc[tb] = __builtin_amdgcn_mfma_f32_16x16x32_bf16(bf, af, acc[tb], 0, 0, 0); }
            }
#pragma unroll
            for (int tb = 0; tb < 8; ++tb) if (tb < ntb) *(u32x2*)(cbase + (size_t)(16 * tb + i15) * LDX) = pack4(acc[tb]);
        } else {
            const int h = j - 4;
            u32x2 uu[8]; float bsv[8];
            {
                u32x4 wv[4], gvv[4]; float sv[4];
#pragma unroll
                for (int i = 0; i < 4; ++i) wv[i] = *(const u32x4*)(Wsp + ((size_t)h * 128 + r0 + 32 * i) * 128 + c8 * 8);
#pragma unroll
                for (int i = 0; i < 4; ++i) {
                    const int sr = r0 + 32 * i; gvv[i] = (u32x4){0u, 0u, 0u, 0u}; sv[i] = 0.f;
                    if (sr < nrows) { const int row = row0 + sr; gvv[i] = *(const u32x4*)(GVb + (size_t)row * SW + h * 128 + c8 * 8); sv[i] = stv[(size_t)row * 16 + c8]; }
                }
                const float* vg = c.k->in[I_VG] + l * SW + h * 128 + c8 * 8; const float* vb = c.k->in[I_VB] + l * SW + h * 128 + c8 * 8;
                const f32x4 g0 = *(const f32x4*)vg, g1 = *(const f32x4*)(vg + 4), b0 = *(const f32x4*)vb, b1 = *(const f32x4*)(vb + 4);
#pragma unroll
                for (int tb = 0; tb < 8; ++tb) { uu[tb] = (u32x2){0u, 0u}; bsv[tb] = 0.f;
                    if (tb < ntb) { uu[tb] = *(const u32x2*)(Ub + (size_t)(row0 + 16 * tb + i15) * SW + h * 128 + 16 * wid + 4 * kq);
                                    bsv[tb] = c.k->in[I_BSP][((size_t)l * 4 + h) * 128 + 16 * tb + i15]; } }
#pragma unroll
                for (int i = 0; i < 4; ++i) *(LAS u32x4*)(tA + (r0 + 32 * i) * TP + c8 * 16) = wv[i];
#pragma unroll
                for (int i = 0; i < 4; ++i) {
                    const int sr = r0 + 32 * i;
                    float sx = sv[i]; sx += __shfl_xor(sx, 2); sx += __shfl_xor(sx, 4); sx += __shfl_xor(sx, 8);
                    const float so_ = __shfl_xor(sx, 1);
                    const float sum = (c8 & 1) ? so_ : sx, sq = (c8 & 1) ? sx : so_;
                    u32x4 outv = (u32x4){0u, 0u, 0u, 0u};
                    if (sr < nrows) {
                        float gvf[8]; unpack8(gvv[i], gvf);
                        const float mean = sum * (1.0f / SW); float var = sq * (1.0f / SW) - mean * mean; var = var < 0.f ? 0.f : var;
                        const float rstd = rsqrtf(var + EPS);
                        float vl[8];
#pragma unroll
                        for (int k = 0; k < 4; ++k) { vl[k] = (gvf[k] - mean) * rstd * g0[k] + b0[k]; vl[4 + k] = (gvf[4 + k] - mean) * rstd * g1[k] + b1[k]; }
                        if (samp) { float* so = outp + OUT_SV + (((size_t)l * NBS + sb) * DSEQ + sr) * SW + h * 128 + c8 * 8;
                            *(f32x4*)so = (f32x4){vl[0], vl[1], vl[2], vl[3]}; *(f32x4*)(so + 4) = (f32x4){vl[4], vl[5], vl[6], vl[7]}; }
                        outv = pack8(vl);
                    }
                    *(LAS u32x4*)(tB + sr * TP + c8 * 16) = outv;
                }
            }
            __syncthreads();
            f32x4 acc[8];
#pragma unroll
            for (int tb = 0; tb < 8; ++tb) acc[tb] = (f32x4){0.f, 0.f, 0.f, 0.f};
            const int q = i15 >> 2, p = lane & 3;
#pragma unroll
            for (int kk = 0; kk < 4; ++kk) {
                LAS unsigned char* vp = tB + (32 * kk + 8 * kq + q) * TP + (16 * wid + 4 * p) * 2;
                const s16x4 lo = __builtin_amdgcn_ds_read_tr16_b64_v4i16((LAS s16x4*)vp);
                const s16x4 hi = __builtin_amdgcn_ds_read_tr16_b64_v4i16((LAS s16x4*)(vp + 4 * TP));
                const bf16x8 vf = __builtin_shufflevector(lo, hi, 0, 1, 2, 3, 4, 5, 6, 7);
#pragma unroll
                for (int tb = 0; tb < 8; ++tb) if (tb >= 2 * kk && tb < ntb) {
                    const bf16x8 af = *(const LAS bf16x8*)(tA + (16 * tb + i15) * TP + kk * 64 + kq * 16);
                    acc[tb] = __builtin_amdgcn_mfma_f32_16x16x32_bf16(vf, af, acc[tb], 0, 0, 0); }
            }
#pragma unroll
            for (int tb = 0; tb < 8; ++tb) if (tb < ntb) {
                f32x4 o = acc[tb]; const u32x2 w2 = uu[tb]; const float bs = bsv[tb];
                o = (f32x4){bflo(w2.x) * (o[0] + bs), bfhi(w2.x) * (o[1] + bs), bflo(w2.y) * (o[2] + bs), bfhi(w2.y) * (o[3] + bs)};
                *(u32x2*)(cbase + (size_t)(16 * tb + i15) * LDX) = pack4(o);
            }
        }
    }
}
__device__ void phase_final(const Ctx& c) {
    const float* ssq1 = (const float*)(c.k->ws + WS_SSQ1); const float* gf = c.k->in[I_GFIN];
    for (int rg = c.bx; rg < MT / 8; rg += c.G) {
        const int row = rg * 8 + c.wid;
        float p = c.lane < 16 ? ssq1[(size_t)row * 16 + c.lane] : 0.f;
        p = wave_sum(p);
        const float rstd = rsqrtf(p * (1.0f / D) + EPS);
        float* xr = c.k->out + OUT_Y + (size_t)row * D;
#pragma unroll
        for (int i = 0; i < 4; ++i) { const int k = i * 256 + c.lane * 4; const f32x4 x = *(const f32x4*)(xr + k), g = *(const f32x4*)(gf + k); *(f32x4*)(xr + k) = x * rstd * g; }
    }
}

constexpr int NPHASE = 2 + 5 * DEPTH + 1;
__global__ void __launch_bounds__(NTHREADS, 2) mk_fwd(Params p) {
    __shared__ __attribute__((aligned(16))) unsigned char shm[pg8::STAGE_BYTES];
    cg::grid_group grid = cg::this_grid();
    Ctx c;
    c.k = kargs(); c.lds = (LAS unsigned char*)shm;
    c.tid = threadIdx.x; c.lane = c.tid & 63; c.wid = __builtin_amdgcn_readfirstlane(c.tid >> 6); c.G = gridDim.x; c.bx = blockIdx.x;
#ifndef PHMASK
#define PHMASK 0xffff
#endif
#define PHON(k) ((PHMASK >> (k)) & 1)
#ifndef DUPMASK
#define DUPMASK 0
#endif
#define DUPN(k) (((DUPMASK >> (k)) & 1) ? 2 : 1)
    for (int ph = p.ph_lo; ph < p.ph_hi; ++ph) {
        { int t_ = threadIdx.x; asm volatile("" : "+v"(t_)); c.tid = t_; c.lane = t_ & 63; c.wid = __builtin_amdgcn_readfirstlane(t_ >> 6); c.k = kargs(); }
        unsigned char* ws = c.k->ws;
        const float* mod = (const float*)(ws + WS_MOD);
        if (ph == 0) { for (int r_ = 0; r_ < DUPN(0); ++r_) phase_init0(c); }
        else if (ph == 1) { for (int r_ = 0; r_ < DUPN(1); ++r_) phase_init1(c); }
        else if (ph == NPHASE - 1) { if (PHON(7)) phase_final(c); }
        else {
            const int l = (ph - 2) / 5, s = (ph - 2) % 5;
            const float* modl = mod + (size_t)l * NBT * NMOD;
            pg8::StaticOrder S;
            if (s == 0 && PHON(2)) {
                pg8::Gemm g{(const bf16_t*)(ws + WS_XG), (const bf16_t*)(ws + WS_WIN_T) + (size_t)l * DIN * LDX, MT, DIN, D, LDX, LDX}; S.init(MT, DIN, c.G, c.bx);
                EpiIn E{(const float*)(ws + WS_SSQ1), (const float*)(ws + WS_SHWIN) + (size_t)l * NBT * DIN, (bf16_t*)(ws + WS_A), (bf16_t*)(ws + WS_U), (bf16_t*)(ws + WS_GV), (float*)(ws + WS_STV)};
                for (int r_ = 0; r_ < DUPN(2); ++r_) pg8::gemm_phase<EpiIn>(c.lds, g, S, E);
            } else if (s == 1 && PHON(3)) {
                for (int r_ = 0; r_ < DUPN(3); ++r_) phase_mixer(c, l);
            } else if (s == 2 && PHON(4)) {
                pg8::Gemm g{(const bf16_t*)(ws + WS_CAT), (const bf16_t*)(ws + WS_WOUT_T) + (size_t)l * D * LDX, MT, D, D, LDX, LDX}; S.init(MT, D, c.G, c.bx);
                EpiRes E{c.k->in[I_XP], c.k->in[I_XS], l == 0 ? nullptr : c.k->out + OUT_Y, c.k->out + OUT_Y, modl + 2 * D, c.k->in[I_GFFN] + l * D, modl + 4 * D, (bf16_t*)(ws + WS_XG), (float*)(ws + WS_SSQ2)};
                pg8::gemm_phase<EpiRes>(c.lds, g, S, E);
            } else if (s == 3 && PHON(5)) {
                pg8::Gemm g{(const bf16_t*)(ws + WS_XG), (const bf16_t*)(ws + WS_W1_T) + (size_t)l * DFF * LDX, MT, DFF, D, LDX, LDX}; S.init(MT, DFF, c.G, c.bx);
                EpiFf1 E{(const float*)(ws + WS_SSQ2), (const float*)(ws + WS_SHW1) + (size_t)l * NBT * DFF, (bf16_t*)(ws + WS_F1)};
                for (int r_ = 0; r_ < DUPN(5); ++r_) pg8::gemm_phase<EpiFf1>(c.lds, g, S, E);
            } else if (s == 4 && PHON(6)) {
                pg8::Gemm g{(const bf16_t*)(ws + WS_F1), (const bf16_t*)(ws + WS_W2_T) + (size_t)l * D * LDF, MT, D, DFF, LDF, LDF}; S.init(MT, D, c.G, c.bx);
                const bool more = (l + 1 < DEPTH);
                EpiRes E{c.k->in[I_XP], c.k->in[I_XS], c.k->out + OUT_Y, c.k->out + OUT_Y, modl + 5 * D, more ? c.k->in[I_GMIX] + (l + 1) * D : nullptr, mod + (size_t)(more ? l + 1 : l) * NBT * NMOD + 1 * D,
                         (bf16_t*)(ws + WS_XG), (float*)(ws + WS_SSQ1)};
                pg8::gemm_phase<EpiRes>(c.lds, g, S, E);
            }
        }
        if (ph + 1 < p.ph_hi) grid.sync();
    }
}

extern "C" void kernel_launch(void* const* d_in, const int* in_sizes, int n_in, void* d_out, int out_size, void* d_ws, size_t ws_size, hipStream_t stream) {
    static int grid_blocks = 0;
    if (!grid_blocks) {
        int dev = 0, cus = 0, per_cu = 0;
        hipGetDevice(&dev);
        hipDeviceGetAttribute(&cus, hipDeviceAttributeMultiprocessorCount, dev);
        hipOccupancyMaxActiveBlocksPerMultiprocessor(&per_cu, mk_fwd, NTHREADS, 0);
        if (per_cu < 1) per_cu = 1;
        if (per_cu > 1) per_cu = 1;
        grid_blocks = cus * per_cu;
        if (n_in != 20 || ws_size < WS_END) fprintf(stderr, "kernel_launch: unexpected n_in %d / ws_size %zu (need %zu)\n", n_in, ws_size, (size_t)WS_END);
    }
    Params p{};
    for (int i = 0; i < 20; ++i) p.in[i] = (const float*)d_in[i];
    p.out = (float*)d_out; p.ws = (unsigned char*)d_ws;
#if MK_SINGLE
    p.ph_lo = 0; p.ph_hi = NPHASE;
    { void* args[] = {&p};
      hipError_t e = hipLaunchCooperativeKernel((void*)mk_fwd, dim3(grid_blocks), dim3(NTHREADS), args, 0, stream);
      if (e != hipSuccess) fprintf(stderr, "cooperative launch failed: %s (grid %d)\n", hipGetErrorString(e), grid_blocks); }
#else
    for (int ph = 0; ph < NPHASE; ++ph) {
        p.ph_lo = ph; p.ph_hi = ph + 1;
        void* args[] = {&p};
        hipError_t e = hipLaunchCooperativeKernel((void*)mk_fwd, dim3(grid_blocks), dim3(NTHREADS), args, 0, stream);
        if (e != hipSuccess) { fprintf(stderr, "cooperative launch failed: %s (grid %d, phase %d)\n", hipGetErrorString(e), grid_blocks, ph); break; }
    }
#endif
}
```

```cpp
#include <hip/hip_runtime.h>
#include <hip/hip_cooperative_groups.h>
#include <cstdio>
namespace cg = cooperative_groups;

#ifndef MK_SINGLE
#define MK_SINGLE 1
#endif

#define LAS __attribute__((address_space(3)))
typedef unsigned short bf16_t;
typedef short bf16x8 __attribute__((ext_vector_type(8)));
typedef short s16x4 __attribute__((ext_vector_type(4)));
typedef float f32x4 __attribute__((ext_vector_type(4)));
typedef float f32x2 __attribute__((ext_vector_type(2)));
typedef unsigned u32x4 __attribute__((ext_vector_type(4)));
typedef unsigned u32x2 __attribute__((ext_vector_type(2)));

constexpr int D = 1024, NBP = 16, SEQ = 4096, MP = NBP * SEQ, NBS = 8, DSEQ = 64, MS = NBS * DSEQ, MT = MP + MS;
constexpr int DIN = 1536, DFF = 4096, DEPTH = 2, NBT = NBP + NBS, PW = 512, SW = 512, NMOD = 6 * D;
constexpr float EPS = 1e-6f;
constexpr int NTHREADS = 512;

constexpr size_t WS_WIN_T = 0;
constexpr size_t WS_WOUT_T = WS_WIN_T + (size_t)DEPTH * DIN * D * 2;
constexpr size_t WS_W1_T = WS_WOUT_T + (size_t)DEPTH * D * D * 2;
constexpr size_t WS_W2_T = WS_W1_T + (size_t)DEPTH * DFF * D * 2;
constexpr size_t WS_WP_T = WS_W2_T + (size_t)DEPTH * DFF * D * 2;
constexpr size_t WS_WSP = WS_WP_T + (size_t)DEPTH * 4 * 128 * 128 * 2;
constexpr size_t WS_MOD = WS_WSP + (size_t)DEPTH * 4 * 128 * 128 * 2;
constexpr size_t WS_SHWIN = WS_MOD + (size_t)DEPTH * NBT * NMOD * 4;
constexpr size_t WS_SHW1 = WS_SHWIN + (size_t)DEPTH * NBT * DIN * 4;
constexpr size_t WS_SSQ1 = WS_SHW1 + (size_t)DEPTH * NBT * DFF * 4;
constexpr size_t WS_SSQ2 = WS_SSQ1 + (size_t)MT * 16 * 4;
constexpr size_t WS_STV = WS_SSQ2 + (size_t)MT * 16 * 4;
constexpr size_t WS_XG = WS_STV + (size_t)MT * 16 * 4;
constexpr size_t WS_F1 = WS_XG + (size_t)MT * D * 2;
constexpr size_t WS_A = WS_F1;
constexpr size_t WS_U = WS_A + (size_t)MT * PW * 2;
constexpr size_t WS_GV = WS_U + (size_t)MT * SW * 2;
constexpr size_t WS_CAT = WS_GV + (size_t)MT * SW * 2;
constexpr size_t WS_END = WS_F1 + (size_t)MT * DFF * 2;

constexpr size_t OUT_Y = 0;
constexpr size_t OUT_SPP = (size_t)MT * D;
constexpr size_t OUT_SPS = OUT_SPP + (size_t)DEPTH * NBP * 15 * PW;
constexpr size_t OUT_SV = OUT_SPS + (size_t)DEPTH * NBS * 15 * PW;

struct Params {
    const float* in[20];
    float* out;
    unsigned char* ws;
    int ph_lo, ph_hi;
};
enum { I_XP = 0, I_XS, I_SPOOL, I_CP, I_CS, I_WADA, I_BADA, I_GMIX, I_WIN, I_WPOOL, I_PSCALE, I_VG, I_VB, I_WSP, I_BSP, I_WOUT, I_GFFN, I_W1, I_W2, I_GFIN };

__device__ __forceinline__ unsigned cvt_pk_bf16(float lo, float hi) { unsigned r; asm volatile("v_cvt_pk_bf16_f32 %0, %1, %2" : "=v"(r) : "v"(lo), "v"(hi)); return r; }
__device__ __forceinline__ float bflo(unsigned w) { return __uint_as_float(w << 16); }
__device__ __forceinline__ float bfhi(unsigned w) { return __uint_as_float(w & 0xffff0000u); }
__device__ __forceinline__ int batch_of(int row) { return row < MP ? (row >> 12) : NBP + ((row - MP) >> 6); }
__device__ __forceinline__ f32x2 gelu_pk(f32x2 v) {
    const f32x2 av = __builtin_elementwise_abs(v), d = av * 0.2316418882f + 1.0f;
    f32x2 t; t.x = __builtin_amdgcn_rcpf(d.x); t.y = __builtin_amdgcn_rcpf(d.y);
    f32x2 q = t * 0.5307027145f + (-0.7265760135f); q = q * t + 0.7107068705f; q = q * t + (-0.142248368f); q = q * t + 0.127414796f; q = q * t;
    const f32x2 s = (v * v) * (-0.72134752044f);
    f32x2 e; e.x = __builtin_amdgcn_exp2f(s.x); e.y = __builtin_amdgcn_exp2f(s.y);
    const f32x2 m = v * (q * e), r = v - m;
    f32x2 o; o.x = v.x < 0.f ? m.x : r.x; o.y = v.y < 0.f ? m.y : r.y; return o;
}
__device__ __forceinline__ f32x4 gelu4(f32x4 v) { f32x2 a = gelu_pk((f32x2){v[0], v[1]}), b = gelu_pk((f32x2){v[2], v[3]}); return (f32x4){a.x, a.y, b.x, b.y}; }
__device__ __forceinline__ float wave_sum(float v) {
#pragma unroll
    for (int o = 32; o >= 1; o >>= 1) v += __shfl_xor(v, o);
    return v;
}
__device__ __forceinline__ float quad_row_sum(float v) { v += __shfl_xor(v, 16); v += __shfl_xor(v, 32); return v; }

namespace pg8 {
constexpr int BM = 256, BK = 64, HALF = 128, HTB = HALF * BK * 2, STAGE_BYTES = 8 * HTB, NXCD = 8, WGM = 8;
__device__ __forceinline__ int lds_byte(int r, int c) { const int st = (r >> 4) * 2 + (c >> 5), rr = r & 15, cc = c & 31, ob = rr * 64 + cc * 2; return st * 1024 + (ob ^ (((ob >> 9) & 1) << 5)); }
__device__ __forceinline__ void stage_rc(int b, int& R, int& C) { const int st = b / 1024, sb = b % 1024, swz = sb ^ (((sb >> 9) & 1) << 5); R = (st >> 1) * 16 + swz / 64; C = (st & 1) * 32 + (swz % 64) / 2; }
struct Unit { int pm, pn; };
struct Gemm { const bf16_t* A; const bf16_t* Bt; int M, N, K; };
struct StaticOrder {
    int nM, nN, nwg, G, c;
    __device__ void init(int M, int N, int G_, int c_) { nM = M / BM; nN = N / BM; nwg = nM * nN; G = G_; c = c_; }
    __device__ bool next(int i, Unit& u) const {
        const long L = (long)i * G + c; if (L >= nwg) return false;
        int wgid = (int)L; { const int q = nwg / NXCD, r = nwg % NXCD, xcd = wgid % NXCD, off = wgid / NXCD; wgid = (xcd < r ? xcd * (q + 1) : r * (q + 1) + (xcd - r) * q) + off; }
        const int nig = WGM * nN, gid = wgid / nig, fm = gid * WGM, gsz = (nM - fm) < WGM ? (nM - fm) : WGM;
        u.pm = fm + ((wgid % nig) % gsz); u.pn = (wgid % nig) / gsz; return true;
    }
};

template <class Epi>
__device__ __forceinline__ void gemm_phase(LAS unsigned char* lds, const Gemm g, const StaticOrder& S, const Epi& E) {
    int tid_ = threadIdx.x; asm volatile("" : "+v"(tid_));
    const int tid = tid_, wid = __builtin_amdgcn_readfirstlane(tid >> 6), lane = tid & 63, wr = wid >> 2, wc = wid & 3, fr = lane & 15, fq = lane >> 4;
    const int K = g.K, nt = K / BK;
    unsigned voffA[2], voffB[2];
#pragma unroll
    for (int i = 0; i < 2; ++i) { int R, C; stage_rc(tid * 16 + i * 8192, R, C); voffA[i] = (unsigned)(R * K + C) * 2u; voffB[i] = (unsigned)(R * K + C) * 2u; }
    const size_t kstep = (size_t)(BK * 2);
    const size_t hstep = (size_t)HALF * K * 2;
    const size_t tstep = 2 * hstep;
    const unsigned ldsw = (unsigned)wid * 1024u;
    const int aoff = lds_byte(wr * 64 + fr, fq * 8), boff = lds_byte(wc * 32 + fr, fq * 8);
#define PG8_SA(b, h) (((b) * 2 + (h)) * HTB)
#define PG8_SB(b, h) ((4 + (b) * 2 + (h)) * HTB)
#define PG8_STAGE(bufoff, gbase, voff) do { _Pragma("unroll") for (int _i = 0; _i < 2; ++_i) \
        __builtin_amdgcn_global_load_lds((const unsigned*)((const char*)(gbase) + (voff)[_i]), (LAS unsigned*)(lds + (bufoff) + ldsw + _i * 8192), 16, 0, 0); } while (0)
#define PG8_LDA(dst, b, h) do { _Pragma("unroll") for (int m = 0; m < 4; ++m) _Pragma("unroll") for (int k = 0; k < 2; ++k) dst[m][k] = *(const LAS bf16x8*)(lds + PG8_SA(b, h) + aoff + m * 2048 + k * 1024); } while (0)
#define PG8_LDB(dst, b, h) do { _Pragma("unroll") for (int n = 0; n < 2; ++n) _Pragma("unroll") for (int k = 0; k < 2; ++k) dst[n][k] = *(const LAS bf16x8*)(lds + PG8_SB(b, h) + boff + n * 2048 + k * 1024); } while (0)
#define PG8_MMA(ai, bj, At, Bt) do { __builtin_amdgcn_s_setprio(1); _Pragma("unroll") for (int m = 0; m < 4; ++m) _Pragma("unroll") for (int n = 0; n < 2; ++n) _Pragma("unroll") for (int k = 0; k < 2; ++k) \
        acc[ai][bj][m][n] = __builtin_amdgcn_mfma_f32_16x16x32_bf16(Bt[n][k], At[m][k], acc[ai][bj][m][n], 0, 0, 0); __builtin_amdgcn_s_setprio(0); } while (0)
#define PG8_WAIT_V(n) asm volatile("s_waitcnt vmcnt(" #n ")" ::: "memory")
#define PG8_WAIT_L(n) asm volatile("s_waitcnt lgkmcnt(" #n ")" ::: "memory")
#define PG8_BAR __builtin_amdgcn_s_barrier()
#define PG8_SCHED __builtin_amdgcn_sched_barrier(0)
    Unit cur, nxt; int ui = 0;
    if (!S.next(0, cur)) return;
    f32x4 acc[2][2][4][2];
#pragma unroll
    for (int a = 0; a < 2; ++a)
#pragma unroll
        for (int b = 0; b < 2; ++b)
#pragma unroll
            for (int m = 0; m < 4; ++m)
#pragma unroll
                for (int n = 0; n < 2; ++n) acc[a][b][m][n] = (f32x4){0.f, 0.f, 0.f, 0.f};
    bf16x8 At[4][2], B0[2][2], B1[2][2];
    const char* cA = (const char*)g.A + (size_t)cur.pm * tstep; const char* cB = (const char*)g.Bt + (size_t)cur.pn * tstep;
    PG8_STAGE(PG8_SB(0, 0), cB, voffB); PG8_STAGE(PG8_SA(0, 0), cA, voffA); PG8_STAGE(PG8_SB(0, 1), cB + hstep, voffB); PG8_STAGE(PG8_SA(0, 1), cA + hstep, voffA);
    if (wr == 1) PG8_BAR;
    PG8_WAIT_V(4); PG8_BAR;
    PG8_STAGE(PG8_SB(1, 0), cB + kstep, voffB); PG8_STAGE(PG8_SA(1, 0), cA + kstep, voffA); PG8_STAGE(PG8_SB(1, 1), cB + hstep + kstep, voffB);
    PG8_WAIT_V(6); PG8_BAR;
    for (;;) {
        const bool has_next = S.next(ui + 1, nxt);
        const char* nA = has_next ? (const char*)g.A + (size_t)nxt.pm * tstep : cA; const char* nB = has_next ? (const char*)g.Bt + (size_t)nxt.pn * tstep : cB;
        for (int t = 0; t < nt; t += 2) {
            const bool last = (t == nt - 2);
            const char* a1 = cA + (size_t)(t + 1) * kstep;
            const char* a2 = last ? nA : cA + (size_t)(t + 2) * kstep; const char* b2 = last ? nB : cB + (size_t)(t + 2) * kstep;
            const char* a3 = a2 + kstep; const char* b3 = b2 + kstep;
            PG8_LDB(B0, 0, 0); PG8_SCHED; PG8_LDA(At, 0, 0); PG8_STAGE(PG8_SA(1, 1), a1 + hstep, voffA);
            PG8_WAIT_L(8); PG8_BAR; PG8_WAIT_L(0); PG8_MMA(0, 0, At, B0); PG8_BAR; PG8_SCHED;
            PG8_LDB(B1, 0, 1); PG8_STAGE(PG8_SB(0, 0), b2, voffB);
            PG8_BAR; PG8_WAIT_L(0); PG8_MMA(0, 1, At, B1); PG8_BAR;
            PG8_LDA(At, 0, 1); PG8_STAGE(PG8_SA(0, 0), a2, voffA);
            PG8_BAR; PG8_WAIT_L(0); PG8_MMA(1, 0, At, B0); PG8_BAR; PG8_SCHED;
            PG8_STAGE(PG8_SB(0, 1), b2 + hstep, voffB);
            PG8_WAIT_V(6); PG8_BAR; PG8_MMA(1, 1, At, B1); PG8_BAR;
            PG8_LDB(B0, 1, 0); PG8_SCHED; PG8_LDA(At, 1, 0); PG8_STAGE(PG8_SA(0, 1), a2 + hstep, voffA);
            PG8_WAIT_L(8); PG8_BAR; PG8_WAIT_L(0); PG8_MMA(0, 0, At, B0); PG8_BAR; PG8_SCHED;
            PG8_LDB(B1, 1, 1); PG8_STAGE(PG8_SB(1, 0), b3, voffB);
            PG8_BAR; PG8_WAIT_L(0); PG8_MMA(0, 1, At, B1); PG8_BAR;
            PG8_LDA(At, 1, 1); PG8_STAGE(PG8_SA(1, 0), a3, voffA);
            PG8_BAR; PG8_WAIT_L(0); PG8_MMA(1, 0, At, B0); PG8_BAR; PG8_SCHED;
            PG8_STAGE(PG8_SB(1, 1), b3 + hstep, voffB);
            PG8_WAIT_V(6); PG8_BAR; PG8_MMA(1, 1, At, B1); PG8_BAR;
        }
        E(acc, cur, wr, wc, fr, fq);
        if (!has_next) break;
#pragma unroll
        for (int a = 0; a < 2; ++a)
#pragma unroll
            for (int b = 0; b < 2; ++b)
#pragma unroll
                for (int m = 0; m < 4; ++m)
#pragma unroll
                    for (int n = 0; n < 2; ++n) acc[a][b][m][n] = (f32x4){0.f, 0.f, 0.f, 0.f};
        cur = nxt; cA = nA; cB = nB; ++ui;
    }
    PG8_WAIT_V(0);
    if (wr == 0) PG8_BAR;
    PG8_BAR;
#undef PG8_SA
#undef PG8_SB
#undef PG8_STAGE
#undef PG8_LDA
#undef PG8_LDB
#undef PG8_MMA
#undef PG8_WAIT_V
#undef PG8_WAIT_L
#undef PG8_BAR
#undef PG8_SCHED
}
}

typedef f32x4 AccT[2][2][4][2];

__device__ __forceinline__ f32x4 ldg4(const void* base, unsigned off) { return *(const f32x4*)((const char*)base + off); }
__device__ __forceinline__ void stg4(void* base, unsigned off, f32x4 v) { *(f32x4*)((char*)base + off) = v; }
__device__ __forceinline__ void stg2(void* base, unsigned off, u32x2 v) { *(u32x2*)((char*)base + off) = v; }
__device__ __forceinline__ void stf2(void* base, unsigned off, f32x2 v) { *(f32x2*)((char*)base + off) = v; }
__device__ __forceinline__ void stf1(void* base, unsigned off, float v) { *(float*)((char*)base + off) = v; }
__device__ __forceinline__ u32x2 pack4(f32x4 z) { u32x2 w; w.x = cvt_pk_bf16(z[0], z[1]); w.y = cvt_pk_bf16(z[2], z[3]); return w; }
constexpr unsigned CO[2][2] = {{0u, 16u}, {128u, 144u}};

struct EpiIn {
    const float* ssq1; const float* shw; bf16_t* A; bf16_t* U; bf16_t* GV; float* stv;
    __device__ __forceinline__ void operator()(const AccT& acc, const pg8::Unit& u, int wr, int wc, int fr, int fq) const {
        const int rowu = u.pm * 256 + wr * 64;
        const unsigned colb = (unsigned)(u.pn * 256 + wc * 32 + 4 * fq), rowb = (unsigned)(rowu + fr);
        bf16_t* const dbase = u.pn < 2 ? A : (u.pn < 4 ? U - 512 : GV - 1024);
#pragma unroll
        for (int ai = 0; ai < 2; ++ai) {
            const float* bias = shw + (size_t)batch_of(rowu + ai * 128) * DIN;
            f32x4 pp[4], bv[2][2];
#pragma unroll
            for (int m = 0; m < 4; ++m) pp[m] = ldg4(ssq1, ((rowb + ai * 128 + m * 16) * 16 + fq * 4) * 4);
#pragma unroll
            for (int bj = 0; bj < 2; ++bj)
#pragma unroll
                for (int n = 0; n < 2; ++n) bv[bj][n] = ldg4(bias, (colb + CO[bj][n]) * 4);
            float rstd[4], s1[4], s2[4];
#pragma unroll
            for (int m = 0; m < 4; ++m) { const f32x4 p = pp[m]; rstd[m] = rsqrtf(quad_row_sum((p[0] + p[1]) + (p[2] + p[3])) * (1.0f / D) + EPS); }
#pragma unroll
            for (int m = 0; m < 4; ++m) {
                const unsigned row = rowb + ai * 128 + m * 16;
                float t1 = 0.f, t2 = 0.f;
#pragma unroll
                for (int bj = 0; bj < 2; ++bj)
#pragma unroll
                    for (int n = 0; n < 2; ++n) {
                        f32x4 z = acc[ai][bj][m][n] * rstd[m] + bv[bj][n];
                        if (u.pn >= 2) z = gelu4(z);
                        if (u.pn >= 4) { t1 += (z[0] + z[1]) + (z[2] + z[3]); t2 += (z[0] * z[0] + z[1] * z[1]) + (z[2] * z[2] + z[3] * z[3]); }
                        stg2(dbase, (row * 512 + colb + CO[bj][n]) * 2, pack4(z));
                    }
                s1[m] = t1; s2[m] = t2;
            }
            if (u.pn >= 4) {
#pragma unroll
                for (int m = 0; m < 4; ++m) {
                    const float a = quad_row_sum(s1[m]), b = quad_row_sum(s2[m]);
                    if (fq == 0) stf2(stv, ((rowb + ai * 128 + m * 16) * 16 + ((u.pn - 4) * 4 + wc) * 2) * 4, (f32x2){a, b});
                }
            }
        }
    }
};
struct EpiRes {
    const float* xp; const float* xs; const float* xres_in;
    float* xres; const float* gate;
    const float* gnext; const float* scnext;
    bf16_t* XG; float* ssq;
    __device__ __forceinline__ void operator()(const AccT& acc, const pg8::Unit& u, int wr, int wc, int fr, int fq) const {
        const int rowu = u.pm * 256 + wr * 64;
        const unsigned colb = (unsigned)(u.pn * 256 + wc * 32 + 4 * fq), rowb = (unsigned)(rowu + fr);
        const float* const xin = xres_in ? xres_in : (u.pm >= MP / 256 ? xs - (size_t)MP * D : xp);
        float ssr[8];
        f32x4 gt[2][2], gm[2][2];
        f32x4 ring[3][2][2];
        int bcur = -1;
#define ER_LOADROW(r_, slot_) do { const unsigned ro_ = (rowb + ((r_) >> 2) * 128 + ((r_) & 3) * 16) * D + colb; \
            _Pragma("unroll") for (int bj = 0; bj < 2; ++bj) _Pragma("unroll") for (int n = 0; n < 2; ++n) ring[slot_][bj][n] = ldg4(xin, (ro_ + CO[bj][n]) * 4); } while (0)
#pragma unroll
        for (int r = 0; r < 8; ++r) {
            const int ai = r >> 2, m = r & 3; const unsigned row = rowb + ai * 128 + m * 16;
            if (r == 0 || r == 4) {
                const int b = batch_of(rowu + ai * 128);
                if (b != bcur) {
                    bcur = b;
#pragma unroll
                    for (int bj = 0; bj < 2; ++bj)
#pragma unroll
                        for (int n = 0; n < 2; ++n) {
                            const unsigned co = (colb + CO[bj][n]) * 4;
                            gt[bj][n] = ldg4(gate + (size_t)b * NMOD, co);
                            if (gnext) gm[bj][n] = ldg4(gnext, co) * (ldg4(scnext + (size_t)b * NMOD, co) + 1.0f);
                            else gm[bj][n] = (f32x4){0.f, 0.f, 0.f, 0.f};
                        }
                }
            }
            if (r == 0) { ER_LOADROW(0, 0); ER_LOADROW(1, 1); }
            if (r + 2 < 8) ER_LOADROW(r + 2, (r + 2) % 3);
            float ss = 0.f;
#pragma unroll
            for (int bj = 0; bj < 2; ++bj)
#pragma unroll
                for (int n = 0; n < 2; ++n) {
                    const unsigned eo = row * D + colb + CO[bj][n];
                    const f32x4 x1 = ring[r % 3][bj][n] + gt[bj][n] * acc[ai][bj][m][n];
                    stg4(xres, eo * 4, x1);
                    ss += (x1[0] * x1[0] + x1[1] * x1[1]) + (x1[2] * x1[2] + x1[3] * x1[3]);
                    if (gnext) stg2(XG, eo * 2, pack4(x1 * gm[bj][n]));
                }
            ssr[r] = ss;
        }
#undef ER_LOADROW
#pragma unroll
        for (int r = 0; r < 8; ++r) { const float t = quad_row_sum(ssr[r]); if (fq == 0) stf1(ssq, ((rowb + (r >> 2) * 128 + (r & 3) * 16) * 16 + u.pn * 4 + wc) * 4, t); }
    }
};
struct EpiFf1 {
    const float* ssq2; const float* shw; bf16_t* F1;
    __device__ __forceinline__ void operator()(const AccT& acc, const pg8::Unit& u, int wr, int wc, int fr, int fq) const {
        const int rowu = u.pm * 256 + wr * 64;
        const unsigned colb = (unsigned)(u.pn * 256 + wc * 32 + 4 * fq), rowb = (unsigned)(rowu + fr);
#pragma unroll
        for (int ai = 0; ai < 2; ++ai) {
            const float* bias = shw + (size_t)batch_of(rowu + ai * 128) * DFF;
            f32x4 pp[4], bv[2][2];
#pragma unroll
            for (int m = 0; m < 4; ++m) pp[m] = ldg4(ssq2, ((rowb + ai * 128 + m * 16) * 16 + fq * 4) * 4);
#pragma unroll
            for (int bj = 0; bj < 2; ++bj)
#pragma unroll
                for (int n = 0; n < 2; ++n) bv[bj][n] = ldg4(bias, (colb + CO[bj][n]) * 4);
            float rstd[4];
#pragma unroll
            for (int m = 0; m < 4; ++m) { const f32x4 p = pp[m]; rstd[m] = rsqrtf(quad_row_sum((p[0] + p[1]) + (p[2] + p[3])) * (1.0f / D) + EPS); }
#pragma unroll
            for (int m = 0; m < 4; ++m) {
                const unsigned row = rowb + ai * 128 + m * 16;
#pragma unroll
                for (int bj = 0; bj < 2; ++bj)
#pragma unroll
                    for (int n = 0; n < 2; ++n) {
                        f32x4 z = acc[ai][bj][m][n] * rstd[m] + bv[bj][n];
                        z = __builtin_elementwise_max(z, (f32x4){0.f, 0.f, 0.f, 0.f}); z = z * z;
                        stg2(F1, (row * DFF + colb + CO[bj][n]) * 2, pack4(z));
                    }
            }
        }
    }
};

typedef const __attribute__((address_space(4))) Params* KArgs;
__device__ __forceinline__ KArgs kargs() { KArgs k = (KArgs)__builtin_amdgcn_kernarg_segment_ptr(); asm volatile("" : "+s"(k)); return k; }
struct Ctx {
    KArgs k;
    LAS unsigned char* lds; int tid, lane, wid, G, bx;
};

__device__ __forceinline__ void gemv24_unit(const Ctx& c, int mode, const float* vsrc, int vstride, const float* W, int ldw, int n0, const float* bias, float* out, int ldo) {
    LAS float* tbl = (LAS float*)c.lds;
    __syncthreads();
    for (int i = c.tid; i < NBT * D; i += NTHREADS) {
        const int b = i >> 10, k = i & 1023; float v;
        if (mode == 0) { const float x = b < NBP ? c.k->in[I_CP][b * D + k] : c.k->in[I_CS][(b - NBP) * D + k]; v = x / (1.0f + __expf(-x)); }
        else v = vsrc[(size_t)b * vstride + k];
        tbl[k * NBT + b] = v;
    }
    __syncthreads();
    const int ks = c.tid >> 6, j = c.tid & 63;
    float acc[NBT];
#pragma unroll
    for (int b = 0; b < NBT; ++b) acc[b] = 0.f;
    const float* wp = W + (size_t)(ks * 128) * ldw + n0 + j;
#pragma unroll 4
    for (int kk = 0; kk < 128; ++kk) {
        const float w = wp[(size_t)kk * ldw];
        const LAS f32x4* t4 = (const LAS f32x4*)(tbl + (ks * 128 + kk) * NBT);
#pragma unroll
        for (int q = 0; q < 6; ++q) { const f32x4 t = t4[q]; acc[4 * q + 0] += t[0] * w; acc[4 * q + 1] += t[1] * w; acc[4 * q + 2] += t[2] * w; acc[4 * q + 3] += t[3] * w; }
    }
    __syncthreads();
    LAS float* red = (LAS float*)c.lds;
#pragma unroll
    for (int b = 0; b < NBT; ++b) red[(ks * NBT + b) * 64 + j] = acc[b];
    __syncthreads();
    for (int o = c.tid; o < NBT * 64; o += NTHREADS) {
        const int b = o >> 6, jj = o & 63; float s = bias ? bias[n0 + jj] : 0.f;
#pragma unroll
        for (int q = 0; q < 8; ++q) s += red[(q * NBT + b) * 64 + jj];
        out[(size_t)b * ldo + n0 + jj] = s;
    }
}
__device__ __forceinline__ void transpose_unit(const Ctx& c, const float* W, int K, int N, int k0, int n0, bf16_t* Wt, const float* nscale) {
    LAS float* tile = (LAS float*)c.lds;
    __syncthreads();
    { const int r = c.tid >> 4, c4 = c.tid & 15;
#pragma unroll
      for (int i = 0; i < 2; ++i) { const int kk = r + 32 * i; const f32x4 v = *(const f32x4*)(W + (size_t)(k0 + kk) * N + n0 + c4 * 4);
          tile[kk * 65 + c4 * 4 + 0] = v[0]; tile[kk * 65 + c4 * 4 + 1] = v[1]; tile[kk * 65 + c4 * 4 + 2] = v[2]; tile[kk * 65 + c4 * 4 + 3] = v[3]; } }
    __syncthreads();
    { const int nn = c.tid >> 3, k8 = c.tid & 7; const float s = nscale ? nscale[n0 + nn] : 1.0f; float f[8];
#pragma unroll
      for (int j = 0; j < 8; ++j) f[j] = tile[(k8 * 8 + j) * 65 + nn] * s;
      u32x4 w; w.x = cvt_pk_bf16(f[0], f[1]); w.y = cvt_pk_bf16(f[2], f[3]); w.z = cvt_pk_bf16(f[4], f[5]); w.w = cvt_pk_bf16(f[6], f[7]);
      *(u32x4*)(Wt + (size_t)(n0 + nn) * K + k0 + k8 * 8) = w; }
}

constexpr int NU_MOD = DEPTH * (NMOD / 64);
constexpr int T_IN = 16 * 24, T_OUT = 16 * 16, T_F1 = 16 * 64, T_F2 = 64 * 16, T_LAYER = T_IN + T_OUT + T_F1 + T_F2;
constexpr int NU_TR = DEPTH * T_LAYER, NU_WP = DEPTH * 4 * 4, NU_WS = DEPTH * 4 * 4;
constexpr int NU_I0 = NU_MOD + NU_TR + NU_WP + NU_WS;
__device__ void phase_init0(const Ctx& c) {
    float* mod = (float*)(c.k->ws + WS_MOD);
    for (int u = c.bx; u < NU_I0; u += c.G) {
        if (u < NU_MOD) {
            const int l = u / (NMOD / 64), nb = u % (NMOD / 64);
            gemv24_unit(c, 0, nullptr, 0, c.k->in[I_WADA] + (size_t)l * D * NMOD, NMOD, nb * 64, c.k->in[I_BADA] + (size_t)l * NMOD, mod + (size_t)l * NBT * NMOD, NMOD);
        } else if (u < NU_MOD + NU_TR) {
            const int v = u - NU_MOD, l = v / T_LAYER; int r = v % T_LAYER;
            if (r < T_IN) transpose_unit(c, c.k->in[I_WIN] + (size_t)l * D * DIN, D, DIN, (r / 24) * 64, (r % 24) * 64, (bf16_t*)(c.k->ws + WS_WIN_T) + (size_t)l * DIN * D, nullptr);
            else if ((r -= T_IN) < T_OUT) transpose_unit(c, c.k->in[I_WOUT] + (size_t)l * D * D, D, D, (r / 16) * 64, (r % 16) * 64, (bf16_t*)(c.k->ws + WS_WOUT_T) + (size_t)l * D * D, nullptr);
            else if ((r -= T_OUT) < T_F1) transpose_unit(c, c.k->in[I_W1] + (size_t)l * D * DFF, D, DFF, (r / 64) * 64, (r % 64) * 64, (bf16_t*)(c.k->ws + WS_W1_T) + (size_t)l * DFF * D, nullptr);
            else { r -= T_F1; transpose_unit(c, c.k->in[I_W2] + (size_t)l * DFF * D, DFF, D, (r / 16) * 64, (r % 16) * 64, (bf16_t*)(c.k->ws + WS_W2_T) + (size_t)l * D * DFF, nullptr); }
        } else if (u < NU_MOD + NU_TR + NU_WP) {
            const int v = u - NU_MOD - NU_TR, lg = v >> 2, t = v & 3, l = lg >> 2, g = lg & 3;
            transpose_unit(c, c.k->in[I_WPOOL] + (size_t)lg * 128 * 128, 128, 128, (t >> 1) * 64, (t & 1) * 64, (bf16_t*)(c.k->ws + WS_WP_T) + (size_t)lg * 128 * 128, c.k->in[I_PSCALE] + l * PW + g * 128);
        } else {
            const int v = u - NU_MOD - NU_TR - NU_WP, lh = v >> 2, t = v & 3, t0 = (t >> 1) * 64, s0 = (t & 1) * 64;
            const int tt = t0 + (c.tid >> 3), s8 = s0 + (c.tid & 7) * 8;
            const float* src = c.k->in[I_WSP] + ((size_t)lh * 128 + tt) * 128 + s8;
            const f32x4 a = *(const f32x4*)src, b = *(const f32x4*)(src + 4);
            float f[8] = {a[0], a[1], a[2], a[3], b[0], b[1], b[2], b[3]};
#pragma unroll
            for (int j = 0; j < 8; ++j) if (s8 + j > tt) f[j] = 0.f;
            u32x4 w; w.x = cvt_pk_bf16(f[0], f[1]); w.y = cvt_pk_bf16(f[2], f[3]); w.z = cvt_pk_bf16(f[4], f[5]); w.w = cvt_pk_bf16(f[6], f[7]);
            *(u32x4*)((bf16_t*)(c.k->ws + WS_WSP) + ((size_t)lh * 128 + tt) * 128 + s8) = w;
        }
    }
}
constexpr int NU_SH_L = DIN / 64 + DFF / 64;
__device__ void phase_init1(const Ctx& c) {
    const float* mod = (const float*)(c.k->ws + WS_MOD);
    for (int u = c.bx; u < DEPTH * NU_SH_L; u += c.G) {
        const int l = u / NU_SH_L, r = u % NU_SH_L;
        const float* ml = mod + (size_t)l * NBT * NMOD;
        if (r < DIN / 64) gemv24_unit(c, 1, ml + 0 * D, NMOD, c.k->in[I_WIN] + (size_t)l * D * DIN, DIN, r * 64, nullptr, (float*)(c.k->ws + WS_SHWIN) + (size_t)l * NBT * DIN, DIN);
        else gemv24_unit(c, 1, ml + 3 * D, NMOD, c.k->in[I_W1] + (size_t)l * D * DFF, DFF, (r - DIN / 64) * 64, nullptr, (float*)(c.k->ws + WS_SHW1) + (size_t)l * NBT * DFF, DFF);
    }
    bf16_t* XG = (bf16_t*)(c.k->ws + WS_XG); float* ssq1 = (float*)(c.k->ws + WS_SSQ1);
    const float* gm = c.k->in[I_GMIX];
    for (int rg = c.bx; rg < MT / 32; rg += c.G) {
        const int rowb = rg * 32 + c.wid * 4, b = batch_of(rowb);
        const float* sc = mod + (size_t)b * NMOD + 1 * D;
        f32x4 x[4][4], gmul[4];
#pragma unroll
        for (int r = 0; r < 4; ++r) { const int row = rowb + r;
            const float* xr = row < MP ? c.k->in[I_XP] + (size_t)row * D : c.k->in[I_XS] + (size_t)(row - MP) * D;
#pragma unroll
            for (int i = 0; i < 4; ++i) x[r][i] = *(const f32x4*)(xr + i * 256 + c.lane * 4); }
#pragma unroll
        for (int i = 0; i < 4; ++i) { const int k = i * 256 + c.lane * 4; gmul[i] = *(const f32x4*)(gm + k) * (*(const f32x4*)(sc + k) + 1.0f); }
#pragma unroll
        for (int r = 0; r < 4; ++r) {
            float ss = 0.f;
#pragma unroll
            for (int i = 0; i < 4; ++i) { const f32x4 v = x[r][i]; ss += (v[0] * v[0] + v[1] * v[1]) + (v[2] * v[2] + v[3] * v[3]);
                *(u32x2*)(XG + (size_t)(rowb + r) * D + i * 256 + c.lane * 4) = pack4(v * gmul[i]); }
            ss = wave_sum(ss);
            if (c.lane < 16) ssq1[(size_t)(rowb + r) * 16 + c.lane] = c.lane == 0 ? ss : 0.f;
        }
    }
}
constexpr int TP = 272;
__device__ __forceinline__ void unpack8(u32x4 v, float* f) { f[0] = bflo(v.x); f[1] = bfhi(v.x); f[2] = bflo(v.y); f[3] = bfhi(v.y); f[4] = bflo(v.z); f[5] = bfhi(v.z); f[6] = bflo(v.w); f[7] = bfhi(v.w); }
__device__ __forceinline__ u32x4 pack8(const float* f) { u32x4 w; w.x = cvt_pk_bf16(f[0], f[1]); w.y = cvt_pk_bf16(f[2], f[3]); w.z = cvt_pk_bf16(f[4], f[5]); w.w = cvt_pk_bf16(f[6], f[7]); return w; }
__device__ void phase_mixer(const Ctx& c, int l) {
    LAS unsigned char* tA = c.lds; LAS unsigned char* tB = c.lds + 128 * TP; LAS unsigned char* tX = c.lds + 256 * TP;
    unsigned char* ws = c.k->ws; float* outp = c.k->out;
    const bf16_t* Ab = (const bf16_t*)(ws + WS_A); const bf16_t* Ub = (const bf16_t*)(ws + WS_U); const bf16_t* GVb = (const bf16_t*)(ws + WS_GV);
    bf16_t* CAT = (bf16_t*)(ws + WS_CAT); const float* stv = (const float*)(ws + WS_STV);
    const bf16_t* WpT = (const bf16_t*)(ws + WS_WP_T) + (size_t)l * 4 * 128 * 128;
    const bf16_t* Wsp = (const bf16_t*)(ws + WS_WSP) + (size_t)l * 4 * 128 * 128;
    const int lane = c.lane, wid = c.wid, i15 = lane & 15, kq = lane >> 4, c8 = c.tid & 15, r0 = c.tid >> 4;
    constexpr int NCH = MP / 128 + NBS;
    for (int u = c.bx; u < NCH * 8; u += c.G) {
        const int ct = u >> 3, j = u & 7;
        const bool samp = ct >= MP / 128;
        const int sb = ct - MP / 128;
        const int row0 = samp ? MP + sb * DSEQ : ct * 128, nrows = samp ? DSEQ : 128, bm = samp ? NBP + sb : (ct >> 5), tseq0 = samp ? SEQ : (ct & 31) * 128;
        const int ntb = nrows >> 4;
        bf16_t* const cbase = CAT + (size_t)row0 * D + (j < 4 ? j * 128 : 512 + (j - 4) * 128) + 16 * wid + 4 * kq;
        __syncthreads();
        if (j < 4) {
            const int g = j, w = 2 << g;
            {
                u32x4 wv[4], xv[5];
#pragma unroll
                for (int i = 0; i < 4; ++i) wv[i] = *(const u32x4*)(WpT + ((size_t)g * 128 + r0 + 32 * i) * 128 + c8 * 8);
                const bf16_t* ap = Ab + (size_t)row0 * PW + g * 128 + c8 * 8;
#pragma unroll
                for (int i = 0; i < 5; ++i) {
                    const int rr = r0 + 32 * i, t = rr - 15;
                    xv[i] = (u32x4){0u, 0u, 0u, 0u};
                    if (rr < 143 && t < nrows) {
                        if (t >= 0 || (!samp && tseq0 > 0)) xv[i] = *(const u32x4*)(ap + (ptrdiff_t)t * PW);
                        else if (samp) { const float* sp = c.k->in[I_SPOOL] + (((size_t)l * NBS + sb) * 15 + rr) * PW + g * 128 + c8 * 8;
                            const f32x4 p0 = *(const f32x4*)sp, p1 = *(const f32x4*)(sp + 4);
                            xv[i].x = cvt_pk_bf16(p0[0], p0[1]); xv[i].y = cvt_pk_bf16(p0[2], p0[3]); xv[i].z = cvt_pk_bf16(p1[0], p1[1]); xv[i].w = cvt_pk_bf16(p1[2], p1[3]); }
                    }
                }
#pragma unroll
                for (int i = 0; i < 4; ++i) *(LAS u32x4*)(tB + (r0 + 32 * i) * TP + c8 * 16) = wv[i];
#pragma unroll
                for (int i = 0; i < 5; ++i) { const int rr = r0 + 32 * i; if (rr < 143) *(LAS u32x4*)(tX + rr * TP + c8 * 16) = xv[i]; }
            }
            __syncthreads();
#pragma unroll 1
            for (int i = 0; i < 4; ++i) {
                const int t = r0 + 32 * i;
                if (t < nrows) {
                    const LAS unsigned char* xp0 = tX + (t + 15) * TP + c8 * 16;
                    float a0[8], s[8], tmp[8];
                    unpack8(*(const LAS u32x4*)xp0, a0);
#pragma unroll
                    for (int k = 0; k < 8; ++k) s[k] = a0[k];
#pragma unroll 2
                    for (int jj = 1; jj < w; ++jj) { unpack8(*(const LAS u32x4*)(xp0 - jj * TP), tmp);
#pragma unroll
                        for (int k = 0; k < 8; ++k) s[k] += tmp[k]; }
                    const int pos1 = tseq0 + t + 1; const float inv = 1.0f / (float)(pos1 < w ? pos1 : w);
                    float dd[8];
#pragma unroll
                    for (int k = 0; k < 8; ++k) dd[k] = s[k] * inv - a0[k];
                    *(LAS u32x4*)(tA + t * TP + c8 * 16) = pack8(dd);
                    float* so = nullptr;
                    if (!samp && (ct & 31) == 31 && t >= 113) so = outp + OUT_SPP + (((size_t)l * NBP + bm) * 15 + (t - 113)) * PW + g * 128 + c8 * 8;
                    if (samp && t >= 49) so = outp + OUT_SPS + (((size_t)l * NBS + sb) * 15 + (t - 49)) * PW + g * 128 + c8 * 8;
                    if (so) { *(f32x4*)so = (f32x4){a0[0], a0[1], a0[2], a0[3]}; *(f32x4*)(so + 4) = (f32x4){a0[4], a0[5], a0[6], a0[7]}; }
                }
            }
            __syncthreads();
            f32x4 acc[8];
#pragma unroll
            for (int tb = 0; tb < 8; ++tb) acc[tb] = (f32x4){0.f, 0.f, 0.f, 0.f};
#pragma unroll
            for (int kk = 0; kk < 4; ++kk) {
                const bf16x8 bf = *(const LAS bf16x8*)(tB + (16 * wid + i15) * TP + kk * 64 + kq * 16);
#pragma unroll
                for (int tb = 0; tb < 8; ++tb) if (tb < ntb) {
                    const bf16x8 af = *(const LAS bf16x8*)(tA + (16 * tb + i15) * TP + kk * 64 + kq * 16);
                    acc[tb] = __builtin_amdgcn_mfma_f32_16x16x32_bf16(bf, af, acc[tb], 0, 0, 0); }
            }
#pragma unroll
            for (int tb = 0; tb < 8; ++tb) if (tb < ntb) *(u32x2*)(cbase + (size_t)(16 * tb + i15) * D) = pack4(acc[tb]);
        } else {
            const int h = j - 4;
            u32x2 uu[8]; float bsv[8];
            {
                u32x4 wv[4], gvv[4]; float sv[4];
#pragma unroll
                for (int i = 0; i < 4; ++i) wv[i] = *(const u32x4*)(Wsp + ((size_t)h * 128 + r0 + 32 * i) * 128 + c8 * 8);
#pragma unroll
                for (int i = 0; i < 4; ++i) {
                    const int sr = r0 + 32 * i; gvv[i] = (u32x4){0u, 0u, 0u, 0u}; sv[i] = 0.f;
                    if (sr < nrows) { const int row = row0 + sr; gvv[i] = *(const u32x4*)(GVb + (size_t)row * SW + h * 128 + c8 * 8); sv[i] = stv[(size_t)row * 16 + c8]; }
                }
                const float* vg = c.k->in[I_VG] + l * SW + h * 128 + c8 * 8; const float* vb = c.k->in[I_VB] + l * SW + h * 128 + c8 * 8;
                const f32x4 g0 = *(const f32x4*)vg, g1 = *(const f32x4*)(vg + 4), b0 = *(const f32x4*)vb, b1 = *(const f32x4*)(vb + 4);
#pragma unroll
                for (int tb = 0; tb < 8; ++tb) { uu[tb] = (u32x2){0u, 0u}; bsv[tb] = 0.f;
                    if (tb < ntb) { uu[tb] = *(const u32x2*)(Ub + (size_t)(row0 + 16 * tb + i15) * SW + h * 128 + 16 * wid + 4 * kq);
                                    bsv[tb] = c.k->in[I_BSP][((size_t)l * 4 + h) * 128 + 16 * tb + i15]; } }
#pragma unroll
                for (int i = 0; i < 4; ++i) *(LAS u32x4*)(tA + (r0 + 32 * i) * TP + c8 * 16) = wv[i];
#pragma unroll
                for (int i = 0; i < 4; ++i) {
                    const int sr = r0 + 32 * i;
                    float sx = sv[i]; sx += __shfl_xor(sx, 2); sx += __shfl_xor(sx, 4); sx += __shfl_xor(sx, 8);
                    const float so_ = __shfl_xor(sx, 1);
                    const float sum = (c8 & 1) ? so_ : sx, sq = (c8 & 1) ? sx : so_;
                    u32x4 outv = (u32x4){0u, 0u, 0u, 0u};
                    if (sr < nrows) {
                        float gvf[8]; unpack8(gvv[i], gvf);
                        const float mean = sum * (1.0f / SW); float var = sq * (1.0f / SW) - mean * mean; var = var < 0.f ? 0.f : var;
                        const float rstd = rsqrtf(var + EPS);
                        float vl[8];
#pragma unroll
                        for (int k = 0; k < 4; ++k) { vl[k] = (gvf[k] - mean) * rstd * g0[k] + b0[k]; vl[4 + k] = (gvf[4 + k] - mean) * rstd * g1[k] + b1[k]; }
                        if (samp) { float* so = outp + OUT_SV + (((size_t)l * NBS + sb) * DSEQ + sr) * SW + h * 128 + c8 * 8;
                            *(f32x4*)so = (f32x4){vl[0], vl[1], vl[2], vl[3]}; *(f32x4*)(so + 4) = (f32x4){vl[4], vl[5], vl[6], vl[7]}; }
                        outv = pack8(vl);
                    }
                    *(LAS u32x4*)(tB + sr * TP + c8 * 16) = outv;
                }
            }
            __syncthreads();
            f32x4 acc[8];
#pragma unroll
            for (int tb = 0; tb < 8; ++tb) acc[tb] = (f32x4){0.f, 0.f, 0.f, 0.f};
            const int q = i15 >> 2, p = lane & 3;
#pragma unroll
            for (int kk = 0; kk < 4; ++kk) {
                LAS unsigned char* vp = tB + (32 * kk + 8 * kq + q) * TP + (16 * wid + 4 * p) * 2;
                const s16x4 lo = __builtin_amdgcn_ds_read_tr16_b64_v4i16((LAS s16x4*)vp);
                const s16x4 hi = __builtin_amdgcn_ds_read_tr16_b64_v4i16((LAS s16x4*)(vp + 4 * TP));
                const bf16x8 vf = __builtin_shufflevector(lo, hi, 0, 1, 2, 3, 4, 5, 6, 7);
#pragma unroll
                for (int tb = 0; tb < 8; ++tb) if (tb >= 2 * kk && tb < ntb) {
                    const bf16x8 af = *(const LAS bf16x8*)(tA + (16 * tb + i15) * TP + kk * 64 + kq * 16);
                    acc[tb] = __builtin_amdgcn_mfma_f32_16x16x32_bf16(vf, af, acc[tb], 0, 0, 0); }
            }
#pragma unroll
            for (int tb = 0; tb < 8; ++tb) if (tb < ntb) {
                f32x4 o = acc[tb]; const u32x2 w2 = uu[tb]; const float bs = bsv[tb];
                o = (f32x4){bflo(w2.x) * (o[0] + bs), bfhi(w2.x) * (o[1] + bs), bflo(w2.y) * (o[2] + bs), bfhi(w2.y) * (o[3] + bs)};
                *(u32x2*)(cbase + (size_t)(16 * tb + i15) * D) = pack4(o);
            }
        }
    }
}
template <class Epi>
__device__ __forceinline__ void sample_gemm(const Ctx& c, const bf16_t* A, int lda, const bf16_t* Bt, int ldb, int N, int K, const Epi& E) {
    LAS unsigned char* tA = c.lds; LAS unsigned char* tB = c.lds + 128 * TP; LAS float* red = (LAS float*)(c.lds + 256 * TP);
    const int lane = c.lane, wid = c.wid, i15 = lane & 15, kq = lane >> 4, c8 = c.tid & 15, r0 = c.tid >> 4;
    const int ntn = N >> 7, ntiles = NBS * ntn, nks = K >> 7;
    for (int tile = c.bx; tile < ntiles; tile += c.G) {
        const int sb = tile / ntn, n0 = (tile - sb * ntn) * 128;
        const bf16_t* ap = A + (size_t)(MP + sb * DSEQ + r0) * lda + c8 * 8;
        const bf16_t* bp = Bt + (size_t)(n0 + r0) * ldb + c8 * 8;
        u32x4 ra[2], rb[4];
#pragma unroll
        for (int i = 0; i < 2; ++i) ra[i] = *(const u32x4*)(ap + (size_t)(32 * i) * lda);
#pragma unroll
        for (int i = 0; i < 4; ++i) rb[i] = *(const u32x4*)(bp + (size_t)(32 * i) * ldb);
        f32x4 acc[4];
#pragma unroll
        for (int tb = 0; tb < 4; ++tb) acc[tb] = (f32x4){0.f, 0.f, 0.f, 0.f};
#pragma unroll 1
        for (int ks = 0; ks < nks; ++ks) {
            __syncthreads();
#pragma unroll
            for (int i = 0; i < 2; ++i) *(LAS u32x4*)(tA + (r0 + 32 * i) * TP + c8 * 16) = ra[i];
#pragma unroll
            for (int i = 0; i < 4; ++i) *(LAS u32x4*)(tB + (r0 + 32 * i) * TP + c8 * 16) = rb[i];
            __syncthreads();
            if (ks + 1 < nks) {
#pragma unroll
                for (int i = 0; i < 2; ++i) ra[i] = *(const u32x4*)(ap + (size_t)(32 * i) * lda + (ks + 1) * 128);
#pragma unroll
                for (int i = 0; i < 4; ++i) rb[i] = *(const u32x4*)(bp + (size_t)(32 * i) * ldb + (ks + 1) * 128);
            }
#pragma unroll
            for (int kk = 0; kk < 4; ++kk) {
                const bf16x8 bf = *(const LAS bf16x8*)(tB + (16 * wid + i15) * TP + kk * 64 + kq * 16);
#pragma unroll
                for (int tb = 0; tb < 4; ++tb) {
                    const bf16x8 af = *(const LAS bf16x8*)(tA + (16 * tb + i15) * TP + kk * 64 + kq * 16);
                    acc[tb] = __builtin_amdgcn_mfma_f32_16x16x32_bf16(bf, af, acc[tb], 0, 0, 0); }
            }
        }
        E(c, acc, sb, n0, red);
    }
    __syncthreads();
}
struct EpiInS {
    const float* ssq1; const float* shw; bf16_t* A; bf16_t* U; bf16_t* GV; float* stv;
    __device__ __forceinline__ void operator()(const Ctx& c, const f32x4 (&acc)[4], int sb, int n0, LAS float* red) const {
        const int i15 = c.lane & 15, kq = c.lane >> 4;
        const unsigned rowb = (unsigned)(MP + sb * DSEQ + i15), col = (unsigned)(n0 + 16 * c.wid + 4 * kq);
        f32x4 pp[4];
#pragma unroll
        for (int tb = 0; tb < 4; ++tb) pp[tb] = ldg4(ssq1, ((rowb + 16 * tb) * 16 + kq * 4) * 4);
        const f32x4 bv = ldg4(shw + (size_t)(NBP + sb) * DIN, col * 4);
        bf16_t* const dbase = n0 < 512 ? A : (n0 < 1024 ? U - 512 : GV - 1024);
        float s1[4], s2[4];
#pragma unroll
        for (int tb = 0; tb < 4; ++tb) {
            const f32x4 p = pp[tb]; const float rstd = rsqrtf(quad_row_sum((p[0] + p[1]) + (p[2] + p[3])) * (1.0f / D) + EPS);
            f32x4 z = acc[tb] * rstd + bv;
            if (n0 >= 512) z = gelu4(z);
            s1[tb] = (z[0] + z[1]) + (z[2] + z[3]); s2[tb] = (z[0] * z[0] + z[1] * z[1]) + (z[2] * z[2] + z[3] * z[3]);
            stg2(dbase, ((rowb + 16 * tb) * 512 + col) * 2, pack4(z));
        }
        if (n0 >= 1024) {
#pragma unroll
            for (int tb = 0; tb < 4; ++tb) { const float a = quad_row_sum(s1[tb]), b = quad_row_sum(s2[tb]);
                if (kq == 0) { red[(c.wid * 64 + 16 * tb + i15) * 2] = a; red[(c.wid * 64 + 16 * tb + i15) * 2 + 1] = b; } }
            __syncthreads();
            if (c.tid < 64) {
                float a = 0.f, b = 0.f;
#pragma unroll
                for (int w = 0; w < 8; ++w) { a += red[(w * 64 + c.tid) * 2]; b += red[(w * 64 + c.tid) * 2 + 1]; }
                float* dst = stv + (size_t)(MP + sb * DSEQ + c.tid) * 16;
                *(f32x2*)(dst + ((n0 - 1024) >> 7) * 2) = (f32x2){a, b};
                if (n0 == 1024) { *(f32x4*)(dst + 8) = (f32x4){0.f, 0.f, 0.f, 0.f}; *(f32x4*)(dst + 12) = (f32x4){0.f, 0.f, 0.f, 0.f}; }
            }
        }
    }
};
struct EpiResS {
    const float* xs; const float* xres_in; float* xres; const float* gate; const float* gnext; const float* scnext; bf16_t* XG; float* ssq;
    __device__ __forceinline__ void operator()(const Ctx& c, const f32x4 (&acc)[4], int sb, int n0, LAS float* red) const {
        const int i15 = c.lane & 15, kq = c.lane >> 4, b = NBP + sb;
        const unsigned rowb = (unsigned)(MP + sb * DSEQ + i15), col = (unsigned)(n0 + 16 * c.wid + 4 * kq);
        const float* const xin = xres_in ? xres_in : xs - (size_t)MP * D;
        f32x4 xv[4];
#pragma unroll
        for (int tb = 0; tb < 4; ++tb) xv[tb] = ldg4(xin, ((rowb + 16 * tb) * D + col) * 4);
        const f32x4 gt = ldg4(gate + (size_t)b * NMOD, col * 4);
        f32x4 gm = (f32x4){0.f, 0.f, 0.f, 0.f};
        if (gnext) gm = ldg4(gnext, col * 4) * (ldg4(scnext + (size_t)b * NMOD, col * 4) + 1.0f);
        float ss[4];
#pragma unroll
        for (int tb = 0; tb < 4; ++tb) {
            const unsigned eo = (rowb + 16 * tb) * D + col;
            const f32x4 x1 = xv[tb] + gt * acc[tb];
            stg4(xres, eo * 4, x1);
            ss[tb] = (x1[0] * x1[0] + x1[1] * x1[1]) + (x1[2] * x1[2] + x1[3] * x1[3]);
            if (gnext) stg2(XG, eo * 2, pack4(x1 * gm));
        }
#pragma unroll
        for (int tb = 0; tb < 4; ++tb) { const float a = quad_row_sum(ss[tb]); if (kq == 0) red[c.wid * 64 + 16 * tb + i15] = a; }
        __syncthreads();
        if (c.tid < 64) {
            float a = 0.f;
#pragma unroll
            for (int w = 0; w < 8; ++w) a += red[w * 64 + c.tid];
            float* dst = ssq + (size_t)(MP + sb * DSEQ + c.tid) * 16;
            dst[n0 >> 7] = a;
            if (n0 == 0) { *(f32x4*)(dst + 8) = (f32x4){0.f, 0.f, 0.f, 0.f}; *(f32x4*)(dst + 12) = (f32x4){0.f, 0.f, 0.f, 0.f}; }
        }
    }
};
struct EpiFf1S {
    const float* ssq2; const float* shw; bf16_t* F1;
    __device__ __forceinline__ void operator()(const Ctx& c, const f32x4 (&acc)[4], int sb, int n0, LAS float* red) const {
        const int i15 = c.lane & 15, kq = c.lane >> 4;
        const unsigned rowb = (unsigned)(MP + sb * DSEQ + i15), col = (unsigned)(n0 + 16 * c.wid + 4 * kq);
        f32x4 pp[4];
#pragma unroll
        for (int tb = 0; tb < 4; ++tb) pp[tb] = ldg4(ssq2, ((rowb + 16 * tb) * 16 + kq * 4) * 4);
        const f32x4 bv = ldg4(shw + (size_t)(NBP + sb) * DFF, col * 4);
#pragma unroll
        for (int tb = 0; tb < 4; ++tb) {
            const f32x4 p = pp[tb]; const float rstd = rsqrtf(quad_row_sum((p[0] + p[1]) + (p[2] + p[3])) * (1.0f / D) + EPS);
            f32x4 z = acc[tb] * rstd + bv;
            z = __builtin_elementwise_max(z, (f32x4){0.f, 0.f, 0.f, 0.f}); z = z * z;
            stg2(F1, ((rowb + 16 * tb) * DFF + col) * 2, pack4(z));
        }
    }
};
__device__ void phase_final(const Ctx& c) {
    const float* ssq1 = (const float*)(c.k->ws + WS_SSQ1); const float* gf = c.k->in[I_GFIN];
    f32x4 g[4];
#pragma unroll
    for (int i = 0; i < 4; ++i) g[i] = *(const f32x4*)(gf + i * 256 + c.lane * 4);
    for (int rg = c.bx; rg < MT / 32; rg += c.G) {
        const int rowb = rg * 32 + c.wid * 4;
        float* xr = c.k->out + OUT_Y + (size_t)rowb * D;
        f32x4 x[4][4];
        float p = ssq1[(size_t)rowb * 16 + c.lane];
#pragma unroll
        for (int r = 0; r < 4; ++r)
#pragma unroll
            for (int i = 0; i < 4; ++i) x[r][i] = *(const f32x4*)(xr + r * D + i * 256 + c.lane * 4);
        p += __shfl_xor(p, 1); p += __shfl_xor(p, 2); p += __shfl_xor(p, 4); p += __shfl_xor(p, 8);
#pragma unroll
        for (int r = 0; r < 4; ++r) {
            const float rstd = rsqrtf(__shfl(p, 16 * r) * (1.0f / D) + EPS);
#pragma unroll
            for (int i = 0; i < 4; ++i) *(f32x4*)(xr + r * D + i * 256 + c.lane * 4) = x[r][i] * rstd * g[i];
        }
    }
}

constexpr int NPHASE = 2 + 5 * DEPTH + 1;
__global__ void __launch_bounds__(NTHREADS, 2) mk_fwd(Params p) {
    __shared__ __attribute__((aligned(16))) unsigned char shm[pg8::STAGE_BYTES];
    cg::grid_group grid = cg::this_grid();
    Ctx c;
    c.k = kargs(); c.lds = (LAS unsigned char*)shm;
    c.tid = threadIdx.x; c.lane = c.tid & 63; c.wid = __builtin_amdgcn_readfirstlane(c.tid >> 6); c.G = gridDim.x; c.bx = blockIdx.x;
#ifndef PHMASK
#define PHMASK 0xffff
#endif
#define PHON(k) ((PHMASK >> (k)) & 1)
#ifndef DUPMASK
#define DUPMASK 0
#endif
#define DUPN(k) (((DUPMASK >> (k)) & 1) ? 2 : 1)
    for (int ph = p.ph_lo; ph < p.ph_hi; ++ph) {
        { int t_ = threadIdx.x; asm volatile("" : "+v"(t_)); c.tid = t_; c.lane = t_ & 63; c.wid = __builtin_amdgcn_readfirstlane(t_ >> 6); c.k = kargs(); }
        unsigned char* ws = c.k->ws;
        const float* mod = (const float*)(ws + WS_MOD);
        if (ph == 0) { for (int r_ = 0; r_ < DUPN(0); ++r_) phase_init0(c); }
        else if (ph == 1) { for (int r_ = 0; r_ < DUPN(1); ++r_) phase_init1(c); }
        else if (ph == NPHASE - 1) { if (PHON(7)) phase_final(c); }
        else {
            const int l = (ph - 2) / 5, s = (ph - 2) % 5;
            const float* modl = mod + (size_t)l * NBT * NMOD;
            pg8::StaticOrder S;
            if (s == 0 && PHON(2)) {
                pg8::Gemm g{(const bf16_t*)(ws + WS_XG), (const bf16_t*)(ws + WS_WIN_T) + (size_t)l * DIN * D, MP, DIN, D}; S.init(MP, DIN, c.G, c.bx);
                { EpiInS Es{(const float*)(ws + WS_SSQ1), (const float*)(ws + WS_SHWIN) + (size_t)l * NBT * DIN, (bf16_t*)(ws + WS_A), (bf16_t*)(ws + WS_U), (bf16_t*)(ws + WS_GV), (float*)(ws + WS_STV)};
                  sample_gemm<EpiInS>(c, g.A, D, g.Bt, D, DIN, D, Es); }
                EpiIn E{(const float*)(ws + WS_SSQ1), (const float*)(ws + WS_SHWIN) + (size_t)l * NBT * DIN, (bf16_t*)(ws + WS_A), (bf16_t*)(ws + WS_U), (bf16_t*)(ws + WS_GV), (float*)(ws + WS_STV)};
                for (int r_ = 0; r_ < DUPN(2); ++r_) pg8::gemm_phase<EpiIn>(c.lds, g, S, E);
            } else if (s == 1 && PHON(3)) {
                for (int r_ = 0; r_ < DUPN(3); ++r_) phase_mixer(c, l);
            } else if (s == 2 && PHON(4)) {
                pg8::Gemm g{(const bf16_t*)(ws + WS_CAT), (const bf16_t*)(ws + WS_WOUT_T) + (size_t)l * D * D, MP, D, D}; S.init(MP, D, c.G, c.bx);
                { EpiResS Es{c.k->in[I_XS], l == 0 ? nullptr : c.k->out + OUT_Y, c.k->out + OUT_Y, modl + 2 * D, c.k->in[I_GFFN] + l * D, modl + 4 * D, (bf16_t*)(ws + WS_XG), (float*)(ws + WS_SSQ2)};
                  sample_gemm<EpiResS>(c, g.A, D, g.Bt, D, D, D, Es); }
                EpiRes E{c.k->in[I_XP], c.k->in[I_XS], l == 0 ? nullptr : c.k->out + OUT_Y, c.k->out + OUT_Y, modl + 2 * D, c.k->in[I_GFFN] + l * D, modl + 4 * D, (bf16_t*)(ws + WS_XG), (float*)(ws + WS_SSQ2)};
                pg8::gemm_phase<EpiRes>(c.lds, g, S, E);
            } else if (s == 3 && PHON(5)) {
                pg8::Gemm g{(const bf16_t*)(ws + WS_XG), (const bf16_t*)(ws + WS_W1_T) + (size_t)l * DFF * D, MP, DFF, D}; S.init(MP, DFF, c.G, c.bx);
                { EpiFf1S Es{(const float*)(ws + WS_SSQ2), (const float*)(ws + WS_SHW1) + (size_t)l * NBT * DFF, (bf16_t*)(ws + WS_F1)};
                  sample_gemm<EpiFf1S>(c, g.A, D, g.Bt, D, DFF, D, Es); }
                EpiFf1 E{(const float*)(ws + WS_SSQ2), (const float*)(ws + WS_SHW1) + (size_t)l * NBT * DFF, (bf16_t*)(ws + WS_F1)};
                for (int r_ = 0; r_ < DUPN(5); ++r_) pg8::gemm_phase<EpiFf1>(c.lds, g, S, E);
            } else if (s == 4 && PHON(6)) {
                pg8::Gemm g{(const bf16_t*)(ws + WS_F1), (const bf16_t*)(ws + WS_W2_T) + (size_t)l * D * DFF, MP, D, DFF}; S.init(MP, D, c.G, c.bx);
                const bool more = (l + 1 < DEPTH);
                { EpiResS Es{c.k->in[I_XS], c.k->out + OUT_Y, c.k->out + OUT_Y, modl + 5 * D, more ? c.k->in[I_GMIX] + (l + 1) * D : nullptr, mod + (size_t)(more ? l + 1 : l) * NBT * NMOD + 1 * D,
                             (bf16_t*)(ws + WS_XG), (float*)(ws + WS_SSQ1)};
                  sample_gemm<EpiResS>(c, g.A, DFF, g.Bt, DFF, D, DFF, Es); }
                EpiRes E{c.k->in[I_XP], c.k->in[I_XS], c.k->out + OUT_Y, c.k->out + OUT_Y, modl + 5 * D, more ? c.k->in[I_GMIX] + (l + 1) * D : nullptr, mod + (size_t)(more ? l + 1 : l) * NBT * NMOD + 1 * D,
                         (bf16_t*)(ws + WS_XG), (float*)(ws + WS_SSQ1)};
                pg8::gemm_phase<EpiRes>(c.lds, g, S, E);
            }
        }
        if (ph + 1 < p.ph_hi) grid.sync();
    }
}

extern "C" void kernel_launch(void* const* d_in, const int* in_sizes, int n_in, void* d_out, int out_size, void* d_ws, size_t ws_size, hipStream_t stream) {
    static int grid_blocks = 0;
    if (!grid_blocks) {
        int dev = 0, cus = 0, per_cu = 0;
        hipGetDevice(&dev);
        hipDeviceGetAttribute(&cus, hipDeviceAttributeMultiprocessorCount, dev);
        hipOccupancyMaxActiveBlocksPerMultiprocessor(&per_cu, mk_fwd, NTHREADS, 0);
        if (per_cu < 1) per_cu = 1;
        if (per_cu > 1) per_cu = 1;
        grid_blocks = cus * per_cu;
        if (n_in != 20 || ws_size < WS_END) fprintf(stderr, "kernel_launch: unexpected n_in %d / ws_size %zu (need %zu)\n", n_in, ws_size, (size_t)WS_END);
    }
    Params p{};
    for (int i = 0; i < 20; ++i) p.in[i] = (const float*)d_in[i];
    p.out = (float*)d_out; p.ws = (unsigned char*)d_ws;
#if MK_SINGLE
    p.ph_lo = 0; p.ph_hi = NPHASE;
    { void* args[] = {&p};
      hipError_t e = hipLaunchCooperativeKernel((void*)mk_fwd, dim3(grid_blocks), dim3(NTHREADS), args, 0, stream);
      if (e != hipSuccess) fprintf(stderr, "cooperative launch failed: %s (grid %d)\n", hipGetErrorString(e), grid_blocks); }
#else
    for (int ph = 0; ph < NPHASE; ++ph) {
        p.ph_lo = ph; p.ph_hi = ph + 1;
        void* args[] = {&p};
        hipError_t e = hipLaunchCooperativeKernel((void*)mk_fwd, dim3(grid_blocks), dim3(NTHREADS), args, 0, stream);
        if (e != hipSuccess) { fprintf(stderr, "cooperative launch failed: %s (grid %d, phase %d)\n", hipGetErrorString(e), grid_blocks, ph); break; }
    }
#endif
}
```

```cpp
#include <hip/hip_runtime.h>
#include <hip/hip_cooperative_groups.h>
#include <cstdio>
namespace cg = cooperative_groups;

#ifndef MK_SINGLE
#define MK_SINGLE 1
#endif

#define LAS __attribute__((address_space(3)))
typedef unsigned short bf16_t;
typedef short bf16x8 __attribute__((ext_vector_type(8)));
typedef short s16x4 __attribute__((ext_vector_type(4)));
typedef float f32x4 __attribute__((ext_vector_type(4)));
typedef float f32x2 __attribute__((ext_vector_type(2)));
typedef unsigned u32x4 __attribute__((ext_vector_type(4)));
typedef unsigned u32x2 __attribute__((ext_vector_type(2)));

constexpr int D = 1024, NBP = 16, SEQ = 4096, MP = NBP * SEQ, NBS = 8, DSEQ = 64, MS = NBS * DSEQ, MT = MP + MS;
constexpr int DIN = 1536, DFF = 4096, DEPTH = 2, NBT = NBP + NBS, PW = 512, SW = 512, NMOD = 6 * D;
constexpr float EPS = 1e-6f;
constexpr int NTHREADS = 512;

constexpr size_t WS_WIN_T = 0;
constexpr size_t WS_WOUT_T = WS_WIN_T + (size_t)DEPTH * DIN * D * 2;
constexpr size_t WS_W1_T = WS_WOUT_T + (size_t)DEPTH * D * D * 2;
constexpr size_t WS_W2_T = WS_W1_T + (size_t)DEPTH * DFF * D * 2;
constexpr size_t WS_WP_T = WS_W2_T + (size_t)DEPTH * DFF * D * 2;
constexpr size_t WS_WSP = WS_WP_T + (size_t)DEPTH * 4 * 128 * 128 * 2;
constexpr size_t WS_MOD = WS_WSP + (size_t)DEPTH * 4 * 128 * 128 * 2;
constexpr size_t WS_SHWIN = WS_MOD + (size_t)DEPTH * NBT * NMOD * 4;
constexpr size_t WS_SHW1 = WS_SHWIN + (size_t)DEPTH * NBT * DIN * 4;
constexpr size_t WS_SSQ1 = WS_SHW1 + (size_t)DEPTH * NBT * DFF * 4;
constexpr size_t WS_SSQ2 = WS_SSQ1 + (size_t)MT * 16 * 4;
constexpr size_t WS_STV = WS_SSQ2 + (size_t)MT * 16 * 4;
constexpr size_t WS_XG = WS_STV + (size_t)MT * 16 * 4;
constexpr size_t WS_F1 = WS_XG + (size_t)MT * D * 2;
constexpr size_t WS_A = WS_F1;
constexpr size_t WS_U = WS_A + (size_t)MT * PW * 2;
constexpr size_t WS_GV = WS_U + (size_t)MT * SW * 2;
constexpr size_t WS_CAT = WS_GV + (size_t)MT * SW * 2;
constexpr size_t WS_BAR = WS_F1 + (size_t)MT * DFF * 2;
constexpr size_t WS_BAR_BYTES = 16384;
constexpr size_t WS_END = WS_BAR + WS_BAR_BYTES;

constexpr size_t OUT_Y = 0;
constexpr size_t OUT_SPP = (size_t)MT * D;
constexpr size_t OUT_SPS = OUT_SPP + (size_t)DEPTH * NBP * 15 * PW;
constexpr size_t OUT_SV = OUT_SPS + (size_t)DEPTH * NBS * 15 * PW;

struct Params {
    const float* in[20];
    float* out;
    unsigned char* ws;
    int ph_lo, ph_hi;
};
enum { I_XP = 0, I_XS, I_SPOOL, I_CP, I_CS, I_WADA, I_BADA, I_GMIX, I_WIN, I_WPOOL, I_PSCALE, I_VG, I_VB, I_WSP, I_BSP, I_WOUT, I_GFFN, I_W1, I_W2, I_GFIN };

__device__ __forceinline__ unsigned cvt_pk_bf16(float lo, float hi) { unsigned r; asm volatile("v_cvt_pk_bf16_f32 %0, %1, %2" : "=v"(r) : "v"(lo), "v"(hi)); return r; }
__device__ __forceinline__ float bflo(unsigned w) { return __uint_as_float(w << 16); }
__device__ __forceinline__ float bfhi(unsigned w) { return __uint_as_float(w & 0xffff0000u); }
__device__ __forceinline__ int batch_of(int row) { return row < MP ? (row >> 12) : NBP + ((row - MP) >> 6); }
__device__ __forceinline__ f32x2 gelu_pk(f32x2 v) {
    const f32x2 av = __builtin_elementwise_abs(v), d = av * 0.2316418882f + 1.0f;
    f32x2 t; t.x = __builtin_amdgcn_rcpf(d.x); t.y = __builtin_amdgcn_rcpf(d.y);
    f32x2 q = t * 0.5307027145f + (-0.7265760135f); q = q * t + 0.7107068705f; q = q * t + (-0.142248368f); q = q * t + 0.127414796f; q = q * t;
    const f32x2 s = (v * v) * (-0.72134752044f);
    f32x2 e; e.x = __builtin_amdgcn_exp2f(s.x); e.y = __builtin_amdgcn_exp2f(s.y);
    const f32x2 m = v * (q * e), r = v - m;
    f32x2 o; o.x = v.x < 0.f ? m.x : r.x; o.y = v.y < 0.f ? m.y : r.y; return o;
}
__device__ __forceinline__ f32x4 gelu4(f32x4 v) { f32x2 a = gelu_pk((f32x2){v[0], v[1]}), b = gelu_pk((f32x2){v[2], v[3]}); return (f32x4){a.x, a.y, b.x, b.y}; }
__device__ __forceinline__ float wave_sum(float v) {
#pragma unroll
    for (int o = 32; o >= 1; o >>= 1) v += __shfl_xor(v, o);
    return v;
}
__device__ __forceinline__ float quad_row_sum(float v) { v += __shfl_xor(v, 16); v += __shfl_xor(v, 32); return v; }

namespace pg8 {
constexpr int BM = 256, BK = 64, HALF = 128, HTB = HALF * BK * 2, STAGE_BYTES = 8 * HTB, NXCD = 8, WGM = 8;
__device__ __forceinline__ int lds_byte(int r, int c) { const int st = (r >> 4) * 2 + (c >> 5), rr = r & 15, cc = c & 31, ob = rr * 64 + cc * 2; return st * 1024 + (ob ^ (((ob >> 9) & 1) << 5)); }
__device__ __forceinline__ void stage_rc(int b, int& R, int& C) { const int st = b / 1024, sb = b % 1024, swz = sb ^ (((sb >> 9) & 1) << 5); R = (st >> 1) * 16 + swz / 64; C = (st & 1) * 32 + (swz % 64) / 2; }
struct Unit { int pm, pn; };
struct Gemm { const bf16_t* A; const bf16_t* Bt; int M, N, K; };
struct StaticOrder {
    int nM, nN, nwg, G, c;
    __device__ void init(int M, int N, int G_, int c_) { nM = M / BM; nN = N / BM; nwg = nM * nN; G = G_; c = c_; }
    __device__ bool next(int i, Unit& u) const {
        const long L = (long)i * G + c; if (L >= nwg) return false;
        int wgid = (int)L; { const int q = nwg / NXCD, r = nwg % NXCD, xcd = wgid % NXCD, off = wgid / NXCD; wgid = (xcd < r ? xcd * (q + 1) : r * (q + 1) + (xcd - r) * q) + off; }
        const int nig = WGM * nN, gid = wgid / nig, fm = gid * WGM, gsz = (nM - fm) < WGM ? (nM - fm) : WGM;
        u.pm = fm + ((wgid % nig) % gsz); u.pn = (wgid % nig) / gsz; return true;
    }
};

template <class Epi>
__device__ __forceinline__ void gemm_phase(LAS unsigned char* lds, const Gemm g, const StaticOrder& S, const Epi& E) {
    int tid_ = threadIdx.x; asm volatile("" : "+v"(tid_));
    const int tid = tid_, wid = __builtin_amdgcn_readfirstlane(tid >> 6), lane = tid & 63, wr = wid >> 2, wc = wid & 3, fr = lane & 15, fq = lane >> 4;
    const int K = g.K, nt = K / BK;
    unsigned voffA[2], voffB[2];
#pragma unroll
    for (int i = 0; i < 2; ++i) { int R, C; stage_rc(tid * 16 + i * 8192, R, C); voffA[i] = (unsigned)(R * K + C) * 2u; voffB[i] = (unsigned)(R * K + C) * 2u; }
    const size_t kstep = (size_t)(BK * 2);
    const size_t hstep = (size_t)HALF * K * 2;
    const size_t tstep = 2 * hstep;
    const unsigned ldsw = (unsigned)wid * 1024u;
    const int aoff = lds_byte(wr * 64 + fr, fq * 8), boff = lds_byte(wc * 32 + fr, fq * 8);
#define PG8_SA(b, h) (((b) * 2 + (h)) * HTB)
#define PG8_SB(b, h) ((4 + (b) * 2 + (h)) * HTB)
#define PG8_STAGE(bufoff, gbase, voff) do { _Pragma("unroll") for (int _i = 0; _i < 2; ++_i) \
        __builtin_amdgcn_global_load_lds((const unsigned*)((const char*)(gbase) + (voff)[_i]), (LAS unsigned*)(lds + (bufoff) + ldsw + _i * 8192), 16, 0, 0); } while (0)
#define PG8_LDA(dst, b, h) do { _Pragma("unroll") for (int m = 0; m < 4; ++m) _Pragma("unroll") for (int k = 0; k < 2; ++k) dst[m][k] = *(const LAS bf16x8*)(lds + PG8_SA(b, h) + aoff + m * 2048 + k * 1024); } while (0)
#define PG8_LDB(dst, b, h) do { _Pragma("unroll") for (int n = 0; n < 2; ++n) _Pragma("unroll") for (int k = 0; k < 2; ++k) dst[n][k] = *(const LAS bf16x8*)(lds + PG8_SB(b, h) + boff + n * 2048 + k * 1024); } while (0)
#define PG8_MMA(ai, bj, At, Bt) do { __builtin_amdgcn_s_setprio(1); _Pragma("unroll") for (int m = 0; m < 4; ++m) _Pragma("unroll") for (int n = 0; n < 2; ++n) _Pragma("unroll") for (int k = 0; k < 2; ++k) \
        acc[ai][bj][m][n] = __builtin_amdgcn_mfma_f32_16x16x32_bf16(Bt[n][k], At[m][k], acc[ai][bj][m][n], 0, 0, 0); __builtin_amdgcn_s_setprio(0); } while (0)
#define PG8_WAIT_V(n) asm volatile("s_waitcnt vmcnt(" #n ")" ::: "memory")
#define PG8_WAIT_L(n) asm volatile("s_waitcnt lgkmcnt(" #n ")" ::: "memory")
#define PG8_BAR __builtin_amdgcn_s_barrier()
#define PG8_SCHED __builtin_amdgcn_sched_barrier(0)
    Unit cur, nxt; int ui = 0;
    if (!S.next(0, cur)) return;
    f32x4 acc[2][2][4][2];
#pragma unroll
    for (int a = 0; a < 2; ++a)
#pragma unroll
        for (int b = 0; b < 2; ++b)
#pragma unroll
            for (int m = 0; m < 4; ++m)
#pragma unroll
                for (int n = 0; n < 2; ++n) acc[a][b][m][n] = (f32x4){0.f, 0.f, 0.f, 0.f};
    bf16x8 At[4][2], B0[2][2], B1[2][2];
    const char* cA = (const char*)g.A + (size_t)cur.pm * tstep; const char* cB = (const char*)g.Bt + (size_t)cur.pn * tstep;
    PG8_STAGE(PG8_SB(0, 0), cB, voffB); PG8_STAGE(PG8_SA(0, 0), cA, voffA); PG8_STAGE(PG8_SB(0, 1), cB + hstep, voffB); PG8_STAGE(PG8_SA(0, 1), cA + hstep, voffA);
    if (wr == 1) PG8_BAR;
    PG8_WAIT_V(4); PG8_BAR;
    PG8_STAGE(PG8_SB(1, 0), cB + kstep, voffB); PG8_STAGE(PG8_SA(1, 0), cA + kstep, voffA); PG8_STAGE(PG8_SB(1, 1), cB + hstep + kstep, voffB);
    PG8_WAIT_V(6); PG8_BAR;
    for (;;) {
        const bool has_next = S.next(ui + 1, nxt);
        const char* nA = has_next ? (const char*)g.A + (size_t)nxt.pm * tstep : cA; const char* nB = has_next ? (const char*)g.Bt + (size_t)nxt.pn * tstep : cB;
        for (int t = 0; t < nt; t += 2) {
            const bool last = (t == nt - 2);
            const char* a1 = cA + (size_t)(t + 1) * kstep;
            const char* a2 = last ? nA : cA + (size_t)(t + 2) * kstep; const char* b2 = last ? nB : cB + (size_t)(t + 2) * kstep;
            const char* a3 = a2 + kstep; const char* b3 = b2 + kstep;
            PG8_LDB(B0, 0, 0); PG8_SCHED; PG8_LDA(At, 0, 0); PG8_STAGE(PG8_SA(1, 1), a1 + hstep, voffA);
            PG8_WAIT_L(8); PG8_BAR; PG8_WAIT_L(0); PG8_MMA(0, 0, At, B0); PG8_BAR; PG8_SCHED;
            PG8_LDB(B1, 0, 1); PG8_STAGE(PG8_SB(0, 0), b2, voffB);
            PG8_BAR; PG8_WAIT_L(0); PG8_MMA(0, 1, At, B1); PG8_BAR;
            PG8_LDA(At, 0, 1); PG8_STAGE(PG8_SA(0, 0), a2, voffA);
            PG8_BAR; PG8_WAIT_L(0); PG8_MMA(1, 0, At, B0); PG8_BAR; PG8_SCHED;
            PG8_STAGE(PG8_SB(0, 1), b2 + hstep, voffB);
            PG8_WAIT_V(6); PG8_BAR; PG8_MMA(1, 1, At, B1); PG8_BAR;
            PG8_LDB(B0, 1, 0); PG8_SCHED; PG8_LDA(At, 1, 0); PG8_STAGE(PG8_SA(0, 1), a2 + hstep, voffA);
            PG8_WAIT_L(8); PG8_BAR; PG8_WAIT_L(0); PG8_MMA(0, 0, At, B0); PG8_BAR; PG8_SCHED;
            PG8_LDB(B1, 1, 1); PG8_STAGE(PG8_SB(1, 0), b3, voffB);
            PG8_BAR; PG8_WAIT_L(0); PG8_MMA(0, 1, At, B1); PG8_BAR;
            PG8_LDA(At, 1, 1); PG8_STAGE(PG8_SA(1, 0), a3, voffA);
            PG8_BAR; PG8_WAIT_L(0); PG8_MMA(1, 0, At, B0); PG8_BAR; PG8_SCHED;
            PG8_STAGE(PG8_SB(1, 1), b3 + hstep, voffB);
            PG8_WAIT_V(6); PG8_BAR; PG8_MMA(1, 1, At, B1); PG8_BAR;
        }
        E(acc, cur, wr, wc, fr, fq);
        if (!has_next) break;
#pragma unroll
        for (int a = 0; a < 2; ++a)
#pragma unroll
            for (int b = 0; b < 2; ++b)
#pragma unroll
                for (int m = 0; m < 4; ++m)
#pragma unroll
                    for (int n = 0; n < 2; ++n) acc[a][b][m][n] = (f32x4){0.f, 0.f, 0.f, 0.f};
        cur = nxt; cA = nA; cB = nB; ++ui;
    }
    PG8_WAIT_V(0);
    if (wr == 0) PG8_BAR;
    PG8_BAR;
#undef PG8_SA
#undef PG8_SB
#undef PG8_STAGE
#undef PG8_LDA
#undef PG8_LDB
#undef PG8_MMA
#undef PG8_WAIT_V
#undef PG8_WAIT_L
#undef PG8_BAR
#undef PG8_SCHED
}
}

typedef f32x4 AccT[2][2][4][2];

__device__ __forceinline__ f32x4 ldg4(const void* base, unsigned off) { return *(const f32x4*)((const char*)base + off); }
__device__ __forceinline__ void stg4(void* base, unsigned off, f32x4 v) { *(f32x4*)((char*)base + off) = v; }
__device__ __forceinline__ void stg2(void* base, unsigned off, u32x2 v) { *(u32x2*)((char*)base + off) = v; }
__device__ __forceinline__ void stf2(void* base, unsigned off, f32x2 v) { *(f32x2*)((char*)base + off) = v; }
__device__ __forceinline__ void stf1(void* base, unsigned off, float v) { *(float*)((char*)base + off) = v; }
__device__ __forceinline__ u32x2 pack4(f32x4 z) { u32x2 w; w.x = cvt_pk_bf16(z[0], z[1]); w.y = cvt_pk_bf16(z[2], z[3]); return w; }
constexpr unsigned CO[2][2] = {{0u, 16u}, {128u, 144u}};

struct EpiIn {
    const float* ssq1; const float* shw; bf16_t* A; bf16_t* U; bf16_t* GV; float* stv;
    __device__ __forceinline__ void operator()(const AccT& acc, const pg8::Unit& u, int wr, int wc, int fr, int fq) const {
        const int rowu = u.pm * 256 + wr * 64;
        const unsigned colb = (unsigned)(u.pn * 256 + wc * 32 + 4 * fq), rowb = (unsigned)(rowu + fr);
        bf16_t* const dbase = u.pn < 2 ? A : (u.pn < 4 ? U - 512 : GV - 1024);
#pragma unroll
        for (int ai = 0; ai < 2; ++ai) {
            const float* bias = shw + (size_t)batch_of(rowu + ai * 128) * DIN;
            f32x4 pp[4], bv[2][2];
#pragma unroll
            for (int m = 0; m < 4; ++m) pp[m] = ldg4(ssq1, ((rowb + ai * 128 + m * 16) * 16 + fq * 4) * 4);
#pragma unroll
            for (int bj = 0; bj < 2; ++bj)
#pragma unroll
                for (int n = 0; n < 2; ++n) bv[bj][n] = ldg4(bias, (colb + CO[bj][n]) * 4);
            float rstd[4], s1[4], s2[4];
#pragma unroll
            for (int m = 0; m < 4; ++m) { const f32x4 p = pp[m]; rstd[m] = rsqrtf(quad_row_sum((p[0] + p[1]) + (p[2] + p[3])) * (1.0f / D) + EPS); }
#pragma unroll
            for (int m = 0; m < 4; ++m) {
                const unsigned row = rowb + ai * 128 + m * 16;
                float t1 = 0.f, t2 = 0.f;
#pragma unroll
                for (int bj = 0; bj < 2; ++bj)
#pragma unroll
                    for (int n = 0; n < 2; ++n) {
                        f32x4 z = acc[ai][bj][m][n] * rstd[m] + bv[bj][n];
                        if (u.pn >= 2) z = gelu4(z);
                        if (u.pn >= 4) { t1 += (z[0] + z[1]) + (z[2] + z[3]); t2 += (z[0] * z[0] + z[1] * z[1]) + (z[2] * z[2] + z[3] * z[3]); }
                        stg2(dbase, (row * 512 + colb + CO[bj][n]) * 2, pack4(z));
                    }
                s1[m] = t1; s2[m] = t2;
            }
            if (u.pn >= 4) {
#pragma unroll
                for (int m = 0; m < 4; ++m) {
                    const float a = quad_row_sum(s1[m]), b = quad_row_sum(s2[m]);
                    if (fq == 0) stf2(stv, ((rowb + ai * 128 + m * 16) * 16 + ((u.pn - 4) * 4 + wc) * 2) * 4, (f32x2){a, b});
                }
            }
        }
    }
};
struct EpiRes {
    const float* xp; const float* xs; const float* xres_in;
    float* xres; const float* gate;
    const float* gnext; const float* scnext;
    bf16_t* XG; float* ssq;
    __device__ __forceinline__ void operator()(const AccT& acc, const pg8::Unit& u, int wr, int wc, int fr, int fq) const {
        const int rowu = u.pm * 256 + wr * 64;
        const unsigned colb = (unsigned)(u.pn * 256 + wc * 32 + 4 * fq), rowb = (unsigned)(rowu + fr);
        const float* const xin = xres_in ? xres_in : (u.pm >= MP / 256 ? xs - (size_t)MP * D : xp);
        float ssr[8];
        f32x4 gt[2][2], gm[2][2];
        f32x4 ring[3][2][2];
        int bcur = -1;
#define ER_LOADROW(r_, slot_) do { const unsigned ro_ = (rowb + ((r_) >> 2) * 128 + ((r_) & 3) * 16) * D + colb; \
            _Pragma("unroll") for (int bj = 0; bj < 2; ++bj) _Pragma("unroll") for (int n = 0; n < 2; ++n) ring[slot_][bj][n] = ldg4(xin, (ro_ + CO[bj][n]) * 4); } while (0)
#pragma unroll
        for (int r = 0; r < 8; ++r) {
            const int ai = r >> 2, m = r & 3; const unsigned row = rowb + ai * 128 + m * 16;
            if (r == 0 || r == 4) {
                const int b = batch_of(rowu + ai * 128);
                if (b != bcur) {
                    bcur = b;
#pragma unroll
                    for (int bj = 0; bj < 2; ++bj)
#pragma unroll
                        for (int n = 0; n < 2; ++n) {
                            const unsigned co = (colb + CO[bj][n]) * 4;
                            gt[bj][n] = ldg4(gate + (size_t)b * NMOD, co);
                            if (gnext) gm[bj][n] = ldg4(gnext, co) * (ldg4(scnext + (size_t)b * NMOD, co) + 1.0f);
                            else gm[bj][n] = (f32x4){0.f, 0.f, 0.f, 0.f};
                        }
                }
            }
            if (r == 0) { ER_LOADROW(0, 0); ER_LOADROW(1, 1); }
            if (r + 2 < 8) ER_LOADROW(r + 2, (r + 2) % 3);
            float ss = 0.f;
#pragma unroll
            for (int bj = 0; bj < 2; ++bj)
#pragma unroll
                for (int n = 0; n < 2; ++n) {
                    const unsigned eo = row * D + colb + CO[bj][n];
                    const f32x4 x1 = ring[r % 3][bj][n] + gt[bj][n] * acc[ai][bj][m][n];
                    stg4(xres, eo * 4, x1);
                    ss += (x1[0] * x1[0] + x1[1] * x1[1]) + (x1[2] * x1[2] + x1[3] * x1[3]);
                    if (gnext) stg2(XG, eo * 2, pack4(x1 * gm[bj][n]));
                }
            ssr[r] = ss;
        }
#undef ER_LOADROW
#pragma unroll
        for (int r = 0; r < 8; ++r) { const float t = quad_row_sum(ssr[r]); if (fq == 0) stf1(ssq, ((rowb + (r >> 2) * 128 + (r & 3) * 16) * 16 + u.pn * 4 + wc) * 4, t); }
    }
};
struct EpiFf1 {
    const float* ssq2; const float* shw; bf16_t* F1;
    __device__ __forceinline__ void operator()(const AccT& acc, const pg8::Unit& u, int wr, int wc, int fr, int fq) const {
        const int rowu = u.pm * 256 + wr * 64;
        const unsigned colb = (unsigned)(u.pn * 256 + wc * 32 + 4 * fq), rowb = (unsigned)(rowu + fr);
#pragma unroll
        for (int ai = 0; ai < 2; ++ai) {
            const float* bias = shw + (size_t)batch_of(rowu + ai * 128) * DFF;
            f32x4 pp[4], bv[2][2];
#pragma unroll
            for (int m = 0; m < 4; ++m) pp[m] = ldg4(ssq2, ((rowb + ai * 128 + m * 16) * 16 + fq * 4) * 4);
#pragma unroll
            for (int bj = 0; bj < 2; ++bj)
#pragma unroll
                for (int n = 0; n < 2; ++n) bv[bj][n] = ldg4(bias, (colb + CO[bj][n]) * 4);
            float rstd[4];
#pragma unroll
            for (int m = 0; m < 4; ++m) { const f32x4 p = pp[m]; rstd[m] = rsqrtf(quad_row_sum((p[0] + p[1]) + (p[2] + p[3])) * (1.0f / D) + EPS); }
#pragma unroll
            for (int m = 0; m < 4; ++m) {
                const unsigned row = rowb + ai * 128 + m * 16;
#pragma unroll
                for (int bj = 0; bj < 2; ++bj)
#pragma unroll
                    for (int n = 0; n < 2; ++n) {
                        f32x4 z = acc[ai][bj][m][n] * rstd[m] + bv[bj][n];
                        z = __builtin_elementwise_max(z, (f32x4){0.f, 0.f, 0.f, 0.f}); z = z * z;
                        stg2(F1, (row * DFF + colb + CO[bj][n]) * 2, pack4(z));
                    }
            }
        }
    }
};

typedef const __attribute__((address_space(4))) Params* KArgs;
__device__ __forceinline__ KArgs kargs() { KArgs k = (KArgs)__builtin_amdgcn_kernarg_segment_ptr(); asm volatile("" : "+s"(k)); return k; }
struct Ctx {
    KArgs k;
    LAS unsigned char* lds; int tid, lane, wid, G, bx;
};

__device__ __forceinline__ void gemv24_unit(const Ctx& c, int mode, const float* vsrc, int vstride, const float* W, int ldw, int n0, const float* bias, float* out, int ldo) {
    LAS float* tbl = (LAS float*)c.lds;
    __syncthreads();
    for (int i = c.tid; i < NBT * D; i += NTHREADS) {
        const int b = i >> 10, k = i & 1023; float v;
        if (mode == 0) { const float x = b < NBP ? c.k->in[I_CP][b * D + k] : c.k->in[I_CS][(b - NBP) * D + k]; v = x / (1.0f + __expf(-x)); }
        else v = vsrc[(size_t)b * vstride + k];
        tbl[k * NBT + b] = v;
    }
    __syncthreads();
    const int ks = c.tid >> 6, j = c.tid & 63;
    float acc[NBT];
#pragma unroll
    for (int b = 0; b < NBT; ++b) acc[b] = 0.f;
    const float* wp = W + (size_t)(ks * 128) * ldw + n0 + j;
#pragma unroll 8
    for (int kk = 0; kk < 128; ++kk) {
        const float w = wp[(size_t)kk * ldw];
        const LAS f32x4* t4 = (const LAS f32x4*)(tbl + (ks * 128 + kk) * NBT);
#pragma unroll
        for (int q = 0; q < 6; ++q) { const f32x4 t = t4[q]; acc[4 * q + 0] += t[0] * w; acc[4 * q + 1] += t[1] * w; acc[4 * q + 2] += t[2] * w; acc[4 * q + 3] += t[3] * w; }
    }
    __syncthreads();
    LAS float* red = (LAS float*)c.lds;
#pragma unroll
    for (int b = 0; b < NBT; ++b) red[(ks * NBT + b) * 64 + j] = acc[b];
    __syncthreads();
    for (int o = c.tid; o < NBT * 64; o += NTHREADS) {
        const int b = o >> 6, jj = o & 63; float s = bias ? bias[n0 + jj] : 0.f;
#pragma unroll
        for (int q = 0; q < 8; ++q) s += red[(q * NBT + b) * 64 + jj];
        out[(size_t)b * ldo + n0 + jj] = s;
    }
}
__device__ __forceinline__ void transpose_unit(const Ctx& c, const float* W, int K, int N, int k0, int n0, bf16_t* Wt, const float* nscale) {
    LAS float* tile = (LAS float*)c.lds;
    __syncthreads();
    { const int r = c.tid >> 4, c4 = c.tid & 15;
#pragma unroll
      for (int i = 0; i < 2; ++i) { const int kk = r + 32 * i; const f32x4 v = *(const f32x4*)(W + (size_t)(k0 + kk) * N + n0 + c4 * 4);
          tile[kk * 65 + c4 * 4 + 0] = v[0]; tile[kk * 65 + c4 * 4 + 1] = v[1]; tile[kk * 65 + c4 * 4 + 2] = v[2]; tile[kk * 65 + c4 * 4 + 3] = v[3]; } }
    __syncthreads();
    { const int nn = c.tid >> 3, k8 = c.tid & 7; const float s = nscale ? nscale[n0 + nn] : 1.0f; float f[8];
#pragma unroll
      for (int j = 0; j < 8; ++j) f[j] = tile[(k8 * 8 + j) * 65 + nn] * s;
      u32x4 w; w.x = cvt_pk_bf16(f[0], f[1]); w.y = cvt_pk_bf16(f[2], f[3]); w.z = cvt_pk_bf16(f[4], f[5]); w.w = cvt_pk_bf16(f[6], f[7]);
      *(u32x4*)(Wt + (size_t)(n0 + nn) * K + k0 + k8 * 8) = w; }
}

constexpr int NU_MOD = DEPTH * (NMOD / 64);
constexpr int T_IN = 16 * 24, T_OUT = 16 * 16, T_F1 = 16 * 64, T_F2 = 64 * 16, T_LAYER = T_IN + T_OUT + T_F1 + T_F2;
constexpr int NU_TR = DEPTH * T_LAYER, NU_WP = DEPTH * 4 * 4, NU_WS = DEPTH * 4 * 4;
constexpr int NU_I0 = NU_MOD + NU_TR + NU_WP + NU_WS;
__device__ void phase_init0(const Ctx& c) {
    float* mod = (float*)(c.k->ws + WS_MOD);
    for (int u = c.bx; u < NU_I0; u += c.G) {
        if (u < NU_MOD) {
            const int l = u / (NMOD / 64), nb = u % (NMOD / 64);
            gemv24_unit(c, 0, nullptr, 0, c.k->in[I_WADA] + (size_t)l * D * NMOD, NMOD, nb * 64, c.k->in[I_BADA] + (size_t)l * NMOD, mod + (size_t)l * NBT * NMOD, NMOD);
        } else if (u < NU_MOD + NU_TR) {
            const int v = u - NU_MOD, l = v / T_LAYER; int r = v % T_LAYER;
            if (r < T_IN) transpose_unit(c, c.k->in[I_WIN] + (size_t)l * D * DIN, D, DIN, (r / 24) * 64, (r % 24) * 64, (bf16_t*)(c.k->ws + WS_WIN_T) + (size_t)l * DIN * D, nullptr);
            else if ((r -= T_IN) < T_OUT) transpose_unit(c, c.k->in[I_WOUT] + (size_t)l * D * D, D, D, (r / 16) * 64, (r % 16) * 64, (bf16_t*)(c.k->ws + WS_WOUT_T) + (size_t)l * D * D, nullptr);
            else if ((r -= T_OUT) < T_F1) transpose_unit(c, c.k->in[I_W1] + (size_t)l * D * DFF, D, DFF, (r / 64) * 64, (r % 64) * 64, (bf16_t*)(c.k->ws + WS_W1_T) + (size_t)l * DFF * D, nullptr);
            else { r -= T_F1; transpose_unit(c, c.k->in[I_W2] + (size_t)l * DFF * D, DFF, D, (r / 16) * 64, (r % 16) * 64, (bf16_t*)(c.k->ws + WS_W2_T) + (size_t)l * D * DFF, nullptr); }
        } else if (u < NU_MOD + NU_TR + NU_WP) {
            const int v = u - NU_MOD - NU_TR, lg = v >> 2, t = v & 3, l = lg >> 2, g = lg & 3;
            transpose_unit(c, c.k->in[I_WPOOL] + (size_t)lg * 128 * 128, 128, 128, (t >> 1) * 64, (t & 1) * 64, (bf16_t*)(c.k->ws + WS_WP_T) + (size_t)lg * 128 * 128, c.k->in[I_PSCALE] + l * PW + g * 128);
        } else {
            const int v = u - NU_MOD - NU_TR - NU_WP, lh = v >> 2, t = v & 3, t0 = (t >> 1) * 64, s0 = (t & 1) * 64;
            const int tt = t0 + (c.tid >> 3), s8 = s0 + (c.tid & 7) * 8;
            const float* src = c.k->in[I_WSP] + ((size_t)lh * 128 + tt) * 128 + s8;
            const f32x4 a = *(const f32x4*)src, b = *(const f32x4*)(src + 4);
            float f[8] = {a[0], a[1], a[2], a[3], b[0], b[1], b[2], b[3]};
#pragma unroll
            for (int j = 0; j < 8; ++j) if (s8 + j > tt) f[j] = 0.f;
            u32x4 w; w.x = cvt_pk_bf16(f[0], f[1]); w.y = cvt_pk_bf16(f[2], f[3]); w.z = cvt_pk_bf16(f[4], f[5]); w.w = cvt_pk_bf16(f[6], f[7]);
            *(u32x4*)((bf16_t*)(c.k->ws + WS_WSP) + ((size_t)lh * 128 + tt) * 128 + s8) = w;
        }
    }
}
constexpr int NU_SH_L = DIN / 64 + DFF / 64;
__device__ void phase_init1(const Ctx& c) {
    const float* mod = (const float*)(c.k->ws + WS_MOD);
    for (int u = c.bx; u < DEPTH * NU_SH_L; u += c.G) {
        const int l = u / NU_SH_L, r = u % NU_SH_L;
        const float* ml = mod + (size_t)l * NBT * NMOD;
        if (r < DIN / 64) gemv24_unit(c, 1, ml + 0 * D, NMOD, c.k->in[I_WIN] + (size_t)l * D * DIN, DIN, r * 64, nullptr, (float*)(c.k->ws + WS_SHWIN) + (size_t)l * NBT * DIN, DIN);
        else gemv24_unit(c, 1, ml + 3 * D, NMOD, c.k->in[I_W1] + (size_t)l * D * DFF, DFF, (r - DIN / 64) * 64, nullptr, (float*)(c.k->ws + WS_SHW1) + (size_t)l * NBT * DFF, DFF);
    }
    bf16_t* XG = (bf16_t*)(c.k->ws + WS_XG); float* ssq1 = (float*)(c.k->ws + WS_SSQ1);
    const float* gm = c.k->in[I_GMIX];
    for (int rg = c.bx; rg < MT / 32; rg += c.G) {
        const int rowb = rg * 32 + c.wid * 4, b = batch_of(rowb);
        const float* sc = mod + (size_t)b * NMOD + 1 * D;
        f32x4 x[4][4], gmul[4];
#pragma unroll
        for (int r = 0; r < 4; ++r) { const int row = rowb + r;
            const float* xr = row < MP ? c.k->in[I_XP] + (size_t)row * D : c.k->in[I_XS] + (size_t)(row - MP) * D;
#pragma unroll
            for (int i = 0; i < 4; ++i) x[r][i] = *(const f32x4*)(xr + i * 256 + c.lane * 4); }
#pragma unroll
        for (int i = 0; i < 4; ++i) { const int k = i * 256 + c.lane * 4; gmul[i] = *(const f32x4*)(gm + k) * (*(const f32x4*)(sc + k) + 1.0f); }
#pragma unroll
        for (int r = 0; r < 4; ++r) {
            float ss = 0.f;
#pragma unroll
            for (int i = 0; i < 4; ++i) { const f32x4 v = x[r][i]; ss += (v[0] * v[0] + v[1] * v[1]) + (v[2] * v[2] + v[3] * v[3]);
                *(u32x2*)(XG + (size_t)(rowb + r) * D + i * 256 + c.lane * 4) = pack4(v * gmul[i]); }
            ss = wave_sum(ss);
            if (c.lane < 16) ssq1[(size_t)(rowb + r) * 16 + c.lane] = c.lane == 0 ? ss : 0.f;
        }
    }
}
constexpr int TP = 272;
__device__ __forceinline__ void unpack8(u32x4 v, float* f) { f[0] = bflo(v.x); f[1] = bfhi(v.x); f[2] = bflo(v.y); f[3] = bfhi(v.y); f[4] = bflo(v.z); f[5] = bfhi(v.z); f[6] = bflo(v.w); f[7] = bfhi(v.w); }
__device__ __forceinline__ u32x4 pack8(const float* f) { u32x4 w; w.x = cvt_pk_bf16(f[0], f[1]); w.y = cvt_pk_bf16(f[2], f[3]); w.z = cvt_pk_bf16(f[4], f[5]); w.w = cvt_pk_bf16(f[6], f[7]); return w; }
__device__ void phase_mixer(const Ctx& c, int l) {
    LAS unsigned char* tA = c.lds; LAS unsigned char* tB = c.lds + 128 * TP; LAS unsigned char* tX = c.lds + 256 * TP;
    unsigned char* ws = c.k->ws; float* outp = c.k->out;
    const bf16_t* Ab = (const bf16_t*)(ws + WS_A); const bf16_t* Ub = (const bf16_t*)(ws + WS_U); const bf16_t* GVb = (const bf16_t*)(ws + WS_GV);
    bf16_t* CAT = (bf16_t*)(ws + WS_CAT); const float* stv = (const float*)(ws + WS_STV);
    const bf16_t* WpT = (const bf16_t*)(ws + WS_WP_T) + (size_t)l * 4 * 128 * 128;
    const bf16_t* Wsp = (const bf16_t*)(ws + WS_WSP) + (size_t)l * 4 * 128 * 128;
    const int lane = c.lane, wid = c.wid, i15 = lane & 15, kq = lane >> 4, c8 = c.tid & 15, r0 = c.tid >> 4;
    constexpr int NCH = MP / 128 + NBS;
    for (int u = c.bx; u < NCH * 8; u += c.G) {
        const int ct = u >> 3, j = (u + (u >> 8)) & 7;
        const bool samp = ct >= MP / 128;
        const int sb = ct - MP / 128;
        const int row0 = samp ? MP + sb * DSEQ : ct * 128, nrows = samp ? DSEQ : 128, bm = samp ? NBP + sb : (ct >> 5), tseq0 = samp ? SEQ : (ct & 31) * 128;
        const int ntb = nrows >> 4;
        bf16_t* const cbase = CAT + (size_t)row0 * D + (j < 4 ? j * 128 : 512 + (j - 4) * 128) + 16 * wid + 4 * kq;
        __syncthreads();
        if (j < 4) {
            const int g = j, w = 2 << g;
            {
                u32x4 wv[4], xv[5];
#pragma unroll
                for (int i = 0; i < 4; ++i) wv[i] = *(const u32x4*)(WpT + ((size_t)g * 128 + r0 + 32 * i) * 128 + c8 * 8);
                const bf16_t* ap = Ab + (size_t)row0 * PW + g * 128 + c8 * 8;
#pragma unroll
                for (int i = 0; i < 5; ++i) {
                    const int rr = r0 + 32 * i, t = rr - 15;
                    xv[i] = (u32x4){0u, 0u, 0u, 0u};
                    if (rr < 143 && t < nrows) {
                        if (t >= 0 || (!samp && tseq0 > 0)) xv[i] = *(const u32x4*)(ap + (ptrdiff_t)t * PW);
                        else if (samp) { const float* sp = c.k->in[I_SPOOL] + (((size_t)l * NBS + sb) * 15 + rr) * PW + g * 128 + c8 * 8;
                            const f32x4 p0 = *(const f32x4*)sp, p1 = *(const f32x4*)(sp + 4);
                            xv[i].x = cvt_pk_bf16(p0[0], p0[1]); xv[i].y = cvt_pk_bf16(p0[2], p0[3]); xv[i].z = cvt_pk_bf16(p1[0], p1[1]); xv[i].w = cvt_pk_bf16(p1[2], p1[3]); }
                    }
                }
#pragma unroll
                for (int i = 0; i < 4; ++i) *(LAS u32x4*)(tB + (r0 + 32 * i) * TP + c8 * 16) = wv[i];
#pragma unroll
                for (int i = 0; i < 5; ++i) { const int rr = r0 + 32 * i; if (rr < 143) *(LAS u32x4*)(tX + rr * TP + c8 * 16) = xv[i]; }
            }
            __syncthreads();
#pragma unroll 1
            for (int i = 0; i < 4; ++i) {
                const int t = r0 + 32 * i;
                if (t < nrows) {
                    const LAS unsigned char* xp0 = tX + (t + 15) * TP + c8 * 16;
                    float a0[8], s[8], tmp[8];
                    unpack8(*(const LAS u32x4*)xp0, a0);
#pragma unroll
                    for (int k = 0; k < 8; ++k) s[k] = a0[k];
#pragma unroll 2
                    for (int jj = 1; jj < w; ++jj) { unpack8(*(const LAS u32x4*)(xp0 - jj * TP), tmp);
#pragma unroll
                        for (int k = 0; k < 8; ++k) s[k] += tmp[k]; }
                    const int pos1 = tseq0 + t + 1; const float inv = 1.0f / (float)(pos1 < w ? pos1 : w);
                    float dd[8];
#pragma unroll
                    for (int k = 0; k < 8; ++k) dd[k] = s[k] * inv - a0[k];
                    *(LAS u32x4*)(tA + t * TP + c8 * 16) = pack8(dd);
                    float* so = nullptr;
                    if (!samp && (ct & 31) == 31 && t >= 113) so = outp + OUT_SPP + (((size_t)l * NBP + bm) * 15 + (t - 113)) * PW + g * 128 + c8 * 8;
                    if (samp && t >= 49) so = outp + OUT_SPS + (((size_t)l * NBS + sb) * 15 + (t - 49)) * PW + g * 128 + c8 * 8;
                    if (so) { *(f32x4*)so = (f32x4){a0[0], a0[1], a0[2], a0[3]}; *(f32x4*)(so + 4) = (f32x4){a0[4], a0[5], a0[6], a0[7]}; }
                }
            }
            __syncthreads();
            f32x4 acc[8];
#pragma unroll
            for (int tb = 0; tb < 8; ++tb) acc[tb] = (f32x4){0.f, 0.f, 0.f, 0.f};
#pragma unroll
            for (int kk = 0; kk < 4; ++kk) {
                const bf16x8 bf = *(const LAS bf16x8*)(tB + (16 * wid + i15) * TP + kk * 64 + kq * 16);
#pragma unroll
                for (int tb = 0; tb < 8; ++tb) if (tb < ntb) {
                    const bf16x8 af = *(const LAS bf16x8*)(tA + (16 * tb + i15) * TP + kk * 64 + kq * 16);
                    acc[tb] = __builtin_amdgcn_mfma_f32_16x16x32_bf16(bf, af, acc[tb], 0, 0, 0); }
            }
#pragma unroll
            for (int tb = 0; tb < 8; ++tb) if (tb < ntb) *(u32x2*)(cbase + (size_t)(16 * tb + i15) * D) = pack4(acc[tb]);
        } else {
            const int h = j - 4;
            u32x2 uu[8]; float bsv[8];
            {
                u32x4 wv[4], gvv[4]; float sv[4];
#pragma unroll
                for (int i = 0; i < 4; ++i) wv[i] = *(const u32x4*)(Wsp + ((size_t)h * 128 + r0 + 32 * i) * 128 + c8 * 8);
#pragma unroll
                for (int i = 0; i < 4; ++i) {
                    const int sr = r0 + 32 * i; gvv[i] = (u32x4){0u, 0u, 0u, 0u}; sv[i] = 0.f;
                    if (sr < nrows) { const int row = row0 + sr; gvv[i] = *(const u32x4*)(GVb + (size_t)row * SW + h * 128 + c8 * 8); sv[i] = stv[(size_t)row * 16 + c8]; }
                }
                const float* vg = c.k->in[I_VG] + l * SW + h * 128 + c8 * 8; const float* vb = c.k->in[I_VB] + l * SW + h * 128 + c8 * 8;
                const f32x4 g0 = *(const f32x4*)vg, g1 = *(const f32x4*)(vg + 4), b0 = *(const f32x4*)vb, b1 = *(const f32x4*)(vb + 4);
#pragma unroll
                for (int tb = 0; tb < 8; ++tb) { uu[tb] = (u32x2){0u, 0u}; bsv[tb] = 0.f;
                    if (tb < ntb) { uu[tb] = *(const u32x2*)(Ub + (size_t)(row0 + 16 * tb + i15) * SW + h * 128 + 16 * wid + 4 * kq);
                                    bsv[tb] = c.k->in[I_BSP][((size_t)l * 4 + h) * 128 + 16 * tb + i15]; } }
#pragma unroll
                for (int i = 0; i < 4; ++i) *(LAS u32x4*)(tA + (r0 + 32 * i) * TP + c8 * 16) = wv[i];
#pragma unroll
                for (int i = 0; i < 4; ++i) {
                    const int sr = r0 + 32 * i;
                    float sx = sv[i]; sx += __shfl_xor(sx, 2); sx += __shfl_xor(sx, 4); sx += __shfl_xor(sx, 8);
                    const float so_ = __shfl_xor(sx, 1);
                    const float sum = (c8 & 1) ? so_ : sx, sq = (c8 & 1) ? sx : so_;
                    u32x4 outv = (u32x4){0u, 0u, 0u, 0u};
                    if (sr < nrows) {
                        float gvf[8]; unpack8(gvv[i], gvf);
                        const float mean = sum * (1.0f / SW); float var = sq * (1.0f / SW) - mean * mean; var = var < 0.f ? 0.f : var;
                        const float rstd = rsqrtf(var + EPS);
                        float vl[8];
#pragma unroll
                        for (int k = 0; k < 4; ++k) { vl[k] = (gvf[k] - mean) * rstd * g0[k] + b0[k]; vl[4 + k] = (gvf[4 + k] - mean) * rstd * g1[k] + b1[k]; }
                        if (samp) { float* so = outp + OUT_SV + (((size_t)l * NBS + sb) * DSEQ + sr) * SW + h * 128 + c8 * 8;
                            *(f32x4*)so = (f32x4){vl[0], vl[1], vl[2], vl[3]}; *(f32x4*)(so + 4) = (f32x4){vl[4], vl[5], vl[6], vl[7]}; }
                        outv = pack8(vl);
                    }
                    *(LAS u32x4*)(tB + sr * TP + c8 * 16) = outv;
                }
            }
            __syncthreads();
            f32x4 acc[8];
#pragma unroll
            for (int tb = 0; tb < 8; ++tb) acc[tb] = (f32x4){0.f, 0.f, 0.f, 0.f};
            const int q = i15 >> 2, p = lane & 3;
#pragma unroll
            for (int kk = 0; kk < 4; ++kk) {
                LAS unsigned char* vp = tB + (32 * kk + 8 * kq + q) * TP + (16 * wid + 4 * p) * 2;
                const s16x4 lo = __builtin_amdgcn_ds_read_tr16_b64_v4i16((LAS s16x4*)vp);
                const s16x4 hi = __builtin_amdgcn_ds_read_tr16_b64_v4i16((LAS s16x4*)(vp + 4 * TP));
                const bf16x8 vf = __builtin_shufflevector(lo, hi, 0, 1, 2, 3, 4, 5, 6, 7);
#pragma unroll
                for (int tb = 0; tb < 8; ++tb) if (tb >= 2 * kk && tb < ntb) {
                    const bf16x8 af = *(const LAS bf16x8*)(tA + (16 * tb + i15) * TP + kk * 64 + kq * 16);
                    acc[tb] = __builtin_amdgcn_mfma_f32_16x16x32_bf16(vf, af, acc[tb], 0, 0, 0); }
            }
#pragma unroll
            for (int tb = 0; tb < 8; ++tb) if (tb < ntb) {
                f32x4 o = acc[tb]; const u32x2 w2 = uu[tb]; const float bs = bsv[tb];
                o = (f32x4){bflo(w2.x) * (o[0] + bs), bfhi(w2.x) * (o[1] + bs), bflo(w2.y) * (o[2] + bs), bfhi(w2.y) * (o[3] + bs)};
                *(u32x2*)(cbase + (size_t)(16 * tb + i15) * D) = pack4(o);
            }
        }
    }
}
template <class Epi>
__device__ __forceinline__ void sample_gemm(const Ctx& c, const bf16_t* A, int lda, const bf16_t* Bt, int ldb, int N, int K, const Epi& E) {
    LAS unsigned char* tA = c.lds; LAS unsigned char* tB = c.lds + 128 * TP; LAS float* red = (LAS float*)(c.lds + 256 * TP);
    const int lane = c.lane, wid = c.wid, i15 = lane & 15, kq = lane >> 4, c8 = c.tid & 15, r0 = c.tid >> 4;
    const int ntn = N >> 7, ntiles = NBS * ntn, nks = K >> 7;
    for (int tile = c.bx; tile < ntiles; tile += c.G) {
        const int sb = tile / ntn, n0 = (tile - sb * ntn) * 128;
        const bf16_t* ap = A + (size_t)(MP + sb * DSEQ + r0) * lda + c8 * 8;
        const bf16_t* bp = Bt + (size_t)(n0 + r0) * ldb + c8 * 8;
        u32x4 ra[2], rb[4];
#pragma unroll
        for (int i = 0; i < 2; ++i) ra[i] = *(const u32x4*)(ap + (size_t)(32 * i) * lda);
#pragma unroll
        for (int i = 0; i < 4; ++i) rb[i] = *(const u32x4*)(bp + (size_t)(32 * i) * ldb);
        f32x4 acc[4];
#pragma unroll
        for (int tb = 0; tb < 4; ++tb) acc[tb] = (f32x4){0.f, 0.f, 0.f, 0.f};
#pragma unroll 1
        for (int ks = 0; ks < nks; ++ks) {
            __syncthreads();
#pragma unroll
            for (int i = 0; i < 2; ++i) *(LAS u32x4*)(tA + (r0 + 32 * i) * TP + c8 * 16) = ra[i];
#pragma unroll
            for (int i = 0; i < 4; ++i) *(LAS u32x4*)(tB + (r0 + 32 * i) * TP + c8 * 16) = rb[i];
            __syncthreads();
            if (ks + 1 < nks) {
#pragma unroll
                for (int i = 0; i < 2; ++i) ra[i] = *(const u32x4*)(ap + (size_t)(32 * i) * lda + (ks + 1) * 128);
#pragma unroll
                for (int i = 0; i < 4; ++i) rb[i] = *(const u32x4*)(bp + (size_t)(32 * i) * ldb + (ks + 1) * 128);
            }
#pragma unroll
            for (int kk = 0; kk < 4; ++kk) {
                const bf16x8 bf = *(const LAS bf16x8*)(tB + (16 * wid + i15) * TP + kk * 64 + kq * 16);
#pragma unroll
                for (int tb = 0; tb < 4; ++tb) {
                    const bf16x8 af = *(const LAS bf16x8*)(tA + (16 * tb + i15) * TP + kk * 64 + kq * 16);
                    acc[tb] = __builtin_amdgcn_mfma_f32_16x16x32_bf16(bf, af, acc[tb], 0, 0, 0); }
            }
        }
        E(c, acc, sb, n0, red);
    }
    __syncthreads();
}
struct EpiInS {
    const float* ssq1; const float* shw; bf16_t* A; bf16_t* U; bf16_t* GV; float* stv;
    __device__ __forceinline__ void operator()(const Ctx& c, const f32x4 (&acc)[4], int sb, int n0, LAS float* red) const {
        const int i15 = c.lane & 15, kq = c.lane >> 4;
        const unsigned rowb = (unsigned)(MP + sb * DSEQ + i15), col = (unsigned)(n0 + 16 * c.wid + 4 * kq);
        f32x4 pp[4];
#pragma unroll
        for (int tb = 0; tb < 4; ++tb) pp[tb] = ldg4(ssq1, ((rowb + 16 * tb) * 16 + kq * 4) * 4);
        const f32x4 bv = ldg4(shw + (size_t)(NBP + sb) * DIN, col * 4);
        bf16_t* const dbase = n0 < 512 ? A : (n0 < 1024 ? U - 512 : GV - 1024);
        float s1[4], s2[4];
#pragma unroll
        for (int tb = 0; tb < 4; ++tb) {
            const f32x4 p = pp[tb]; const float rstd = rsqrtf(quad_row_sum((p[0] + p[1]) + (p[2] + p[3])) * (1.0f / D) + EPS);
            f32x4 z = acc[tb] * rstd + bv;
            if (n0 >= 512) z = gelu4(z);
            s1[tb] = (z[0] + z[1]) + (z[2] + z[3]); s2[tb] = (z[0] * z[0] + z[1] * z[1]) + (z[2] * z[2] + z[3] * z[3]);
            stg2(dbase, ((rowb + 16 * tb) * 512 + col) * 2, pack4(z));
        }
        if (n0 >= 1024) {
#pragma unroll
            for (int tb = 0; tb < 4; ++tb) { const float a = quad_row_sum(s1[tb]), b = quad_row_sum(s2[tb]);
                if (kq == 0) { red[(c.wid * 64 + 16 * tb + i15) * 2] = a; red[(c.wid * 64 + 16 * tb + i15) * 2 + 1] = b; } }
            __syncthreads();
            if (c.tid < 64) {
                float a = 0.f, b = 0.f;
#pragma unroll
                for (int w = 0; w < 8; ++w) { a += red[(w * 64 + c.tid) * 2]; b += red[(w * 64 + c.tid) * 2 + 1]; }
                float* dst = stv + (size_t)(MP + sb * DSEQ + c.tid) * 16;
                *(f32x2*)(dst + ((n0 - 1024) >> 7) * 2) = (f32x2){a, b};
                if (n0 == 1024) { *(f32x4*)(dst + 8) = (f32x4){0.f, 0.f, 0.f, 0.f}; *(f32x4*)(dst + 12) = (f32x4){0.f, 0.f, 0.f, 0.f}; }
            }
        }
    }
};
struct EpiResS {
    const float* xs; const float* xres_in; float* xres; const float* gate; const float* gnext; const float* scnext; bf16_t* XG; float* ssq;
    __device__ __forceinline__ void operator()(const Ctx& c, const f32x4 (&acc)[4], int sb, int n0, LAS float* red) const {
        const int i15 = c.lane & 15, kq = c.lane >> 4, b = NBP + sb;
        const unsigned rowb = (unsigned)(MP + sb * DSEQ + i15), col = (unsigned)(n0 + 16 * c.wid + 4 * kq);
        const float* const xin = xres_in ? xres_in : xs - (size_t)MP * D;
        f32x4 xv[4];
#pragma unroll
        for (int tb = 0; tb < 4; ++tb) xv[tb] = ldg4(xin, ((rowb + 16 * tb) * D + col) * 4);
        const f32x4 gt = ldg4(gate + (size_t)b * NMOD, col * 4);
        f32x4 gm = (f32x4){0.f, 0.f, 0.f, 0.f};
        if (gnext) gm = ldg4(gnext, col * 4) * (ldg4(scnext + (size_t)b * NMOD, col * 4) + 1.0f);
        float ss[4];
#pragma unroll
        for (int tb = 0; tb < 4; ++tb) {
            const unsigned eo = (rowb + 16 * tb) * D + col;
            const f32x4 x1 = xv[tb] + gt * acc[tb];
            stg4(xres, eo * 4, x1);
            ss[tb] = (x1[0] * x1[0] + x1[1] * x1[1]) + (x1[2] * x1[2] + x1[3] * x1[3]);
            if (gnext) stg2(XG, eo * 2, pack4(x1 * gm));
        }
#pragma unroll
        for (int tb = 0; tb < 4; ++tb) { const float a = quad_row_sum(ss[tb]); if (kq == 0) red[c.wid * 64 + 16 * tb + i15] = a; }
        __syncthreads();
        if (c.tid < 64) {
            float a = 0.f;
#pragma unroll
            for (int w = 0; w < 8; ++w) a += red[w * 64 + c.tid];
            float* dst = ssq + (size_t)(MP + sb * DSEQ + c.tid) * 16;
            dst[n0 >> 7] = a;
            if (n0 == 0) { *(f32x4*)(dst + 8) = (f32x4){0.f, 0.f, 0.f, 0.f}; *(f32x4*)(dst + 12) = (f32x4){0.f, 0.f, 0.f, 0.f}; }
        }
    }
};
struct EpiFf1S {
    const float* ssq2; const float* shw; bf16_t* F1;
    __device__ __forceinline__ void operator()(const Ctx& c, const f32x4 (&acc)[4], int sb, int n0, LAS float* red) const {
        const int i15 = c.lane & 15, kq = c.lane >> 4;
        const unsigned rowb = (unsigned)(MP + sb * DSEQ + i15), col = (unsigned)(n0 + 16 * c.wid + 4 * kq);
        f32x4 pp[4];
#pragma unroll
        for (int tb = 0; tb < 4; ++tb) pp[tb] = ldg4(ssq2, ((rowb + 16 * tb) * 16 + kq * 4) * 4);
        const f32x4 bv = ldg4(shw + (size_t)(NBP + sb) * DFF, col * 4);
#pragma unroll
        for (int tb = 0; tb < 4; ++tb) {
            const f32x4 p = pp[tb]; const float rstd = rsqrtf(quad_row_sum((p[0] + p[1]) + (p[2] + p[3])) * (1.0f / D) + EPS);
            f32x4 z = acc[tb] * rstd + bv;
            z = __builtin_elementwise_max(z, (f32x4){0.f, 0.f, 0.f, 0.f}); z = z * z;
            stg2(F1, ((rowb + 16 * tb) * DFF + col) * 2, pack4(z));
        }
    }
};
__device__ void phase_final(const Ctx& c) {
    const float* ssq1 = (const float*)(c.k->ws + WS_SSQ1); const float* gf = c.k->in[I_GFIN];
    f32x4 g[4];
#pragma unroll
    for (int i = 0; i < 4; ++i) g[i] = *(const f32x4*)(gf + i * 256 + c.lane * 4);
    for (int rg = c.bx; rg < MT / 32; rg += c.G) {
        const int rowb = rg * 32 + c.wid * 4;
        float* xr = c.k->out + OUT_Y + (size_t)rowb * D;
        f32x4 x[4][4];
        float p = ssq1[(size_t)rowb * 16 + c.lane];
#pragma unroll
        for (int r = 0; r < 4; ++r)
#pragma unroll
            for (int i = 0; i < 4; ++i) x[r][i] = *(const f32x4*)(xr + r * D + i * 256 + c.lane * 4);
        p += __shfl_xor(p, 1); p += __shfl_xor(p, 2); p += __shfl_xor(p, 4); p += __shfl_xor(p, 8);
#pragma unroll
        for (int r = 0; r < 4; ++r) {
            const float rstd = rsqrtf(__shfl(p, 16 * r) * (1.0f / D) + EPS);
#pragma unroll
            for (int i = 0; i < 4; ++i) *(f32x4*)(xr + r * D + i * 256 + c.lane * 4) = x[r][i] * rstd * g[i];
        }
    }
}

#define XB_TMO      128
#define XB_XCNT(j)  (256  + 64 * (j))
#define XB_XSUB(j)  (1280 + 64 * (j))
#define XB_XGEN(j)  (2304 + 64 * (j))
#define XB_TOP      3328
#define XB_TOPGEN   3392
#define XCD_BAR_WORDS 3456
#define XB_SPIN_CAP (1u << 18)

__device__ __forceinline__ unsigned xb_ld(unsigned* p)              { return __hip_atomic_load(p, __ATOMIC_RELAXED, __HIP_MEMORY_SCOPE_AGENT); }
__device__ __forceinline__ unsigned xb_add(unsigned* p, unsigned v) { return __hip_atomic_fetch_add(p, v, __ATOMIC_RELAXED, __HIP_MEMORY_SCOPE_AGENT); }
__device__ __forceinline__ unsigned xb_xcc_id() { return (unsigned)__builtin_amdgcn_s_getreg((3 << 11) | 20) & 0xFu; }
#define XB_SPIN(cond, bar) do { unsigned _sp = 0; while (cond) { __builtin_amdgcn_s_sleep(1); \
    if ((++_sp & 255u) == 0u) { if (xb_ld(&(bar)[XB_TMO])) break; if (_sp > XB_SPIN_CAP) { atomicAdd(&(bar)[XB_TMO], 1u); break; } } } } while (0)

struct XcdBarrier {
    unsigned* bar; unsigned x;
    volatile LAS unsigned* st;
};

__device__ __forceinline__ XcdBarrier xcd_barrier_post(unsigned* bar, volatile LAS unsigned* st) {
    XcdBarrier b; b.bar = bar; b.x = xb_xcc_id(); b.st = st;
    if (threadIdx.x == 0) (void)xb_add(&bar[XB_XCNT(b.x)], 1u);
    return b;
}
__device__ __forceinline__ void xcd_barrier_complete(unsigned* bar, unsigned x, unsigned& nloc, unsigned& nx) {
    const unsigned G = gridDim.x * gridDim.y * gridDim.z;
    unsigned sum, cnt, mine, sp = 0u;
    for (;;) {
        sum = 0u; cnt = 0u; mine = 0u;
#pragma unroll
        for (unsigned j = 0; j < 16; ++j) { const unsigned c = xb_ld(&bar[XB_XCNT(j)]); sum += c; cnt += (c > 0u) ? 1u : 0u; mine = (j == x) ? c : mine; }
        if (sum == G) break;
        __builtin_amdgcn_s_sleep(1);
        if ((++sp & 255u) == 0u) { if (xb_ld(&bar[XB_TMO])) break; if (sp > XB_SPIN_CAP) { atomicAdd(&bar[XB_TMO], 1u); break; } }
    }
    nloc = mine > 0u ? mine : 1u; nx = cnt > 0u ? cnt : 1u;
}

__device__ __forceinline__ void xcd_barrier(const XcdBarrier& b) {
    asm volatile("s_waitcnt vmcnt(0)" ::: "memory");
    __syncthreads();
    if (threadIdx.x == 0) {
        unsigned* bar = b.bar;
        __builtin_amdgcn_s_waitcnt(0);
        unsigned nloc = b.st[0], nx = b.st[1];
        if (nloc == 0u) { xcd_barrier_complete(bar, b.x, nloc, nx); b.st[0] = nloc; b.st[1] = nx; }
        const unsigned old = xb_add(&bar[XB_XSUB(b.x)], 1u);
        const unsigned gen = old / nloc;
        if (old + 1u == (gen + 1u) * nloc) {
            __builtin_amdgcn_fence(__ATOMIC_RELEASE, "agent");
            asm volatile("s_waitcnt vmcnt(0)" ::: "memory");
            const unsigned og = xb_add(&bar[XB_TOP], 1u);
            const unsigned tg = og / nx;
            if (og + 1u == (tg + 1u) * nx) xb_add(&bar[XB_TOPGEN], 1u);
            else XB_SPIN(xb_ld(&bar[XB_TOPGEN]) == tg, bar);
            __builtin_amdgcn_fence(__ATOMIC_ACQUIRE, "agent");
            xb_add(&bar[XB_XGEN(b.x)], 1u);
            asm volatile("s_waitcnt vmcnt(0)" ::: "memory");
        } else {
            XB_SPIN(xb_ld(&bar[XB_XGEN(b.x)]) == gen, bar);
            __builtin_amdgcn_fence(__ATOMIC_ACQUIRE, "agent");
            asm volatile("s_waitcnt vmcnt(0)" ::: "memory");
        }
    }
    __syncthreads();
}


constexpr int NPHASE = 2 + 5 * DEPTH + 1;
__global__ void __launch_bounds__(NTHREADS, 2) mk_fwd(Params p) {
    __shared__ __attribute__((aligned(16))) unsigned char shm[pg8::STAGE_BYTES + 16];
    cg::grid_group grid = cg::this_grid();
    if (threadIdx.x < 4) ((LAS unsigned*)((LAS unsigned char*)shm + pg8::STAGE_BYTES))[threadIdx.x] = 0u;
    __syncthreads();
    XcdBarrier xbar = xcd_barrier_post((unsigned*)(p.ws + WS_BAR), (volatile LAS unsigned*)((LAS unsigned char*)shm + pg8::STAGE_BYTES));
    Ctx c;
    c.k = kargs(); c.lds = (LAS unsigned char*)shm;
    c.tid = threadIdx.x; c.lane = c.tid & 63; c.wid = __builtin_amdgcn_readfirstlane(c.tid >> 6); c.G = gridDim.x; c.bx = blockIdx.x;
#ifndef PHMASK
#define PHMASK 0xffff
#endif
#define PHON(k) ((PHMASK >> (k)) & 1)
#ifndef DUPMASK
#define DUPMASK 0
#endif
#define DUPN(k) (((DUPMASK >> (k)) & 1) ? 2 : 1)
    for (int ph = p.ph_lo; ph < p.ph_hi; ++ph) {
        { int t_ = threadIdx.x; asm volatile("" : "+v"(t_)); c.tid = t_; c.lane = t_ & 63; c.wid = __builtin_amdgcn_readfirstlane(t_ >> 6); c.k = kargs(); }
        unsigned char* ws = c.k->ws;
        const float* mod = (const float*)(ws + WS_MOD);
        if (ph == 0) { for (int r_ = 0; r_ < DUPN(0); ++r_) phase_init0(c); }
        else if (ph == 1) { for (int r_ = 0; r_ < DUPN(1); ++r_) phase_init1(c); }
        else if (ph == NPHASE - 1) { if (PHON(7)) phase_final(c); }
        else {
            const int l = (ph - 2) / 5, s = (ph - 2) % 5;
            const float* modl = mod + (size_t)l * NBT * NMOD;
            pg8::StaticOrder S;
            if (s == 0 && PHON(2)) {
                pg8::Gemm g{(const bf16_t*)(ws + WS_XG), (const bf16_t*)(ws + WS_WIN_T) + (size_t)l * DIN * D, MP, DIN, D}; S.init(MP, DIN, c.G, c.bx);
                { EpiInS Es{(const float*)(ws + WS_SSQ1), (const float*)(ws + WS_SHWIN) + (size_t)l * NBT * DIN, (bf16_t*)(ws + WS_A), (bf16_t*)(ws + WS_U), (bf16_t*)(ws + WS_GV), (float*)(ws + WS_STV)};
                  sample_gemm<EpiInS>(c, g.A, D, g.Bt, D, DIN, D, Es); }
                EpiIn E{(const float*)(ws + WS_SSQ1), (const float*)(ws + WS_SHWIN) + (size_t)l * NBT * DIN, (bf16_t*)(ws + WS_A), (bf16_t*)(ws + WS_U), (bf16_t*)(ws + WS_GV), (float*)(ws + WS_STV)};
                for (int r_ = 0; r_ < DUPN(2); ++r_) pg8::gemm_phase<EpiIn>(c.lds, g, S, E);
            } else if (s == 1 && PHON(3)) {
                for (int r_ = 0; r_ < DUPN(3); ++r_) phase_mixer(c, l);
            } else if (s == 2 && PHON(4)) {
                pg8::Gemm g{(const bf16_t*)(ws + WS_CAT), (const bf16_t*)(ws + WS_WOUT_T) + (size_t)l * D * D, MP, D, D}; S.init(MP, D, c.G, c.bx);
                { EpiResS Es{c.k->in[I_XS], l == 0 ? nullptr : c.k->out + OUT_Y, c.k->out + OUT_Y, modl + 2 * D, c.k->in[I_GFFN] + l * D, modl + 4 * D, (bf16_t*)(ws + WS_XG), (float*)(ws + WS_SSQ2)};
                  sample_gemm<EpiResS>(c, g.A, D, g.Bt, D, D, D, Es); }
                EpiRes E{c.k->in[I_XP], c.k->in[I_XS], l == 0 ? nullptr : c.k->out + OUT_Y, c.k->out + OUT_Y, modl + 2 * D, c.k->in[I_GFFN] + l * D, modl + 4 * D, (bf16_t*)(ws + WS_XG), (float*)(ws + WS_SSQ2)};
                pg8::gemm_phase<EpiRes>(c.lds, g, S, E);
            } else if (s == 3 && PHON(5)) {
                pg8::Gemm g{(const bf16_t*)(ws + WS_XG), (const bf16_t*)(ws + WS_W1_T) + (size_t)l * DFF * D, MP, DFF, D}; S.init(MP, DFF, c.G, c.bx);
                { EpiFf1S Es{(const float*)(ws + WS_SSQ2), (const float*)(ws + WS_SHW1) + (size_t)l * NBT * DFF, (bf16_t*)(ws + WS_F1)};
                  sample_gemm<EpiFf1S>(c, g.A, D, g.Bt, D, DFF, D, Es); }
                EpiFf1 E{(const float*)(ws + WS_SSQ2), (const float*)(ws + WS_SHW1) + (size_t)l * NBT * DFF, (bf16_t*)(ws + WS_F1)};
                for (int r_ = 0; r_ < DUPN(5); ++r_) pg8::gemm_phase<EpiFf1>(c.lds, g, S, E);
            } else if (s == 4 && PHON(6)) {
                pg8::Gemm g{(const bf16_t*)(ws + WS_F1), (const bf16_t*)(ws + WS_W2_T) + (size_t)l * D * DFF, MP, D, DFF}; S.init(MP, D, c.G, c.bx);
                const bool more = (l + 1 < DEPTH);
                { EpiResS Es{c.k->in[I_XS], c.k->out + OUT_Y, c.k->out + OUT_Y, modl + 5 * D, more ? c.k->in[I_GMIX] + (l + 1) * D : nullptr, mod + (size_t)(more ? l + 1 : l) * NBT * NMOD + 1 * D,
                             (bf16_t*)(ws + WS_XG), (float*)(ws + WS_SSQ1)};
                  sample_gemm<EpiResS>(c, g.A, DFF, g.Bt, DFF, D, DFF, Es); }
                EpiRes E{c.k->in[I_XP], c.k->in[I_XS], c.k->out + OUT_Y, c.k->out + OUT_Y, modl + 5 * D, more ? c.k->in[I_GMIX] + (l + 1) * D : nullptr, mod + (size_t)(more ? l + 1 : l) * NBT * NMOD + 1 * D,
                         (bf16_t*)(ws + WS_XG), (float*)(ws + WS_SSQ1)};
                pg8::gemm_phase<EpiRes>(c.lds, g, S, E);
            }
        }
        if (ph + 1 < p.ph_hi) { if (ph == p.ph_lo) grid.sync(); else xcd_barrier(xbar); }
    }
}

extern "C" void kernel_launch(void* const* d_in, const int* in_sizes, int n_in, void* d_out, int out_size, void* d_ws, size_t ws_size, hipStream_t stream) {
    static int grid_blocks = 0;
    if (!grid_blocks) {
        int dev = 0, cus = 0, per_cu = 0;
        hipGetDevice(&dev);
        hipDeviceGetAttribute(&cus, hipDeviceAttributeMultiprocessorCount, dev);
        hipOccupancyMaxActiveBlocksPerMultiprocessor(&per_cu, mk_fwd, NTHREADS, 0);
        if (per_cu < 1) per_cu = 1;
        if (per_cu > 1) per_cu = 1;
        grid_blocks = cus * per_cu;
        if (n_in != 20 || ws_size < WS_END) fprintf(stderr, "kernel_launch: unexpected n_in %d / ws_size %zu (need %zu)\n", n_in, ws_size, (size_t)WS_END);
    }
    Params p{};
    for (int i = 0; i < 20; ++i) p.in[i] = (const float*)d_in[i];
    p.out = (float*)d_out; p.ws = (unsigned char*)d_ws;
#if MK_SINGLE
    (void)hipMemsetAsync((unsigned char*)d_ws + WS_BAR, 0, WS_BAR_BYTES, stream);
    p.ph_lo = 0; p.ph_hi = NPHASE;
    { void* args[] = {&p};
      hipError_t e = hipLaunchCooperativeKernel((void*)mk_fwd, dim3(grid_blocks), dim3(NTHREADS), args, 0, stream);
      if (e != hipSuccess) fprintf(stderr, "cooperative launch failed: %s (grid %d)\n", hipGetErrorString(e), grid_blocks); }
#else
    for (int ph = 0; ph < NPHASE; ++ph) {
        p.ph_lo = ph; p.ph_hi = ph + 1;
        void* args[] = {&p};
        hipError_t e = hipLaunchCooperativeKernel((void*)mk_fwd, dim3(grid_blocks), dim3(NTHREADS), args, 0, stream);
        if (e != hipSuccess) { fprintf(stderr, "cooperative launch failed: %s (grid %d, phase %d)\n", hipGetErrorString(e), grid_blocks, ph); break; }
    }
#endif
}
```

```cpp
#include <hip/hip_runtime.h>
#include <hip/hip_cooperative_groups.h>
#include <cstdio>
namespace cg = cooperative_groups;

#ifndef MK_SINGLE
#define MK_SINGLE 1
#endif

#define LAS __attribute__((address_space(3)))
typedef unsigned short bf16_t;
typedef short bf16x8 __attribute__((ext_vector_type(8)));
typedef short s16x4 __attribute__((ext_vector_type(4)));
typedef float f32x4 __attribute__((ext_vector_type(4)));
typedef float f32x2 __attribute__((ext_vector_type(2)));
typedef unsigned u32x4 __attribute__((ext_vector_type(4)));
typedef unsigned u32x2 __attribute__((ext_vector_type(2)));

constexpr int D = 1024, NBP = 16, SEQ = 4096, MP = NBP * SEQ, NBS = 8, DSEQ = 64, MS = NBS * DSEQ, MT = MP + MS;
constexpr int DIN = 1536, DFF = 4096, DEPTH = 2, NBT = NBP + NBS, PW = 512, SW = 512, NMOD = 6 * D;
constexpr float EPS = 1e-6f;
constexpr int NTHREADS = 512;

constexpr size_t WS_WIN_T = 0;
constexpr size_t WS_WOUT_T = WS_WIN_T + (size_t)DEPTH * DIN * D * 2;
constexpr size_t WS_W1_T = WS_WOUT_T + (size_t)DEPTH * D * D * 2;
constexpr size_t WS_W2_T = WS_W1_T + (size_t)DEPTH * DFF * D * 2;
constexpr size_t WS_WP_T = WS_W2_T + (size_t)DEPTH * DFF * D * 2;
constexpr size_t WS_WSP = WS_WP_T + (size_t)DEPTH * 4 * 128 * 128 * 2;
constexpr size_t WS_MOD = WS_WSP + (size_t)DEPTH * 4 * 128 * 128 * 2;
constexpr size_t WS_SHWIN = WS_MOD + (size_t)DEPTH * NBT * NMOD * 4;
constexpr size_t WS_SHW1 = WS_SHWIN + (size_t)DEPTH * NBT * DIN * 4;
constexpr size_t WS_SSQ1 = WS_SHW1 + (size_t)DEPTH * NBT * DFF * 4;
constexpr size_t WS_SSQ2 = WS_SSQ1 + (size_t)MT * 16 * 4;
constexpr size_t WS_STV = WS_SSQ2 + (size_t)MT * 16 * 4;
constexpr size_t WS_XG = WS_STV + (size_t)MT * 16 * 4;
constexpr size_t WS_F1 = WS_XG + (size_t)MT * D * 2;
constexpr size_t WS_A = WS_F1;
constexpr size_t WS_U = WS_A + (size_t)MT * PW * 2;
constexpr size_t WS_GV = WS_U + (size_t)MT * SW * 2;
constexpr size_t WS_CAT = WS_GV + (size_t)MT * SW * 2;
constexpr size_t WS_BAR = WS_F1 + (size_t)MT * DFF * 2;
constexpr size_t WS_BAR_BYTES = 16384;
constexpr size_t WS_END = WS_BAR + WS_BAR_BYTES;

constexpr size_t OUT_Y = 0;
constexpr size_t OUT_SPP = (size_t)MT * D;
constexpr size_t OUT_SPS = OUT_SPP + (size_t)DEPTH * NBP * 15 * PW;
constexpr size_t OUT_SV = OUT_SPS + (size_t)DEPTH * NBS * 15 * PW;

struct Params {
    const float* in[20];
    float* out;
    unsigned char* ws;
    int ph_lo, ph_hi;
};
enum { I_XP = 0, I_XS, I_SPOOL, I_CP, I_CS, I_WADA, I_BADA, I_GMIX, I_WIN, I_WPOOL, I_PSCALE, I_VG, I_VB, I_WSP, I_BSP, I_WOUT, I_GFFN, I_W1, I_W2, I_GFIN };

__device__ __forceinline__ unsigned cvt_pk_bf16(float lo, float hi) { unsigned r; asm volatile("v_cvt_pk_bf16_f32 %0, %1, %2" : "=v"(r) : "v"(lo), "v"(hi)); return r; }
__device__ __forceinline__ float bflo(unsigned w) { return __uint_as_float(w << 16); }
__device__ __forceinline__ float bfhi(unsigned w) { return __uint_as_float(w & 0xffff0000u); }
__device__ __forceinline__ int batch_of(int row) { return row < MP ? (row >> 12) : NBP + ((row - MP) >> 6); }
__device__ __forceinline__ f32x2 gelu_pk(f32x2 v) {
    const f32x2 av = __builtin_elementwise_abs(v), d = av * 0.2316418882f + 1.0f;
    f32x2 t; t.x = __builtin_amdgcn_rcpf(d.x); t.y = __builtin_amdgcn_rcpf(d.y);
    f32x2 q = t * 0.5307027145f + (-0.7265760135f); q = q * t + 0.7107068705f; q = q * t + (-0.142248368f); q = q * t + 0.127414796f; q = q * t;
    const f32x2 s = (v * v) * (-0.72134752044f);
    f32x2 e; e.x = __builtin_amdgcn_exp2f(s.x); e.y = __builtin_amdgcn_exp2f(s.y);
    const f32x2 m = v * (q * e), r = v - m;
    f32x2 o; o.x = v.x < 0.f ? m.x : r.x; o.y = v.y < 0.f ? m.y : r.y; return o;
}
__device__ __forceinline__ f32x4 gelu4(f32x4 v) { f32x2 a = gelu_pk((f32x2){v[0], v[1]}), b = gelu_pk((f32x2){v[2], v[3]}); return (f32x4){a.x, a.y, b.x, b.y}; }
__device__ __forceinline__ float wave_sum(float v) {
#pragma unroll
    for (int o = 32; o >= 1; o >>= 1) v += __shfl_xor(v, o);
    return v;
}
__device__ __forceinline__ float quad_row_sum(float v) { v += __shfl_xor(v, 16); v += __shfl_xor(v, 32); return v; }

namespace pg8 {
constexpr int BM = 256, BK = 64, HALF = 128, HTB = HALF * BK * 2, STAGE_BYTES = 8 * HTB, NXCD = 8, WGM = 8;
__device__ __forceinline__ int lds_byte(int r, int c) { const int st = (r >> 4) * 2 + (c >> 5), rr = r & 15, cc = c & 31, ob = rr * 64 + cc * 2; return st * 1024 + (ob ^ (((ob >> 9) & 1) << 5)); }
__device__ __forceinline__ void stage_rc(int b, int& R, int& C) { const int st = b / 1024, sb = b % 1024, swz = sb ^ (((sb >> 9) & 1) << 5); R = (st >> 1) * 16 + swz / 64; C = (st & 1) * 32 + (swz % 64) / 2; }
struct Unit { int pm, pn; };
struct Gemm { const bf16_t* A; const bf16_t* Bt; int M, N, K; };
struct StaticOrder {
    int nM, nN, nwg, G, c;
    __device__ void init(int M, int N, int G_, int c_) { nM = M / BM; nN = N / BM; nwg = nM * nN; G = G_; c = c_; }
    __device__ bool next(int i, Unit& u) const {
        const long L = (long)i * G + c; if (L >= nwg) return false;
        int wgid = (int)L; { const int q = nwg / NXCD, r = nwg % NXCD, xcd = wgid % NXCD, off = wgid / NXCD; wgid = (xcd < r ? xcd * (q + 1) : r * (q + 1) + (xcd - r) * q) + off; }
        const int nig = WGM * nN, gid = wgid / nig, fm = gid * WGM, gsz = (nM - fm) < WGM ? (nM - fm) : WGM;
        u.pm = fm + ((wgid % nig) % gsz); u.pn = (wgid % nig) / gsz; return true;
    }
};

template <class Epi>
__device__ __forceinline__ void gemm_phase(LAS unsigned char* lds, const Gemm g, const StaticOrder& S, const Epi& E) {
    int tid_ = threadIdx.x; asm volatile("" : "+v"(tid_));
    const int tid = tid_, wid = __builtin_amdgcn_readfirstlane(tid >> 6), lane = tid & 63, wr = wid >> 2, wc = wid & 3, fr = lane & 15, fq = lane >> 4;
    const int K = g.K, nt = K / BK;
    unsigned voffA[2], voffB[2];
#pragma unroll
    for (int i = 0; i < 2; ++i) { int R, C; stage_rc(tid * 16 + i * 8192, R, C); voffA[i] = (unsigned)(R * K + C) * 2u; voffB[i] = (unsigned)(R * K + C) * 2u; }
    const size_t kstep = (size_t)(BK * 2);
    const size_t hstep = (size_t)HALF * K * 2;
    const size_t tstep = 2 * hstep;
    const unsigned ldsw = (unsigned)wid * 1024u;
    const int aoff = lds_byte(wr * 64 + fr, fq * 8), boff = lds_byte(wc * 32 + fr, fq * 8);
#define PG8_SA(b, h) (((b) * 2 + (h)) * HTB)
#define PG8_SB(b, h) ((4 + (b) * 2 + (h)) * HTB)
#define PG8_STAGE(bufoff, gbase, voff) do { _Pragma("unroll") for (int _i = 0; _i < 2; ++_i) \
        __builtin_amdgcn_global_load_lds((const unsigned*)((const char*)(gbase) + (voff)[_i]), (LAS unsigned*)(lds + (bufoff) + ldsw + _i * 8192), 16, 0, 0); } while (0)
#define PG8_LDA(dst, b, h) do { _Pragma("unroll") for (int m = 0; m < 4; ++m) _Pragma("unroll") for (int k = 0; k < 2; ++k) dst[m][k] = *(const LAS bf16x8*)(lds + PG8_SA(b, h) + aoff + m * 2048 + k * 1024); } while (0)
#define PG8_LDB(dst, b, h) do { _Pragma("unroll") for (int n = 0; n < 2; ++n) _Pragma("unroll") for (int k = 0; k < 2; ++k) dst[n][k] = *(const LAS bf16x8*)(lds + PG8_SB(b, h) + boff + n * 2048 + k * 1024); } while (0)
#define PG8_MMA(ai, bj, At, Bt) do { __builtin_amdgcn_s_setprio(1); _Pragma("unroll") for (int m = 0; m < 4; ++m) _Pragma("unroll") for (int n = 0; n < 2; ++n) _Pragma("unroll") for (int k = 0; k < 2; ++k) \
        acc[ai][bj][m][n] = __builtin_amdgcn_mfma_f32_16x16x32_bf16(Bt[n][k], At[m][k], acc[ai][bj][m][n], 0, 0, 0); __builtin_amdgcn_s_setprio(0); } while (0)
#define PG8_WAIT_V(n) asm volatile("s_waitcnt vmcnt(" #n ")" ::: "memory")
#define PG8_WAIT_L(n) asm volatile("s_waitcnt lgkmcnt(" #n ")" ::: "memory")
#define PG8_BAR __builtin_amdgcn_s_barrier()
#define PG8_SCHED __builtin_amdgcn_sched_barrier(0)
    Unit cur, nxt; int ui = 0;
    if (!S.next(0, cur)) return;
    f32x4 acc[2][2][4][2];
#pragma unroll
    for (int a = 0; a < 2; ++a)
#pragma unroll
        for (int b = 0; b < 2; ++b)
#pragma unroll
            for (int m = 0; m < 4; ++m)
#pragma unroll
                for (int n = 0; n < 2; ++n) acc[a][b][m][n] = (f32x4){0.f, 0.f, 0.f, 0.f};
    bf16x8 At[4][2], B0[2][2], B1[2][2];
    const char* cA = (const char*)g.A + (size_t)cur.pm * tstep; const char* cB = (const char*)g.Bt + (size_t)cur.pn * tstep;
    PG8_STAGE(PG8_SB(0, 0), cB, voffB); PG8_STAGE(PG8_SA(0, 0), cA, voffA); PG8_STAGE(PG8_SB(0, 1), cB + hstep, voffB); PG8_STAGE(PG8_SA(0, 1), cA + hstep, voffA);
    if (wr == 1) PG8_BAR;
    PG8_WAIT_V(4); PG8_BAR;
    PG8_STAGE(PG8_SB(1, 0), cB + kstep, voffB); PG8_STAGE(PG8_SA(1, 0), cA + kstep, voffA); PG8_STAGE(PG8_SB(1, 1), cB + hstep + kstep, voffB);
    PG8_WAIT_V(6); PG8_BAR;
    for (;;) {
        const bool has_next = S.next(ui + 1, nxt);
        const char* nA = has_next ? (const char*)g.A + (size_t)nxt.pm * tstep : cA; const char* nB = has_next ? (const char*)g.Bt + (size_t)nxt.pn * tstep : cB;
        for (int t = 0; t < nt; t += 2) {
            const bool last = (t == nt - 2);
            const char* a1 = cA + (size_t)(t + 1) * kstep;
            const char* a2 = last ? nA : cA + (size_t)(t + 2) * kstep; const char* b2 = last ? nB : cB + (size_t)(t + 2) * kstep;
            const char* a3 = a2 + kstep; const char* b3 = b2 + kstep;
            PG8_LDB(B0, 0, 0); PG8_SCHED; PG8_LDA(At, 0, 0); PG8_STAGE(PG8_SA(1, 1), a1 + hstep, voffA);
            PG8_WAIT_L(8); PG8_BAR; PG8_WAIT_L(0); PG8_MMA(0, 0, At, B0); PG8_BAR; PG8_SCHED;
            PG8_LDB(B1, 0, 1); PG8_STAGE(PG8_SB(0, 0), b2, voffB);
            PG8_BAR; PG8_WAIT_L(0); PG8_MMA(0, 1, At, B1); PG8_BAR;
            PG8_LDA(At, 0, 1); PG8_STAGE(PG8_SA(0, 0), a2, voffA);
            PG8_BAR; PG8_WAIT_L(0); PG8_MMA(1, 0, At, B0); PG8_BAR; PG8_SCHED;
            PG8_STAGE(PG8_SB(0, 1), b2 + hstep, voffB);
            PG8_WAIT_V(6); PG8_BAR; PG8_MMA(1, 1, At, B1); PG8_BAR;
            PG8_LDB(B0, 1, 0); PG8_SCHED; PG8_LDA(At, 1, 0); PG8_STAGE(PG8_SA(0, 1), a2 + hstep, voffA);
            PG8_WAIT_L(8); PG8_BAR; PG8_WAIT_L(0); PG8_MMA(0, 0, At, B0); PG8_BAR; PG8_SCHED;
            PG8_LDB(B1, 1, 1); PG8_STAGE(PG8_SB(1, 0), b3, voffB);
            PG8_BAR; PG8_WAIT_L(0); PG8_MMA(0, 1, At, B1); PG8_BAR;
            PG8_LDA(At, 1, 1); PG8_STAGE(PG8_SA(1, 0), a3, voffA);
            PG8_BAR; PG8_WAIT_L(0); PG8_MMA(1, 0, At, B0); PG8_BAR; PG8_SCHED;
            PG8_STAGE(PG8_SB(1, 1), b3 + hstep, voffB);
            PG8_WAIT_V(6); PG8_BAR; PG8_MMA(1, 1, At, B1); PG8_BAR;
        }
        E(acc, cur, wr, wc, fr, fq);
        if (!has_next) break;
#pragma unroll
        for (int a = 0; a < 2; ++a)
#pragma unroll
            for (int b = 0; b < 2; ++b)
#pragma unroll
                for (int m = 0; m < 4; ++m)
#pragma unroll
                    for (int n = 0; n < 2; ++n) acc[a][b][m][n] = (f32x4){0.f, 0.f, 0.f, 0.f};
        cur = nxt; cA = nA; cB = nB; ++ui;
    }
    PG8_WAIT_V(0);
    if (wr == 0) PG8_BAR;
    PG8_BAR;
#undef PG8_SA
#undef PG8_SB
#undef PG8_STAGE
#undef PG8_LDA
#undef PG8_LDB
#undef PG8_MMA
#undef PG8_WAIT_V
#undef PG8_WAIT_L
#undef PG8_BAR
#undef PG8_SCHED
}
}

typedef f32x4 AccT[2][2][4][2];

__device__ __forceinline__ f32x4 ldg4(const void* base, unsigned off) { return *(const f32x4*)((const char*)base + off); }
__device__ __forceinline__ void stg4(void* base, unsigned off, f32x4 v) { *(f32x4*)((char*)base + off) = v; }
__device__ __forceinline__ void stg2(void* base, unsigned off, u32x2 v) { *(u32x2*)((char*)base + off) = v; }
__device__ __forceinline__ void stf2(void* base, unsigned off, f32x2 v) { *(f32x2*)((char*)base + off) = v; }
__device__ __forceinline__ void stf1(void* base, unsigned off, float v) { *(float*)((char*)base + off) = v; }
__device__ __forceinline__ u32x2 pack4(f32x4 z) { u32x2 w; w.x = cvt_pk_bf16(z[0], z[1]); w.y = cvt_pk_bf16(z[2], z[3]); return w; }
constexpr unsigned CO[2][2] = {{0u, 16u}, {128u, 144u}};

struct EpiIn {
    const float* ssq1; const float* shw; bf16_t* A; bf16_t* U; bf16_t* GV; float* stv;
    __device__ __forceinline__ void operator()(const AccT& acc, const pg8::Unit& u, int wr, int wc, int fr, int fq) const {
        const int rowu = u.pm * 256 + wr * 64;
        const unsigned colb = (unsigned)(u.pn * 256 + wc * 32 + 4 * fq), rowb = (unsigned)(rowu + fr);
        bf16_t* const dbase = u.pn < 2 ? A : (u.pn < 4 ? U - 512 : GV - 1024);
        const float* bias = shw + (size_t)batch_of(rowu) * DIN;
        f32x4 pp[2][4], bv[2][2];
#pragma unroll
        for (int ai = 0; ai < 2; ++ai)
#pragma unroll
            for (int m = 0; m < 4; ++m) pp[ai][m] = ldg4(ssq1, ((rowb + ai * 128 + m * 16) * 16 + fq * 4) * 4);
#pragma unroll
        for (int bj = 0; bj < 2; ++bj)
#pragma unroll
            for (int n = 0; n < 2; ++n) bv[bj][n] = ldg4(bias, (colb + CO[bj][n]) * 4);
        float rstd[2][4];
#pragma unroll
        for (int ai = 0; ai < 2; ++ai)
#pragma unroll
            for (int m = 0; m < 4; ++m) { const f32x4 p = pp[ai][m]; rstd[ai][m] = rsqrtf(quad_row_sum((p[0] + p[1]) + (p[2] + p[3])) * (1.0f / D) + EPS); }
#pragma unroll
        for (int ai = 0; ai < 2; ++ai) {
            float s1[4], s2[4];
#pragma unroll
            for (int m = 0; m < 4; ++m) {
                const unsigned row = rowb + ai * 128 + m * 16;
                float t1 = 0.f, t2 = 0.f;
#pragma unroll
                for (int bj = 0; bj < 2; ++bj)
#pragma unroll
                    for (int n = 0; n < 2; ++n) {
                        f32x4 z = acc[ai][bj][m][n] * rstd[ai][m] + bv[bj][n];
                        if (u.pn >= 2) z = gelu4(z);
                        if (u.pn >= 4) { t1 += (z[0] + z[1]) + (z[2] + z[3]); t2 += (z[0] * z[0] + z[1] * z[1]) + (z[2] * z[2] + z[3] * z[3]); }
                        stg2(dbase, (row * 512 + colb + CO[bj][n]) * 2, pack4(z));
                    }
                s1[m] = t1; s2[m] = t2;
            }
            if (u.pn >= 4) {
#pragma unroll
                for (int m = 0; m < 4; ++m) {
                    const float a = quad_row_sum(s1[m]), b = quad_row_sum(s2[m]);
                    if (fq == 0) stf2(stv, ((rowb + ai * 128 + m * 16) * 16 + ((u.pn - 4) * 4 + wc) * 2) * 4, (f32x2){a, b});
                }
            }
        }
    }
};
struct EpiRes {
    const float* xp; const float* xs; const float* xres_in;
    float* xres; const float* gate;
    const float* gnext; const float* scnext;
    bf16_t* XG; float* ssq;
    __device__ __forceinline__ void operator()(const AccT& acc, const pg8::Unit& u, int wr, int wc, int fr, int fq) const {
        const int rowu = u.pm * 256 + wr * 64;
        const unsigned colb = (unsigned)(u.pn * 256 + wc * 32 + 4 * fq), rowb = (unsigned)(rowu + fr);
        const float* const xin = xres_in ? xres_in : (u.pm >= MP / 256 ? xs - (size_t)MP * D : xp);
        float ssr[8];
        f32x4 gt[2][2], gm[2][2];
        f32x4 ring[3][2][2];
        int bcur = -1;
#define ER_LOADROW(r_, slot_) do { const unsigned ro_ = (rowb + ((r_) >> 2) * 128 + ((r_) & 3) * 16) * D + colb; \
            _Pragma("unroll") for (int bj = 0; bj < 2; ++bj) _Pragma("unroll") for (int n = 0; n < 2; ++n) ring[slot_][bj][n] = ldg4(xin, (ro_ + CO[bj][n]) * 4); } while (0)
#pragma unroll
        for (int r = 0; r < 8; ++r) {
            const int ai = r >> 2, m = r & 3; const unsigned row = rowb + ai * 128 + m * 16;
            if (r == 0 || r == 4) {
                const int b = batch_of(rowu + ai * 128);
                if (b != bcur) {
                    bcur = b;
#pragma unroll
                    for (int bj = 0; bj < 2; ++bj)
#pragma unroll
                        for (int n = 0; n < 2; ++n) {
                            const unsigned co = (colb + CO[bj][n]) * 4;
                            gt[bj][n] = ldg4(gate + (size_t)b * NMOD, co);
                            if (gnext) gm[bj][n] = ldg4(gnext, co) * (ldg4(scnext + (size_t)b * NMOD, co) + 1.0f);
                            else gm[bj][n] = (f32x4){0.f, 0.f, 0.f, 0.f};
                        }
                }
            }
            if (r == 0) { ER_LOADROW(0, 0); ER_LOADROW(1, 1); }
            if (r + 2 < 8) ER_LOADROW(r + 2, (r + 2) % 3);
            float ss = 0.f;
#pragma unroll
            for (int bj = 0; bj < 2; ++bj)
#pragma unroll
                for (int n = 0; n < 2; ++n) {
                    const unsigned eo = row * D + colb + CO[bj][n];
                    const f32x4 x1 = ring[r % 3][bj][n] + gt[bj][n] * acc[ai][bj][m][n];
                    stg4(xres, eo * 4, x1);
                    ss += (x1[0] * x1[0] + x1[1] * x1[1]) + (x1[2] * x1[2] + x1[3] * x1[3]);
                    if (gnext) stg2(XG, eo * 2, pack4(x1 * gm[bj][n]));
                }
            ssr[r] = ss;
        }
#undef ER_LOADROW
#pragma unroll
        for (int r = 0; r < 8; ++r) { const float t = quad_row_sum(ssr[r]); if (fq == 0) stf1(ssq, ((rowb + (r >> 2) * 128 + (r & 3) * 16) * 16 + u.pn * 4 + wc) * 4, t); }
    }
};
struct EpiFf1 {
    const float* ssq2; const float* shw; bf16_t* F1;
    __device__ __forceinline__ void operator()(const AccT& acc, const pg8::Unit& u, int wr, int wc, int fr, int fq) const {
        const int rowu = u.pm * 256 + wr * 64;
        const unsigned colb = (unsigned)(u.pn * 256 + wc * 32 + 4 * fq), rowb = (unsigned)(rowu + fr);
        const float* bias = shw + (size_t)batch_of(rowu) * DFF;
        f32x4 pp[2][4], bv[2][2];
#pragma unroll
        for (int ai = 0; ai < 2; ++ai)
#pragma unroll
            for (int m = 0; m < 4; ++m) pp[ai][m] = ldg4(ssq2, ((rowb + ai * 128 + m * 16) * 16 + fq * 4) * 4);
#pragma unroll
        for (int bj = 0; bj < 2; ++bj)
#pragma unroll
            for (int n = 0; n < 2; ++n) bv[bj][n] = ldg4(bias, (colb + CO[bj][n]) * 4);
        float rstd[2][4];
#pragma unroll
        for (int ai = 0; ai < 2; ++ai)
#pragma unroll
            for (int m = 0; m < 4; ++m) { const f32x4 p = pp[ai][m]; rstd[ai][m] = rsqrtf(quad_row_sum((p[0] + p[1]) + (p[2] + p[3])) * (1.0f / D) + EPS); }
#pragma unroll
        for (int ai = 0; ai < 2; ++ai)
#pragma unroll
            for (int m = 0; m < 4; ++m) {
                const unsigned row = rowb + ai * 128 + m * 16;
#pragma unroll
                for (int bj = 0; bj < 2; ++bj)
#pragma unroll
                    for (int n = 0; n < 2; ++n) {
                        f32x4 z = acc[ai][bj][m][n] * rstd[ai][m] + bv[bj][n];
                        z = __builtin_elementwise_max(z, (f32x4){0.f, 0.f, 0.f, 0.f}); z = z * z;
                        stg2(F1, (row * DFF + colb + CO[bj][n]) * 2, pack4(z));
                    }
            }
    }
};

typedef const __attribute__((address_space(4))) Params* KArgs;
__device__ __forceinline__ KArgs kargs() { KArgs k = (KArgs)__builtin_amdgcn_kernarg_segment_ptr(); asm volatile("" : "+s"(k)); return k; }
struct Ctx {
    KArgs k;
    LAS unsigned char* lds; int tid, lane, wid, G, bx;
};

__device__ __forceinline__ void gemv24_unit(const Ctx& c, int mode, const float* vsrc, int vstride, const float* W, int ldw, int n0, const float* bias, float* out, int ldo) {
    LAS float* tbl = (LAS float*)c.lds;
    __syncthreads();
    for (int i = c.tid; i < NBT * D; i += NTHREADS) {
        const int b = i >> 10, k = i & 1023; float v;
        if (mode == 0) { const float x = b < NBP ? c.k->in[I_CP][b * D + k] : c.k->in[I_CS][(b - NBP) * D + k]; v = x / (1.0f + __expf(-x)); }
        else v = vsrc[(size_t)b * vstride + k];
        tbl[k * NBT + b] = v;
    }
    __syncthreads();
    const int ks = c.tid >> 6, j = c.tid & 63;
    float acc[NBT];
#pragma unroll
    for (int b = 0; b < NBT; ++b) acc[b] = 0.f;
    const float* wp = W + (size_t)(ks * 128) * ldw + n0 + j;
#pragma unroll 8
    for (int kk = 0; kk < 128; ++kk) {
        const float w = wp[(size_t)kk * ldw];
        const LAS f32x4* t4 = (const LAS f32x4*)(tbl + (ks * 128 + kk) * NBT);
#pragma unroll
        for (int q = 0; q < 6; ++q) { const f32x4 t = t4[q]; acc[4 * q + 0] += t[0] * w; acc[4 * q + 1] += t[1] * w; acc[4 * q + 2] += t[2] * w; acc[4 * q + 3] += t[3] * w; }
    }
    __syncthreads();
    LAS float* red = (LAS float*)c.lds;
#pragma unroll
    for (int b = 0; b < NBT; ++b) red[(ks * NBT + b) * 64 + j] = acc[b];
    __syncthreads();
    for (int o = c.tid; o < NBT * 64; o += NTHREADS) {
        const int b = o >> 6, jj = o & 63; float s = bias ? bias[n0 + jj] : 0.f;
#pragma unroll
        for (int q = 0; q < 8; ++q) s += red[(q * NBT + b) * 64 + jj];
        out[(size_t)b * ldo + n0 + jj] = s;
    }
}
__device__ __forceinline__ void transpose_unit(const Ctx& c, const float* W, int K, int N, int k0, int n0, bf16_t* Wt, const float* nscale) {
    LAS float* tile = (LAS float*)c.lds;
    __syncthreads();
    { const int r = c.tid >> 4, c4 = c.tid & 15;
#pragma unroll
      for (int i = 0; i < 2; ++i) { const int kk = r + 32 * i; const f32x4 v = *(const f32x4*)(W + (size_t)(k0 + kk) * N + n0 + c4 * 4);
          tile[kk * 65 + c4 * 4 + 0] = v[0]; tile[kk * 65 + c4 * 4 + 1] = v[1]; tile[kk * 65 + c4 * 4 + 2] = v[2]; tile[kk * 65 + c4 * 4 + 3] = v[3]; } }
    __syncthreads();
    { const int nn = c.tid >> 3, k8 = c.tid & 7; const float s = nscale ? nscale[n0 + nn] : 1.0f; float f[8];
#pragma unroll
      for (int j = 0; j < 8; ++j) f[j] = tile[(k8 * 8 + j) * 65 + nn] * s;
      u32x4 w; w.x = cvt_pk_bf16(f[0], f[1]); w.y = cvt_pk_bf16(f[2], f[3]); w.z = cvt_pk_bf16(f[4], f[5]); w.w = cvt_pk_bf16(f[6], f[7]);
      *(u32x4*)(Wt + (size_t)(n0 + nn) * K + k0 + k8 * 8) = w; }
}

constexpr int NU_MOD = DEPTH * (NMOD / 64);
constexpr int T_IN = 16 * 24, T_OUT = 16 * 16, T_F1 = 16 * 64, T_F2 = 64 * 16, T_LAYER = T_IN + T_OUT + T_F1 + T_F2;
constexpr int NU_TR = DEPTH * T_LAYER, NU_WP = DEPTH * 4 * 4, NU_WS = DEPTH * 4 * 4;
constexpr int NU_I0 = NU_MOD + NU_TR + NU_WP + NU_WS;
__device__ void phase_init0(const Ctx& c) {
    float* mod = (float*)(c.k->ws + WS_MOD);
    for (int u = c.bx; u < NU_I0; u += c.G) {
        if (u < NU_MOD) {
            const int l = u / (NMOD / 64), nb = u % (NMOD / 64);
            gemv24_unit(c, 0, nullptr, 0, c.k->in[I_WADA] + (size_t)l * D * NMOD, NMOD, nb * 64, c.k->in[I_BADA] + (size_t)l * NMOD, mod + (size_t)l * NBT * NMOD, NMOD);
        } else if (u < NU_MOD + NU_TR) {
            const int v = u - NU_MOD, l = v / T_LAYER; int r = v % T_LAYER;
            if (r < T_IN) transpose_unit(c, c.k->in[I_WIN] + (size_t)l * D * DIN, D, DIN, (r / 24) * 64, (r % 24) * 64, (bf16_t*)(c.k->ws + WS_WIN_T) + (size_t)l * DIN * D, nullptr);
            else if ((r -= T_IN) < T_OUT) transpose_unit(c, c.k->in[I_WOUT] + (size_t)l * D * D, D, D, (r / 16) * 64, (r % 16) * 64, (bf16_t*)(c.k->ws + WS_WOUT_T) + (size_t)l * D * D, nullptr);
            else if ((r -= T_OUT) < T_F1) transpose_unit(c, c.k->in[I_W1] + (size_t)l * D * DFF, D, DFF, (r / 64) * 64, (r % 64) * 64, (bf16_t*)(c.k->ws + WS_W1_T) + (size_t)l * DFF * D, nullptr);
            else { r -= T_F1; transpose_unit(c, c.k->in[I_W2] + (size_t)l * DFF * D, DFF, D, (r / 16) * 64, (r % 16) * 64, (bf16_t*)(c.k->ws + WS_W2_T) + (size_t)l * D * DFF, nullptr); }
        } else if (u < NU_MOD + NU_TR + NU_WP) {
            const int v = u - NU_MOD - NU_TR, lg = v >> 2, t = v & 3, l = lg >> 2, g = lg & 3;
            transpose_unit(c, c.k->in[I_WPOOL] + (size_t)lg * 128 * 128, 128, 128, (t >> 1) * 64, (t & 1) * 64, (bf16_t*)(c.k->ws + WS_WP_T) + (size_t)lg * 128 * 128, c.k->in[I_PSCALE] + l * PW + g * 128);
        } else {
            const int v = u - NU_MOD - NU_TR - NU_WP, lh = v >> 2, t = v & 3, t0 = (t >> 1) * 64, s0 = (t & 1) * 64;
            const int tt = t0 + (c.tid >> 3), s8 = s0 + (c.tid & 7) * 8;
            const float* src = c.k->in[I_WSP] + ((size_t)lh * 128 + tt) * 128 + s8;
            const f32x4 a = *(const f32x4*)src, b = *(const f32x4*)(src + 4);
            float f[8] = {a[0], a[1], a[2], a[3], b[0], b[1], b[2], b[3]};
#pragma unroll
            for (int j = 0; j < 8; ++j) if (s8 + j > tt) f[j] = 0.f;
            u32x4 w; w.x = cvt_pk_bf16(f[0], f[1]); w.y = cvt_pk_bf16(f[2], f[3]); w.z = cvt_pk_bf16(f[4], f[5]); w.w = cvt_pk_bf16(f[6], f[7]);
            *(u32x4*)((bf16_t*)(c.k->ws + WS_WSP) + ((size_t)lh * 128 + tt) * 128 + s8) = w;
        }
    }
}
constexpr int NU_SH_L = DIN / 64 + DFF / 64;
__device__ void phase_init1(const Ctx& c) {
    const float* mod = (const float*)(c.k->ws + WS_MOD);
    for (int u = c.bx; u < DEPTH * NU_SH_L; u += c.G) {
        const int l = u / NU_SH_L, r = u % NU_SH_L;
        const float* ml = mod + (size_t)l * NBT * NMOD;
        if (r < DIN / 64) gemv24_unit(c, 1, ml + 0 * D, NMOD, c.k->in[I_WIN] + (size_t)l * D * DIN, DIN, r * 64, nullptr, (float*)(c.k->ws + WS_SHWIN) + (size_t)l * NBT * DIN, DIN);
        else gemv24_unit(c, 1, ml + 3 * D, NMOD, c.k->in[I_W1] + (size_t)l * D * DFF, DFF, (r - DIN / 64) * 64, nullptr, (float*)(c.k->ws + WS_SHW1) + (size_t)l * NBT * DFF, DFF);
    }
    bf16_t* XG = (bf16_t*)(c.k->ws + WS_XG); float* ssq1 = (float*)(c.k->ws + WS_SSQ1);
    const float* gm = c.k->in[I_GMIX];
    for (int rg = c.bx; rg < MT / 32; rg += c.G) {
        const int rowb = rg * 32 + c.wid * 4, b = batch_of(rowb);
        const float* sc = mod + (size_t)b * NMOD + 1 * D;
        f32x4 x[4][4], gmul[4];
#pragma unroll
        for (int r = 0; r < 4; ++r) { const int row = rowb + r;
            const float* xr = row < MP ? c.k->in[I_XP] + (size_t)row * D : c.k->in[I_XS] + (size_t)(row - MP) * D;
#pragma unroll
            for (int i = 0; i < 4; ++i) x[r][i] = *(const f32x4*)(xr + i * 256 + c.lane * 4); }
#pragma unroll
        for (int i = 0; i < 4; ++i) { const int k = i * 256 + c.lane * 4; gmul[i] = *(const f32x4*)(gm + k) * (*(const f32x4*)(sc + k) + 1.0f); }
#pragma unroll
        for (int r = 0; r < 4; ++r) {
            float ss = 0.f;
#pragma unroll
            for (int i = 0; i < 4; ++i) { const f32x4 v = x[r][i]; ss += (v[0] * v[0] + v[1] * v[1]) + (v[2] * v[2] + v[3] * v[3]);
                *(u32x2*)(XG + (size_t)(rowb + r) * D + i * 256 + c.lane * 4) = pack4(v * gmul[i]); }
            ss = wave_sum(ss);
            if (c.lane < 16) ssq1[(size_t)(rowb + r) * 16 + c.lane] = c.lane == 0 ? ss : 0.f;
        }
    }
}
constexpr int TP = 272;
__device__ __forceinline__ void unpack8(u32x4 v, float* f) { f[0] = bflo(v.x); f[1] = bfhi(v.x); f[2] = bflo(v.y); f[3] = bfhi(v.y); f[4] = bflo(v.z); f[5] = bfhi(v.z); f[6] = bflo(v.w); f[7] = bfhi(v.w); }
__device__ __forceinline__ u32x4 pack8(const float* f) { u32x4 w; w.x = cvt_pk_bf16(f[0], f[1]); w.y = cvt_pk_bf16(f[2], f[3]); w.z = cvt_pk_bf16(f[4], f[5]); w.w = cvt_pk_bf16(f[6], f[7]); return w; }
__device__ void phase_mixer(const Ctx& c, int l) {
    LAS unsigned char* tA = c.lds; LAS unsigned char* tB = c.lds + 128 * TP; LAS unsigned char* tX = c.lds + 256 * TP;
    unsigned char* ws = c.k->ws; float* outp = c.k->out;
    const bf16_t* Ab = (const bf16_t*)(ws + WS_A); const bf16_t* Ub = (const bf16_t*)(ws + WS_U); const bf16_t* GVb = (const bf16_t*)(ws + WS_GV);
    bf16_t* CAT = (bf16_t*)(ws + WS_CAT); const float* stv = (const float*)(ws + WS_STV);
    const bf16_t* WpT = (const bf16_t*)(ws + WS_WP_T) + (size_t)l * 4 * 128 * 128;
    const bf16_t* Wsp = (const bf16_t*)(ws + WS_WSP) + (size_t)l * 4 * 128 * 128;
    const int lane = c.lane, wid = c.wid, i15 = lane & 15, kq = lane >> 4, c8 = c.tid & 15, r0 = c.tid >> 4;
    constexpr int NCH = MP / 128 + NBS;
    for (int u = c.bx; u < NCH * 8; u += c.G) {
        const int ct = u >> 3, j = (u + (u >> 8)) & 7;
        const bool samp = ct >= MP / 128;
        const int sb = ct - MP / 128;
        const int row0 = samp ? MP + sb * DSEQ : ct * 128, nrows = samp ? DSEQ : 128, bm = samp ? NBP + sb : (ct >> 5), tseq0 = samp ? SEQ : (ct & 31) * 128;
        const int ntb = nrows >> 4;
        bf16_t* const cbase = CAT + (size_t)row0 * D + (j < 4 ? j * 128 : 512 + (j - 4) * 128) + 16 * wid + 4 * kq;
        __syncthreads();
        if (j < 4) {
            const int g = j, w = 2 << g;
            {
                u32x4 wv[4], xv[5];
#pragma unroll
                for (int i = 0; i < 4; ++i) wv[i] = *(const u32x4*)(WpT + ((size_t)g * 128 + r0 + 32 * i) * 128 + c8 * 8);
                const bf16_t* ap = Ab + (size_t)row0 * PW + g * 128 + c8 * 8;
#pragma unroll
                for (int i = 0; i < 5; ++i) {
                    const int rr = r0 + 32 * i, t = rr - 15;
                    xv[i] = (u32x4){0u, 0u, 0u, 0u};
                    if (rr < 143 && t < nrows) {
                        if (t >= 0 || (!samp && tseq0 > 0)) xv[i] = *(const u32x4*)(ap + (ptrdiff_t)t * PW);
                        else if (samp) { const float* sp = c.k->in[I_SPOOL] + (((size_t)l * NBS + sb) * 15 + rr) * PW + g * 128 + c8 * 8;
                            const f32x4 p0 = *(const f32x4*)sp, p1 = *(const f32x4*)(sp + 4);
                            xv[i].x = cvt_pk_bf16(p0[0], p0[1]); xv[i].y = cvt_pk_bf16(p0[2], p0[3]); xv[i].z = cvt_pk_bf16(p1[0], p1[1]); xv[i].w = cvt_pk_bf16(p1[2], p1[3]); }
                    }
                }
#pragma unroll
                for (int i = 0; i < 4; ++i) *(LAS u32x4*)(tB + (r0 + 32 * i) * TP + c8 * 16) = wv[i];
#pragma unroll
                for (int i = 0; i < 5; ++i) { const int rr = r0 + 32 * i; if (rr < 143) *(LAS u32x4*)(tX + rr * TP + c8 * 16) = xv[i]; }
            }
            __syncthreads();
#pragma unroll 1
            for (int i = 0; i < 4; ++i) {
                const int t = r0 + 32 * i;
                if (t < nrows) {
                    const LAS unsigned char* xp0 = tX + (t + 15) * TP + c8 * 16;
                    float a0[8], s[8], tmp[8];
                    unpack8(*(const LAS u32x4*)xp0, a0);
#pragma unroll
                    for (int k = 0; k < 8; ++k) s[k] = a0[k];
#pragma unroll 2
                    for (int jj = 1; jj < w; ++jj) { unpack8(*(const LAS u32x4*)(xp0 - jj * TP), tmp);
#pragma unroll
                        for (int k = 0; k < 8; ++k) s[k] += tmp[k]; }
                    const int pos1 = tseq0 + t + 1; const float inv = 1.0f / (float)(pos1 < w ? pos1 : w);
                    float dd[8];
#pragma unroll
                    for (int k = 0; k < 8; ++k) dd[k] = s[k] * inv - a0[k];
                    *(LAS u32x4*)(tA + t * TP + c8 * 16) = pack8(dd);
                    float* so = nullptr;
                    if (!samp && (ct & 31) == 31 && t >= 113) so = outp + OUT_SPP + (((size_t)l * NBP + bm) * 15 + (t - 113)) * PW + g * 128 + c8 * 8;
                    if (samp && t >= 49) so = outp + OUT_SPS + (((size_t)l * NBS + sb) * 15 + (t - 49)) * PW + g * 128 + c8 * 8;
                    if (so) { *(f32x4*)so = (f32x4){a0[0], a0[1], a0[2], a0[3]}; *(f32x4*)(so + 4) = (f32x4){a0[4], a0[5], a0[6], a0[7]}; }
                }
            }
            __syncthreads();
            f32x4 acc[8];
#pragma unroll
            for (int tb = 0; tb < 8; ++tb) acc[tb] = (f32x4){0.f, 0.f, 0.f, 0.f};
#pragma unroll
            for (int kk = 0; kk < 4; ++kk) {
                const bf16x8 bf = *(const LAS bf16x8*)(tB + (16 * wid + i15) * TP + kk * 64 + kq * 16);
#pragma unroll
                for (int tb = 0; tb < 8; ++tb) if (tb < ntb) {
                    const bf16x8 af = *(const LAS bf16x8*)(tA + (16 * tb + i15) * TP + kk * 64 + kq * 16);
                    acc[tb] = __builtin_amdgcn_mfma_f32_16x16x32_bf16(bf, af, acc[tb], 0, 0, 0); }
            }
#pragma unroll
            for (int tb = 0; tb < 8; ++tb) if (tb < ntb) *(u32x2*)(cbase + (size_t)(16 * tb + i15) * D) = pack4(acc[tb]);
        } else {
            const int h = j - 4;
            u32x2 uu[8]; float bsv[8];
            {
                u32x4 wv[4], gvv[4]; float sv[4];
#pragma unroll
                for (int i = 0; i < 4; ++i) wv[i] = *(const u32x4*)(Wsp + ((size_t)h * 128 + r0 + 32 * i) * 128 + c8 * 8);
#pragma unroll
                for (int i = 0; i < 4; ++i) {
                    const int sr = r0 + 32 * i; gvv[i] = (u32x4){0u, 0u, 0u, 0u}; sv[i] = 0.f;
                    if (sr < nrows) { const int row = row0 + sr; gvv[i] = *(const u32x4*)(GVb + (size_t)row * SW + h * 128 + c8 * 8); sv[i] = stv[(size_t)row * 16 + c8]; }
                }
                const float* vg = c.k->in[I_VG] + l * SW + h * 128 + c8 * 8; const float* vb = c.k->in[I_VB] + l * SW + h * 128 + c8 * 8;
                const f32x4 g0 = *(const f32x4*)vg, g1 = *(const f32x4*)(vg + 4), b0 = *(const f32x4*)vb, b1 = *(const f32x4*)(vb + 4);
#pragma unroll
                for (int tb = 0; tb < 8; ++tb) { uu[tb] = (u32x2){0u, 0u}; bsv[tb] = 0.f;
                    if (tb < ntb) { uu[tb] = *(const u32x2*)(Ub + (size_t)(row0 + 16 * tb + i15) * SW + h * 128 + 16 * wid + 4 * kq);
                                    bsv[tb] = c.k->in[I_BSP][((size_t)l * 4 + h) * 128 + 16 * tb + i15]; } }
#pragma unroll
                for (int i = 0; i < 4; ++i) *(LAS u32x4*)(tA + (r0 + 32 * i) * TP + c8 * 16) = wv[i];
#pragma unroll
                for (int i = 0; i < 4; ++i) {
                    const int sr = r0 + 32 * i;
                    float sx = sv[i]; sx += __shfl_xor(sx, 2); sx += __shfl_xor(sx, 4); sx += __shfl_xor(sx, 8);
                    const float so_ = __shfl_xor(sx, 1);
                    const float sum = (c8 & 1) ? so_ : sx, sq = (c8 & 1) ? sx : so_;
                    u32x4 outv = (u32x4){0u, 0u, 0u, 0u};
                    if (sr < nrows) {
                        float gvf[8]; unpack8(gvv[i], gvf);
                        const float mean = sum * (1.0f / SW); float var = sq * (1.0f / SW) - mean * mean; var = var < 0.f ? 0.f : var;
                        const float rstd = rsqrtf(var + EPS);
                        float vl[8];
#pragma unroll
                        for (int k = 0; k < 4; ++k) { vl[k] = (gvf[k] - mean) * rstd * g0[k] + b0[k]; vl[4 + k] = (gvf[4 + k] - mean) * rstd * g1[k] + b1[k]; }
                        if (samp) { float* so = outp + OUT_SV + (((size_t)l * NBS + sb) * DSEQ + sr) * SW + h * 128 + c8 * 8;
                            *(f32x4*)so = (f32x4){vl[0], vl[1], vl[2], vl[3]}; *(f32x4*)(so + 4) = (f32x4){vl[4], vl[5], vl[6], vl[7]}; }
                        outv = pack8(vl);
                    }
                    *(LAS u32x4*)(tB + sr * TP + c8 * 16) = outv;
                }
            }
            __syncthreads();
            f32x4 acc[8];
#pragma unroll
            for (int tb = 0; tb < 8; ++tb) acc[tb] = (f32x4){0.f, 0.f, 0.f, 0.f};
            const int q = i15 >> 2, p = lane & 3;
#pragma unroll
            for (int kk = 0; kk < 4; ++kk) {
                LAS unsigned char* vp = tB + (32 * kk + 8 * kq + q) * TP + (16 * wid + 4 * p) * 2;
                const s16x4 lo = __builtin_amdgcn_ds_read_tr16_b64_v4i16((LAS s16x4*)vp);
                const s16x4 hi = __builtin_amdgcn_ds_read_tr16_b64_v4i16((LAS s16x4*)(vp + 4 * TP));
                const bf16x8 vf = __builtin_shufflevector(lo, hi, 0, 1, 2, 3, 4, 5, 6, 7);
#pragma unroll
                for (int tb = 0; tb < 8; ++tb) if (tb >= 2 * kk && tb < ntb) {
                    const bf16x8 af = *(const LAS bf16x8*)(tA + (16 * tb + i15) * TP + kk * 64 + kq * 16);
                    acc[tb] = __builtin_amdgcn_mfma_f32_16x16x32_bf16(vf, af, acc[tb], 0, 0, 0); }
            }
#pragma unroll
            for (int tb = 0; tb < 8; ++tb) if (tb < ntb) {
                f32x4 o = acc[tb]; const u32x2 w2 = uu[tb]; const float bs = bsv[tb];
                o = (f32x4){bflo(w2.x) * (o[0] + bs), bfhi(w2.x) * (o[1] + bs), bflo(w2.y) * (o[2] + bs), bfhi(w2.y) * (o[3] + bs)};
                *(u32x2*)(cbase + (size_t)(16 * tb + i15) * D) = pack4(o);
            }
        }
    }
}
template <class Epi>
__device__ __forceinline__ void sample_gemm(const Ctx& c, const bf16_t* A, int lda, const bf16_t* Bt, int ldb, int N, int K, const Epi& E) {
    LAS unsigned char* tA = c.lds; LAS unsigned char* tB = c.lds + 128 * TP; LAS float* red = (LAS float*)(c.lds + 256 * TP);
    const int lane = c.lane, wid = c.wid, i15 = lane & 15, kq = lane >> 4, c8 = c.tid & 15, r0 = c.tid >> 4;
    const int ntn = N >> 7, ntiles = NBS * ntn, nks = K >> 7;
    for (int tile = c.bx; tile < ntiles; tile += c.G) {
        const int sb = tile / ntn, n0 = (tile - sb * ntn) * 128;
        const bf16_t* ap = A + (size_t)(MP + sb * DSEQ + r0) * lda + c8 * 8;
        const bf16_t* bp = Bt + (size_t)(n0 + r0) * ldb + c8 * 8;
        u32x4 ra[2], rb[4];
#pragma unroll
        for (int i = 0; i < 2; ++i) ra[i] = *(const u32x4*)(ap + (size_t)(32 * i) * lda);
#pragma unroll
        for (int i = 0; i < 4; ++i) rb[i] = *(const u32x4*)(bp + (size_t)(32 * i) * ldb);
        f32x4 acc[4];
#pragma unroll
        for (int tb = 0; tb < 4; ++tb) acc[tb] = (f32x4){0.f, 0.f, 0.f, 0.f};
#pragma unroll 1
        for (int ks = 0; ks < nks; ++ks) {
            __syncthreads();
#pragma unroll
            for (int i = 0; i < 2; ++i) *(LAS u32x4*)(tA + (r0 + 32 * i) * TP + c8 * 16) = ra[i];
#pragma unroll
            for (int i = 0; i < 4; ++i) *(LAS u32x4*)(tB + (r0 + 32 * i) * TP + c8 * 16) = rb[i];
            __syncthreads();
            if (ks + 1 < nks) {
#pragma unroll
                for (int i = 0; i < 2; ++i) ra[i] = *(const u32x4*)(ap + (size_t)(32 * i) * lda + (ks + 1) * 128);
#pragma unroll
                for (int i = 0; i < 4; ++i) rb[i] = *(const u32x4*)(bp + (size_t)(32 * i) * ldb + (ks + 1) * 128);
            }
#pragma unroll
            for (int kk = 0; kk < 4; ++kk) {
                const bf16x8 bf = *(const LAS bf16x8*)(tB + (16 * wid + i15) * TP + kk * 64 + kq * 16);
#pragma unroll
                for (int tb = 0; tb < 4; ++tb) {
                    const bf16x8 af = *(const LAS bf16x8*)(tA + (16 * tb + i15) * TP + kk * 64 + kq * 16);
                    acc[tb] = __builtin_amdgcn_mfma_f32_16x16x32_bf16(bf, af, acc[tb], 0, 0, 0); }
            }
        }
        E(c, acc, sb, n0, red);
    }
    __syncthreads();
}
struct EpiInS {
    const float* ssq1; const float* shw; bf16_t* A; bf16_t* U; bf16_t* GV; float* stv;
    __device__ __forceinline__ void operator()(const Ctx& c, const f32x4 (&acc)[4], int sb, int n0, LAS float* red) const {
        const int i15 = c.lane & 15, kq = c.lane >> 4;
        const unsigned rowb = (unsigned)(MP + sb * DSEQ + i15), col = (unsigned)(n0 + 16 * c.wid + 4 * kq);
        f32x4 pp[4];
#pragma unroll
        for (int tb = 0; tb < 4; ++tb) pp[tb] = ldg4(ssq1, ((rowb + 16 * tb) * 16 + kq * 4) * 4);
        const f32x4 bv = ldg4(shw + (size_t)(NBP + sb) * DIN, col * 4);
        bf16_t* const dbase = n0 < 512 ? A : (n0 < 1024 ? U - 512 : GV - 1024);
        float s1[4], s2[4];
#pragma unroll
        for (int tb = 0; tb < 4; ++tb) {
            const f32x4 p = pp[tb]; const float rstd = rsqrtf(quad_row_sum((p[0] + p[1]) + (p[2] + p[3])) * (1.0f / D) + EPS);
            f32x4 z = acc[tb] * rstd + bv;
            if (n0 >= 512) z = gelu4(z);
            s1[tb] = (z[0] + z[1]) + (z[2] + z[3]); s2[tb] = (z[0] * z[0] + z[1] * z[1]) + (z[2] * z[2] + z[3] * z[3]);
            stg2(dbase, ((rowb + 16 * tb) * 512 + col) * 2, pack4(z));
        }
        if (n0 >= 1024) {
#pragma unroll
            for (int tb = 0; tb < 4; ++tb) { const float a = quad_row_sum(s1[tb]), b = quad_row_sum(s2[tb]);
                if (kq == 0) { red[(c.wid * 64 + 16 * tb + i15) * 2] = a; red[(c.wid * 64 + 16 * tb + i15) * 2 + 1] = b; } }
            __syncthreads();
            if (c.tid < 64) {
                float a = 0.f, b = 0.f;
#pragma unroll
                for (int w = 0; w < 8; ++w) { a += red[(w * 64 + c.tid) * 2]; b += red[(w * 64 + c.tid) * 2 + 1]; }
                float* dst = stv + (size_t)(MP + sb * DSEQ + c.tid) * 16;
                *(f32x2*)(dst + ((n0 - 1024) >> 7) * 2) = (f32x2){a, b};
                if (n0 == 1024) { *(f32x4*)(dst + 8) = (f32x4){0.f, 0.f, 0.f, 0.f}; *(f32x4*)(dst + 12) = (f32x4){0.f, 0.f, 0.f, 0.f}; }
            }
        }
    }
};
struct EpiResS {
    const float* xs; const float* xres_in; float* xres; const float* gate; const float* gnext; const float* scnext; bf16_t* XG; float* ssq;
    __device__ __forceinline__ void operator()(const Ctx& c, const f32x4 (&acc)[4], int sb, int n0, LAS float* red) const {
        const int i15 = c.lane & 15, kq = c.lane >> 4, b = NBP + sb;
        const unsigned rowb = (unsigned)(MP + sb * DSEQ + i15), col = (unsigned)(n0 + 16 * c.wid + 4 * kq);
        const float* const xin = xres_in ? xres_in : xs - (size_t)MP * D;
        f32x4 xv[4];
#pragma unroll
        for (int tb = 0; tb < 4; ++tb) xv[tb] = ldg4(xin, ((rowb + 16 * tb) * D + col) * 4);
        const f32x4 gt = ldg4(gate + (size_t)b * NMOD, col * 4);
        f32x4 gm = (f32x4){0.f, 0.f, 0.f, 0.f};
        if (gnext) gm = ldg4(gnext, col * 4) * (ldg4(scnext + (size_t)b * NMOD, col * 4) + 1.0f);
        float ss[4];
#pragma unroll
        for (int tb = 0; tb < 4; ++tb) {
            const unsigned eo = (rowb + 16 * tb) * D + col;
            const f32x4 x1 = xv[tb] + gt * acc[tb];
            stg4(xres, eo * 4, x1);
            ss[tb] = (x1[0] * x1[0] + x1[1] * x1[1]) + (x1[2] * x1[2] + x1[3] * x1[3]);
            if (gnext) stg2(XG, eo * 2, pack4(x1 * gm));
        }
#pragma unroll
        for (int tb = 0; tb < 4; ++tb) { const float a = quad_row_sum(ss[tb]); if (kq == 0) red[c.wid * 64 + 16 * tb + i15] = a; }
        __syncthreads();
        if (c.tid < 64) {
            float a = 0.f;
#pragma unroll
            for (int w = 0; w < 8; ++w) a += red[w * 64 + c.tid];
            float* dst = ssq + (size_t)(MP + sb * DSEQ + c.tid) * 16;
            dst[n0 >> 7] = a;
            if (n0 == 0) { *(f32x4*)(dst + 8) = (f32x4){0.f, 0.f, 0.f, 0.f}; *(f32x4*)(dst + 12) = (f32x4){0.f, 0.f, 0.f, 0.f}; }
        }
    }
};
struct EpiFf1S {
    const float* ssq2; const float* shw; bf16_t* F1;
    __device__ __forceinline__ void operator()(const Ctx& c, const f32x4 (&acc)[4], int sb, int n0, LAS float* red) const {
        const int i15 = c.lane & 15, kq = c.lane >> 4;
        const unsigned rowb = (unsigned)(MP + sb * DSEQ + i15), col = (unsigned)(n0 + 16 * c.wid + 4 * kq);
        f32x4 pp[4];
#pragma unroll
        for (int tb = 0; tb < 4; ++tb) pp[tb] = ldg4(ssq2, ((rowb + 16 * tb) * 16 + kq * 4) * 4);
        const f32x4 bv = ldg4(shw + (size_t)(NBP + sb) * DFF, col * 4);
#pragma unroll
        for (int tb = 0; tb < 4; ++tb) {
            const f32x4 p = pp[tb]; const float rstd = rsqrtf(quad_row_sum((p[0] + p[1]) + (p[2] + p[3])) * (1.0f / D) + EPS);
            f32x4 z = acc[tb] * rstd + bv;
            z = __builtin_elementwise_max(z, (f32x4){0.f, 0.f, 0.f, 0.f}); z = z * z;
            stg2(F1, ((rowb + 16 * tb) * DFF + col) * 2, pack4(z));
        }
    }
};
__device__ void phase_final(const Ctx& c) {
    const float* ssq1 = (const float*)(c.k->ws + WS_SSQ1); const float* gf = c.k->in[I_GFIN];
    f32x4 g[4];
#pragma unroll
    for (int i = 0; i < 4; ++i) g[i] = *(const f32x4*)(gf + i * 256 + c.lane * 4);
    for (int rg = c.bx; rg < MT / 32; rg += c.G) {
        const int rowb = rg * 32 + c.wid * 4;
        float* xr = c.k->out + OUT_Y + (size_t)rowb * D;
        f32x4 x[4][4];
        float p = ssq1[(size_t)rowb * 16 + c.lane];
#pragma unroll
        for (int r = 0; r < 4; ++r)
#pragma unroll
            for (int i = 0; i < 4; ++i) x[r][i] = *(const f32x4*)(xr + r * D + i * 256 + c.lane * 4);
        p += __shfl_xor(p, 1); p += __shfl_xor(p, 2); p += __shfl_xor(p, 4); p += __shfl_xor(p, 8);
#pragma unroll
        for (int r = 0; r < 4; ++r) {
            const float rstd = rsqrtf(__shfl(p, 16 * r) * (1.0f / D) + EPS);
#pragma unroll
            for (int i = 0; i < 4; ++i) *(f32x4*)(xr + r * D + i * 256 + c.lane * 4) = x[r][i] * rstd * g[i];
        }
    }
}

#define XB_TMO      128
#define XB_XCNT(j)  (256  + 64 * (j))
#define XB_XSUB(j)  (1280 + 64 * (j))
#define XB_XGEN(j)  (2304 + 64 * (j))
#define XB_TOP      3328
#define XB_TOPGEN   3392
#define XCD_BAR_WORDS 3456
#define XB_SPIN_CAP (1u << 18)

__device__ __forceinline__ unsigned xb_ld(unsigned* p)              { return __hip_atomic_load(p, __ATOMIC_RELAXED, __HIP_MEMORY_SCOPE_AGENT); }
__device__ __forceinline__ unsigned xb_add(unsigned* p, unsigned v) { return __hip_atomic_fetch_add(p, v, __ATOMIC_RELAXED, __HIP_MEMORY_SCOPE_AGENT); }
__device__ __forceinline__ unsigned xb_xcc_id() { return (unsigned)__builtin_amdgcn_s_getreg((3 << 11) | 20) & 0xFu; }
#define XB_SPIN(cond, bar) do { unsigned _sp = 0; while (cond) { __builtin_amdgcn_s_sleep(1); \
    if ((++_sp & 255u) == 0u) { if (xb_ld(&(bar)[XB_TMO])) break; if (_sp > XB_SPIN_CAP) { atomicAdd(&(bar)[XB_TMO], 1u); break; } } } } while (0)

struct XcdBarrier {
    unsigned* bar; unsigned x;
    volatile LAS unsigned* st;
};

__device__ __forceinline__ XcdBarrier xcd_barrier_post(unsigned* bar, volatile LAS unsigned* st) {
    XcdBarrier b; b.bar = bar; b.x = xb_xcc_id(); b.st = st;
    if (threadIdx.x == 0) (void)xb_add(&bar[XB_XCNT(b.x)], 1u);
    return b;
}
__device__ __forceinline__ void xcd_barrier_complete(unsigned* bar, unsigned x, unsigned& nloc, unsigned& nx) {
    const unsigned G = gridDim.x * gridDim.y * gridDim.z;
    unsigned sum, cnt, mine, sp = 0u;
    for (;;) {
        sum = 0u; cnt = 0u; mine = 0u;
#pragma unroll
        for (unsigned j = 0; j < 16; ++j) { const unsigned c = xb_ld(&bar[XB_XCNT(j)]); sum += c; cnt += (c > 0u) ? 1u : 0u; mine = (j == x) ? c : mine; }
        if (sum == G) break;
        __builtin_amdgcn_s_sleep(1);
        if ((++sp & 255u) == 0u) { if (xb_ld(&bar[XB_TMO])) break; if (sp > XB_SPIN_CAP) { atomicAdd(&bar[XB_TMO], 1u); break; } }
    }
    nloc = mine > 0u ? mine : 1u; nx = cnt > 0u ? cnt : 1u;
}

__device__ __forceinline__ void xcd_barrier(const XcdBarrier& b) {
    asm volatile("s_waitcnt vmcnt(0)" ::: "memory");
    __syncthreads();
    if (threadIdx.x == 0) {
        unsigned* bar = b.bar;
        __builtin_amdgcn_s_waitcnt(0);
        unsigned nloc = b.st[0], nx = b.st[1];
        if (nloc == 0u) { xcd_barrier_complete(bar, b.x, nloc, nx); b.st[0] = nloc; b.st[1] = nx; }
        const unsigned old = xb_add(&bar[XB_XSUB(b.x)], 1u);
        const unsigned gen = old / nloc;
        if (old + 1u == (gen + 1u) * nloc) {
            __builtin_amdgcn_fence(__ATOMIC_RELEASE, "agent");
            asm volatile("s_waitcnt vmcnt(0)" ::: "memory");
            const unsigned og = xb_add(&bar[XB_TOP], 1u);
            const unsigned tg = og / nx;
            if (og + 1u == (tg + 1u) * nx) xb_add(&bar[XB_TOPGEN], 1u);
            else XB_SPIN(xb_ld(&bar[XB_TOPGEN]) == tg, bar);
            __builtin_amdgcn_fence(__ATOMIC_ACQUIRE, "agent");
            xb_add(&bar[XB_XGEN(b.x)], 1u);
            asm volatile("s_waitcnt vmcnt(0)" ::: "memory");
        } else {
            XB_SPIN(xb_ld(&bar[XB_XGEN(b.x)]) == gen, bar);
            __builtin_amdgcn_fence(__ATOMIC_ACQUIRE, "agent");
            asm volatile("s_waitcnt vmcnt(0)" ::: "memory");
        }
    }
    __syncthreads();
}


constexpr int NPHASE = 2 + 5 * DEPTH + 1;
__global__ void __launch_bounds__(NTHREADS, 2) mk_fwd(Params p) {
    __shared__ __attribute__((aligned(16))) unsigned char shm[pg8::STAGE_BYTES + 16];
    cg::grid_group grid = cg::this_grid();
    if (threadIdx.x < 4) ((LAS unsigned*)((LAS unsigned char*)shm + pg8::STAGE_BYTES))[threadIdx.x] = 0u;
    __syncthreads();
    XcdBarrier xbar = xcd_barrier_post((unsigned*)(p.ws + WS_BAR), (volatile LAS unsigned*)((LAS unsigned char*)shm + pg8::STAGE_BYTES));
    Ctx c;
    c.k = kargs(); c.lds = (LAS unsigned char*)shm;
    c.tid = threadIdx.x; c.lane = c.tid & 63; c.wid = __builtin_amdgcn_readfirstlane(c.tid >> 6); c.G = gridDim.x; c.bx = blockIdx.x;
#ifndef PHMASK
#define PHMASK 0xffff
#endif
#define PHON(k) ((PHMASK >> (k)) & 1)
#ifndef DUPMASK
#define DUPMASK 0
#endif
#define DUPN(k) (((DUPMASK >> (k)) & 1) ? 2 : 1)
    for (int ph = p.ph_lo; ph < p.ph_hi; ++ph) {
        { int t_ = threadIdx.x; asm volatile("" : "+v"(t_)); c.tid = t_; c.lane = t_ & 63; c.wid = __builtin_amdgcn_readfirstlane(t_ >> 6); c.k = kargs(); }
        unsigned char* ws = c.k->ws;
        const float* mod = (const float*)(ws + WS_MOD);
        if (ph == 0) { for (int r_ = 0; r_ < DUPN(0); ++r_) phase_init0(c); }
        else if (ph == 1) { for (int r_ = 0; r_ < DUPN(1); ++r_) phase_init1(c); }
        else if (ph == NPHASE - 1) { if (PHON(7)) phase_final(c); }
        else {
            const int l = (ph - 2) / 5, s = (ph - 2) % 5;
            const float* modl = mod + (size_t)l * NBT * NMOD;
            pg8::StaticOrder S;
            if (s == 0 && PHON(2)) {
                pg8::Gemm g{(const bf16_t*)(ws + WS_XG), (const bf16_t*)(ws + WS_WIN_T) + (size_t)l * DIN * D, MP, DIN, D}; S.init(MP, DIN, c.G, c.bx);
                { EpiInS Es{(const float*)(ws + WS_SSQ1), (const float*)(ws + WS_SHWIN) + (size_t)l * NBT * DIN, (bf16_t*)(ws + WS_A), (bf16_t*)(ws + WS_U), (bf16_t*)(ws + WS_GV), (float*)(ws + WS_STV)};
                  sample_gemm<EpiInS>(c, g.A, D, g.Bt, D, DIN, D, Es); }
                EpiIn E{(const float*)(ws + WS_SSQ1), (const float*)(ws + WS_SHWIN) + (size_t)l * NBT * DIN, (bf16_t*)(ws + WS_A), (bf16_t*)(ws + WS_U), (bf16_t*)(ws + WS_GV), (float*)(ws + WS_STV)};
                for (int r_ = 0; r_ < DUPN(2); ++r_) pg8::gemm_phase<EpiIn>(c.lds, g, S, E);
            } else if (s == 1 && PHON(3)) {
                for (int r_ = 0; r_ < DUPN(3); ++r_) phase_mixer(c, l);
            } else if (s == 2 && PHON(4)) {
                pg8::Gemm g{(const bf16_t*)(ws + WS_CAT), (const bf16_t*)(ws + WS_WOUT_T) + (size_t)l * D * D, MP, D, D}; S.init(MP, D, c.G, c.bx);
                { EpiResS Es{c.k->in[I_XS], l == 0 ? nullptr : c.k->out + OUT_Y, c.k->out + OUT_Y, modl + 2 * D, c.k->in[I_GFFN] + l * D, modl + 4 * D, (bf16_t*)(ws + WS_XG), (float*)(ws + WS_SSQ2)};
                  sample_gemm<EpiResS>(c, g.A, D, g.Bt, D, D, D, Es); }
                EpiRes E{c.k->in[I_XP], c.k->in[I_XS], l == 0 ? nullptr : c.k->out + OUT_Y, c.k->out + OUT_Y, modl + 2 * D, c.k->in[I_GFFN] + l * D, modl + 4 * D, (bf16_t*)(ws + WS_XG), (float*)(ws + WS_SSQ2)};
                pg8::gemm_phase<EpiRes>(c.lds, g, S, E);
            } else if (s == 3 && PHON(5)) {
                pg8::Gemm g{(const bf16_t*)(ws + WS_XG), (const bf16_t*)(ws + WS_W1_T) + (size_t)l * DFF * D, MP, DFF, D}; S.init(MP, DFF, c.G, c.bx);
                { EpiFf1S Es{(const float*)(ws + WS_SSQ2), (const float*)(ws + WS_SHW1) + (size_t)l * NBT * DFF, (bf16_t*)(ws + WS_F1)};
                  sample_gemm<EpiFf1S>(c, g.A, D, g.Bt, D, DFF, D, Es); }
                EpiFf1 E{(const float*)(ws + WS_SSQ2), (const float*)(ws + WS_SHW1) + (size_t)l * NBT * DFF, (bf16_t*)(ws + WS_F1)};
                for (int r_ = 0; r_ < DUPN(5); ++r_) pg8::gemm_phase<EpiFf1>(c.lds, g, S, E);
            } else if (s == 4 && PHON(6)) {
                pg8::Gemm g{(const bf16_t*)(ws + WS_F1), (const bf16_t*)(ws + WS_W2_T) + (size_t)l * D * DFF, MP, D, DFF}; S.init(MP, D, c.G, c.bx);
                const bool more = (l + 1 < DEPTH);
                { EpiResS Es{c.k->in[I_XS], c.k->out + OUT_Y, c.k->out + OUT_Y, modl + 5 * D, more ? c.k->in[I_GMIX] + (l + 1) * D : nullptr, mod + (size_t)(more ? l + 1 : l) * NBT * NMOD + 1 * D,
                             (bf16_t*)(ws + WS_XG), (float*)(ws + WS_SSQ1)};
                  sample_gemm<EpiResS>(c, g.A, DFF, g.Bt, DFF, D, DFF, Es); }
                EpiRes E{c.k->in[I_XP], c.k->in[I_XS], c.k->out + OUT_Y, c.k->out + OUT_Y, modl + 5 * D, more ? c.k->in[I_GMIX] + (l + 1) * D : nullptr, mod + (size_t)(more ? l + 1 : l) * NBT * NMOD + 1 * D,
                         (bf16_t*)(ws + WS_XG), (float*)(ws + WS_SSQ1)};
                pg8::gemm_phase<EpiRes>(c.lds, g, S, E);
            }
        }
        if (ph + 1 < p.ph_hi) { if (p.ph_hi > NPHASE) grid.sync(); else xcd_barrier(xbar); }
    }
}

extern "C" void kernel_launch(void* const* d_in, const int* in_sizes, int n_in, void* d_out, int out_size, void* d_ws, size_t ws_size, hipStream_t stream) {
    static int grid_blocks = 0;
    if (!grid_blocks) {
        int dev = 0, cus = 0, per_cu = 0;
        hipGetDevice(&dev);
        hipDeviceGetAttribute(&cus, hipDeviceAttributeMultiprocessorCount, dev);
        hipOccupancyMaxActiveBlocksPerMultiprocessor(&per_cu, mk_fwd, NTHREADS, 0);
        if (per_cu < 1) per_cu = 1;
        if (per_cu > 1) per_cu = 1;
        grid_blocks = cus * per_cu;
        if (n_in != 20 || ws_size < WS_END) fprintf(stderr, "kernel_launch: unexpected n_in %d / ws_size %zu (need %zu)\n", n_in, ws_size, (size_t)WS_END);
    }
    Params p{};
    for (int i = 0; i < 20; ++i) p.in[i] = (const float*)d_in[i];
    p.out = (float*)d_out; p.ws = (unsigned char*)d_ws;
#if MK_SINGLE
    (void)hipMemsetAsync((unsigned char*)d_ws + WS_BAR, 0, WS_BAR_BYTES, stream);
    p.ph_lo = 0; p.ph_hi = NPHASE;
    { void* args[] = {&p};
      hipError_t e = hipLaunchCooperativeKernel((void*)mk_fwd, dim3(grid_blocks), dim3(NTHREADS), args, 0, stream);
      if (e != hipSuccess) fprintf(stderr, "cooperative launch failed: %s (grid %d)\n", hipGetErrorString(e), grid_blocks); }
#else
    for (int ph = 0; ph < NPHASE; ++ph) {
        p.ph_lo = ph; p.ph_hi = ph + 1;
        void* args[] = {&p};
        hipError_t e = hipLaunchCooperativeKernel((void*)mk_fwd, dim3(grid_blocks), dim3(NTHREADS), args, 0, stream);
        if (e != hipSuccess) { fprintf(stderr, "cooperative launch failed: %s (grid %d, phase %d)\n", hipGetErrorString(e), grid_blocks, ph); break; }
    }
#endif
}
```

```cpp
#include <hip/hip_runtime.h>
#include <hip/hip_cooperative_groups.h>
#include <cstdio>
namespace cg = cooperative_groups;

#ifndef MK_SINGLE
#define MK_SINGLE 1
#endif

#define LAS __attribute__((address_space(3)))
typedef unsigned short bf16_t;
typedef short bf16x8 __attribute__((ext_vector_type(8)));
typedef short s16x4 __attribute__((ext_vector_type(4)));
typedef float f32x4 __attribute__((ext_vector_type(4)));
typedef float f32x2 __attribute__((ext_vector_type(2)));
typedef unsigned u32x4 __attribute__((ext_vector_type(4)));
typedef unsigned u32x2 __attribute__((ext_vector_type(2)));

constexpr int D = 1024, NBP = 16, SEQ = 4096, MP = NBP * SEQ, NBS = 8, DSEQ = 64, MS = NBS * DSEQ, MT = MP + MS;
constexpr int DIN = 1536, DFF = 4096, DEPTH = 2, NBT = NBP + NBS, PW = 512, SW = 512, NMOD = 6 * D;
constexpr float EPS = 1e-6f;
constexpr int NTHREADS = 512;

constexpr size_t WS_WIN_T = 0;
constexpr size_t WS_WOUT_T = WS_WIN_T + (size_t)DEPTH * DIN * D * 2;
constexpr size_t WS_W1_T = WS_WOUT_T + (size_t)DEPTH * D * D * 2;
constexpr size_t WS_W2_T = WS_W1_T + (size_t)DEPTH * DFF * D * 2;
constexpr size_t WS_WP_T = WS_W2_T + (size_t)DEPTH * DFF * D * 2;
constexpr size_t WS_WSP = WS_WP_T + (size_t)DEPTH * 4 * 128 * 128 * 2;
constexpr size_t WS_MOD = WS_WSP + (size_t)DEPTH * 4 * 128 * 128 * 2;
constexpr size_t WS_SHWIN = WS_MOD + (size_t)DEPTH * NBT * NMOD * 4;
constexpr size_t WS_SHW1 = WS_SHWIN + (size_t)DEPTH * NBT * DIN * 4;
constexpr size_t WS_SSQ1 = WS_SHW1 + (size_t)DEPTH * NBT * DFF * 4;
constexpr size_t WS_SSQ2 = WS_SSQ1 + (size_t)MT * 16 * 4;
constexpr size_t WS_STV = WS_SSQ2 + (size_t)MT * 16 * 4;
constexpr size_t WS_XG = WS_STV + (size_t)MT * 16 * 4;
constexpr size_t WS_F1 = WS_XG + (size_t)MT * D * 2;
constexpr size_t WS_A = WS_F1;
constexpr size_t WS_U = WS_A + (size_t)MT * PW * 2;
constexpr size_t WS_GV = WS_U + (size_t)MT * SW * 2;
constexpr size_t WS_CAT = WS_GV + (size_t)MT * SW * 2;
constexpr size_t WS_XR = WS_F1 + (size_t)MT * DFF * 2;
constexpr size_t WS_BAR = WS_XR + (size_t)MT * D * 2;
constexpr size_t WS_BAR_BYTES = 16384;
constexpr size_t WS_END = WS_BAR + WS_BAR_BYTES;

constexpr size_t OUT_Y = 0;
constexpr size_t OUT_SPP = (size_t)MT * D;
constexpr size_t OUT_SPS = OUT_SPP + (size_t)DEPTH * NBP * 15 * PW;
constexpr size_t OUT_SV = OUT_SPS + (size_t)DEPTH * NBS * 15 * PW;

struct Params {
    const float* in[20];
    float* out;
    unsigned char* ws;
    int ph_lo, ph_hi;
};
enum { I_XP = 0, I_XS, I_SPOOL, I_CP, I_CS, I_WADA, I_BADA, I_GMIX, I_WIN, I_WPOOL, I_PSCALE, I_VG, I_VB, I_WSP, I_BSP, I_WOUT, I_GFFN, I_W1, I_W2, I_GFIN };

__device__ __forceinline__ unsigned cvt_pk_bf16(float lo, float hi) { unsigned r; asm volatile("v_cvt_pk_bf16_f32 %0, %1, %2" : "=v"(r) : "v"(lo), "v"(hi)); return r; }
__device__ __forceinline__ float bflo(unsigned w) { return __uint_as_float(w << 16); }
__device__ __forceinline__ float bfhi(unsigned w) { return __uint_as_float(w & 0xffff0000u); }
__device__ __forceinline__ int batch_of(int row) { return row < MP ? (row >> 12) : NBP + ((row - MP) >> 6); }
__device__ __forceinline__ f32x2 gelu_pk(f32x2 v) {
    const f32x2 av = __builtin_elementwise_abs(v), d = av * 0.2316418882f + 1.0f;
    f32x2 t; t.x = __builtin_amdgcn_rcpf(d.x); t.y = __builtin_amdgcn_rcpf(d.y);
    f32x2 q = t * 0.5307027145f + (-0.7265760135f); q = q * t + 0.7107068705f; q = q * t + (-0.142248368f); q = q * t + 0.127414796f; q = q * t;
    const f32x2 s = (v * v) * (-0.72134752044f);
    f32x2 e; e.x = __builtin_amdgcn_exp2f(s.x); e.y = __builtin_amdgcn_exp2f(s.y);
    const f32x2 m = v * (q * e), r = v - m;
    f32x2 o; o.x = v.x < 0.f ? m.x : r.x; o.y = v.y < 0.f ? m.y : r.y; return o;
}
__device__ __forceinline__ f32x4 gelu4(f32x4 v) { f32x2 a = gelu_pk((f32x2){v[0], v[1]}), b = gelu_pk((f32x2){v[2], v[3]}); return (f32x4){a.x, a.y, b.x, b.y}; }
__device__ __forceinline__ float wave_sum(float v) {
#pragma unroll
    for (int o = 32; o >= 1; o >>= 1) v += __shfl_xor(v, o);
    return v;
}
__device__ __forceinline__ float quad_row_sum(float v) { v += __shfl_xor(v, 16); v += __shfl_xor(v, 32); return v; }

namespace pg8 {
constexpr int BM = 256, BK = 64, HALF = 128, HTB = HALF * BK * 2, STAGE_BYTES = 8 * HTB, NXCD = 8, WGM = 8;
__device__ __forceinline__ int lds_byte(int r, int c) { const int st = (r >> 4) * 2 + (c >> 5), rr = r & 15, cc = c & 31, ob = rr * 64 + cc * 2; return st * 1024 + (ob ^ (((ob >> 9) & 1) << 5)); }
__device__ __forceinline__ void stage_rc(int b, int& R, int& C) { const int st = b / 1024, sb = b % 1024, swz = sb ^ (((sb >> 9) & 1) << 5); R = (st >> 1) * 16 + swz / 64; C = (st & 1) * 32 + (swz % 64) / 2; }
struct Unit { int pm, pn; };
struct Gemm { const bf16_t* A; const bf16_t* Bt; int M, N, K; };
struct StaticOrder {
    int nM, nN, nwg, G, c;
    __device__ void init(int M, int N, int G_, int c_) { nM = M / BM; nN = N / BM; nwg = nM * nN; G = G_; c = c_; }
    __device__ bool next(int i, Unit& u) const {
        const long L = (long)i * G + c; if (L >= nwg) return false;
        int wgid = (int)L; { const int q = nwg / NXCD, r = nwg % NXCD, xcd = wgid % NXCD, off = wgid / NXCD; wgid = (xcd < r ? xcd * (q + 1) : r * (q + 1) + (xcd - r) * q) + off; }
        const int nig = WGM * nN, gid = wgid / nig, fm = gid * WGM, gsz = (nM - fm) < WGM ? (nM - fm) : WGM;
        u.pm = fm + ((wgid % nig) % gsz); u.pn = (wgid % nig) / gsz; return true;
    }
};

template <class Epi>
__device__ __forceinline__ void gemm_phase(LAS unsigned char* lds, const Gemm g, const StaticOrder& S, const Epi& E) {
    int tid_ = threadIdx.x; asm volatile("" : "+v"(tid_));
    const int tid = tid_, wid = __builtin_amdgcn_readfirstlane(tid >> 6), lane = tid & 63, wr = wid >> 2, wc = wid & 3, fr = lane & 15, fq = lane >> 4;
    const int K = g.K, nt = K / BK;
    unsigned voffA[2], voffB[2];
#pragma unroll
    for (int i = 0; i < 2; ++i) { int R, C; stage_rc(tid * 16 + i * 8192, R, C); voffA[i] = (unsigned)(R * K + C) * 2u; voffB[i] = (unsigned)(R * K + C) * 2u; }
    const size_t kstep = (size_t)(BK * 2);
    const size_t hstep = (size_t)HALF * K * 2;
    const size_t tstep = 2 * hstep;
    const unsigned ldsw = (unsigned)wid * 1024u;
    const int aoff = lds_byte(wr * 64 + fr, fq * 8), boff = lds_byte(wc * 32 + fr, fq * 8);
#define PG8_SA(b, h) (((b) * 2 + (h)) * HTB)
#define PG8_SB(b, h) ((4 + (b) * 2 + (h)) * HTB)
#define PG8_STAGE(bufoff, gbase, voff) do { _Pragma("unroll") for (int _i = 0; _i < 2; ++_i) \
        __builtin_amdgcn_global_load_lds((const unsigned*)((const char*)(gbase) + (voff)[_i]), (LAS unsigned*)(lds + (bufoff) + ldsw + _i * 8192), 16, 0, 0); } while (0)
#define PG8_LDA(dst, b, h) do { _Pragma("unroll") for (int m = 0; m < 4; ++m) _Pragma("unroll") for (int k = 0; k < 2; ++k) dst[m][k] = *(const LAS bf16x8*)(lds + PG8_SA(b, h) + aoff + m * 2048 + k * 1024); } while (0)
#define PG8_LDB(dst, b, h) do { _Pragma("unroll") for (int n = 0; n < 2; ++n) _Pragma("unroll") for (int k = 0; k < 2; ++k) dst[n][k] = *(const LAS bf16x8*)(lds + PG8_SB(b, h) + boff + n * 2048 + k * 1024); } while (0)
#define PG8_MMA(ai, bj, At, Bt) do { __builtin_amdgcn_s_setprio(1); _Pragma("unroll") for (int m = 0; m < 4; ++m) _Pragma("unroll") for (int n = 0; n < 2; ++n) _Pragma("unroll") for (int k = 0; k < 2; ++k) \
        acc[ai][bj][m][n] = __builtin_amdgcn_mfma_f32_16x16x32_bf16(Bt[n][k], At[m][k], acc[ai][bj][m][n], 0, 0, 0); __builtin_amdgcn_s_setprio(0); } while (0)
#define PG8_WAIT_V(n) asm volatile("s_waitcnt vmcnt(" #n ")" ::: "memory")
#define PG8_WAIT_L(n) asm volatile("s_waitcnt lgkmcnt(" #n ")" ::: "memory")
#define PG8_BAR __builtin_amdgcn_s_barrier()
#define PG8_SCHED __builtin_amdgcn_sched_barrier(0)
    Unit cur, nxt; int ui = 0;
    if (!S.next(0, cur)) return;
    f32x4 acc[2][2][4][2];
#pragma unroll
    for (int a = 0; a < 2; ++a)
#pragma unroll
        for (int b = 0; b < 2; ++b)
#pragma unroll
            for (int m = 0; m < 4; ++m)
#pragma unroll
                for (int n = 0; n < 2; ++n) acc[a][b][m][n] = (f32x4){0.f, 0.f, 0.f, 0.f};
    bf16x8 At[4][2], B0[2][2], B1[2][2];
    const char* cA = (const char*)g.A + (size_t)cur.pm * tstep; const char* cB = (const char*)g.Bt + (size_t)cur.pn * tstep;
    PG8_STAGE(PG8_SB(0, 0), cB, voffB); PG8_STAGE(PG8_SA(0, 0), cA, voffA); PG8_STAGE(PG8_SB(0, 1), cB + hstep, voffB); PG8_STAGE(PG8_SA(0, 1), cA + hstep, voffA);
    if (wr == 1) PG8_BAR;
    PG8_WAIT_V(4); PG8_BAR;
    PG8_STAGE(PG8_SB(1, 0), cB + kstep, voffB); PG8_STAGE(PG8_SA(1, 0), cA + kstep, voffA); PG8_STAGE(PG8_SB(1, 1), cB + hstep + kstep, voffB);
    PG8_WAIT_V(6); PG8_BAR;
    for (;;) {
        const bool has_next = S.next(ui + 1, nxt);
        const char* nA = has_next ? (const char*)g.A + (size_t)nxt.pm * tstep : cA; const char* nB = has_next ? (const char*)g.Bt + (size_t)nxt.pn * tstep : cB;
        for (int t = 0; t < nt; t += 2) {
            const bool last = (t == nt - 2);
            const char* a1 = cA + (size_t)(t + 1) * kstep;
            const char* a2 = last ? nA : cA + (size_t)(t + 2) * kstep; const char* b2 = last ? nB : cB + (size_t)(t + 2) * kstep;
            const char* a3 = a2 + kstep; const char* b3 = b2 + kstep;
            PG8_LDB(B0, 0, 0); PG8_SCHED; PG8_LDA(At, 0, 0); PG8_STAGE(PG8_SA(1, 1), a1 + hstep, voffA);
            PG8_WAIT_L(8); PG8_BAR; PG8_WAIT_L(0); PG8_MMA(0, 0, At, B0); PG8_BAR; PG8_SCHED;
            PG8_LDB(B1, 0, 1); PG8_STAGE(PG8_SB(0, 0), b2, voffB);
            PG8_BAR; PG8_WAIT_L(0); PG8_MMA(0, 1, At, B1); PG8_BAR;
            PG8_LDA(At, 0, 1); PG8_STAGE(PG8_SA(0, 0), a2, voffA);
            PG8_BAR; PG8_WAIT_L(0); PG8_MMA(1, 0, At, B0); PG8_BAR; PG8_SCHED;
            PG8_STAGE(PG8_SB(0, 1), b2 + hstep, voffB);
            PG8_WAIT_V(6); PG8_BAR; PG8_MMA(1, 1, At, B1); PG8_BAR;
            PG8_LDB(B0, 1, 0); PG8_SCHED; PG8_LDA(At, 1, 0); PG8_STAGE(PG8_SA(0, 1), a2 + hstep, voffA);
            PG8_WAIT_L(8); PG8_BAR; PG8_WAIT_L(0); PG8_MMA(0, 0, At, B0); PG8_BAR; PG8_SCHED;
            PG8_LDB(B1, 1, 1); PG8_STAGE(PG8_SB(1, 0), b3, voffB);
            PG8_BAR; PG8_WAIT_L(0); PG8_MMA(0, 1, At, B1); PG8_BAR;
            PG8_LDA(At, 1, 1); PG8_STAGE(PG8_SA(1, 0), a3, voffA);
            PG8_BAR; PG8_WAIT_L(0); PG8_MMA(1, 0, At, B0); PG8_BAR; PG8_SCHED;
            PG8_STAGE(PG8_SB(1, 1), b3 + hstep, voffB);
            PG8_WAIT_V(6); PG8_BAR; PG8_MMA(1, 1, At, B1); PG8_BAR;
        }
        E(acc, cur, wr, wc, fr, fq);
        if (!has_next) break;
#pragma unroll
        for (int a = 0; a < 2; ++a)
#pragma unroll
            for (int b = 0; b < 2; ++b)
#pragma unroll
                for (int m = 0; m < 4; ++m)
#pragma unroll
                    for (int n = 0; n < 2; ++n) acc[a][b][m][n] = (f32x4){0.f, 0.f, 0.f, 0.f};
        cur = nxt; cA = nA; cB = nB; ++ui;
    }
    PG8_WAIT_V(0);
    if (wr == 0) PG8_BAR;
    PG8_BAR;
#undef PG8_SA
#undef PG8_SB
#undef PG8_STAGE
#undef PG8_LDA
#undef PG8_LDB
#undef PG8_MMA
#undef PG8_WAIT_V
#undef PG8_WAIT_L
#undef PG8_BAR
#undef PG8_SCHED
}
}

typedef f32x4 AccT[2][2][4][2];

__device__ __forceinline__ f32x4 ldg4(const void* base, unsigned off) { return *(const f32x4*)((const char*)base + off); }
__device__ __forceinline__ u32x2 ldg2(const void* base, unsigned off) { return *(const u32x2*)((const char*)base + off); }
__device__ __forceinline__ f32x4 unpack4(u32x2 w) { return (f32x4){bflo(w.x), bfhi(w.x), bflo(w.y), bfhi(w.y)}; }
__device__ __forceinline__ void stg4(void* base, unsigned off, f32x4 v) { *(f32x4*)((char*)base + off) = v; }
__device__ __forceinline__ void stg2(void* base, unsigned off, u32x2 v) { *(u32x2*)((char*)base + off) = v; }
__device__ __forceinline__ void stf2(void* base, unsigned off, f32x2 v) { *(f32x2*)((char*)base + off) = v; }
__device__ __forceinline__ void stf1(void* base, unsigned off, float v) { *(float*)((char*)base + off) = v; }
__device__ __forceinline__ u32x2 pack4(f32x4 z) { u32x2 w; w.x = cvt_pk_bf16(z[0], z[1]); w.y = cvt_pk_bf16(z[2], z[3]); return w; }
constexpr unsigned CO[2][2] = {{0u, 16u}, {128u, 144u}};

struct EpiIn {
    const float* ssq1; const float* shw; bf16_t* A; bf16_t* U; bf16_t* GV; float* stv;
    __device__ __forceinline__ void operator()(const AccT& acc, const pg8::Unit& u, int wr, int wc, int fr, int fq) const {
        const int rowu = u.pm * 256 + wr * 64;
        const unsigned colb = (unsigned)(u.pn * 256 + wc * 32 + 4 * fq), rowb = (unsigned)(rowu + fr);
        bf16_t* const dbase = u.pn < 2 ? A : (u.pn < 4 ? U - 512 : GV - 1024);
        const float* bias = shw + (size_t)batch_of(rowu) * DIN;
        f32x4 pp[2][4], bv[2][2];
#pragma unroll
        for (int ai = 0; ai < 2; ++ai)
#pragma unroll
            for (int m = 0; m < 4; ++m) pp[ai][m] = ldg4(ssq1, ((rowb + ai * 128 + m * 16) * 16 + fq * 4) * 4);
#pragma unroll
        for (int bj = 0; bj < 2; ++bj)
#pragma unroll
            for (int n = 0; n < 2; ++n) bv[bj][n] = ldg4(bias, (colb + CO[bj][n]) * 4);
        float rstd[2][4];
#pragma unroll
        for (int ai = 0; ai < 2; ++ai)
#pragma unroll
            for (int m = 0; m < 4; ++m) { const f32x4 p = pp[ai][m]; rstd[ai][m] = rsqrtf(quad_row_sum((p[0] + p[1]) + (p[2] + p[3])) * (1.0f / D) + EPS); }
#pragma unroll
        for (int ai = 0; ai < 2; ++ai) {
            float s1[4], s2[4];
#pragma unroll
            for (int m = 0; m < 4; ++m) {
                const unsigned row = rowb + ai * 128 + m * 16;
                float t1 = 0.f, t2 = 0.f;
#pragma unroll
                for (int bj = 0; bj < 2; ++bj)
#pragma unroll
                    for (int n = 0; n < 2; ++n) {
                        f32x4 z = acc[ai][bj][m][n] * rstd[ai][m] + bv[bj][n];
                        if (u.pn >= 2) z = gelu4(z);
                        if (u.pn >= 4) { t1 += (z[0] + z[1]) + (z[2] + z[3]); t2 += (z[0] * z[0] + z[1] * z[1]) + (z[2] * z[2] + z[3] * z[3]); }
                        stg2(dbase, (row * 512 + colb + CO[bj][n]) * 2, pack4(z));
                    }
                s1[m] = t1; s2[m] = t2;
            }
            if (u.pn >= 4) {
#pragma unroll
                for (int m = 0; m < 4; ++m) {
                    const float a = quad_row_sum(s1[m]), b = quad_row_sum(s2[m]);
                    if (fq == 0) stf2(stv, ((rowb + ai * 128 + m * 16) * 16 + ((u.pn - 4) * 4 + wc) * 2) * 4, (f32x2){a, b});
                }
            }
        }
    }
};
struct EpiRes {
    bf16_t* XR; const float* gate;
    const float* gnext; const float* scnext;
    bf16_t* XG; float* ssq;
    __device__ __forceinline__ void operator()(const AccT& acc, const pg8::Unit& u, int wr, int wc, int fr, int fq) const {
        const int rowu = u.pm * 256 + wr * 64;
        const unsigned colb = (unsigned)(u.pn * 256 + wc * 32 + 4 * fq), rowb = (unsigned)(rowu + fr);
        const int b = batch_of(rowu);
        float ssr[8];
        f32x4 gt[2][2], gm[2][2];
        u32x2 ring[4][2][2];
#define ER_LOADROW(r_, slot_) do { const unsigned ro_ = (rowb + ((r_) >> 2) * 128 + ((r_) & 3) * 16) * D + colb; \
            _Pragma("unroll") for (int bj = 0; bj < 2; ++bj) _Pragma("unroll") for (int n = 0; n < 2; ++n) ring[slot_][bj][n] = ldg2(XR, (ro_ + CO[bj][n]) * 2); } while (0)
        ER_LOADROW(0, 0); ER_LOADROW(1, 1); ER_LOADROW(2, 2);
#pragma unroll
        for (int bj = 0; bj < 2; ++bj)
#pragma unroll
            for (int n = 0; n < 2; ++n) {
                const unsigned co = (colb + CO[bj][n]) * 4;
                gt[bj][n] = ldg4(gate + (size_t)b * NMOD, co);
                if (gnext) gm[bj][n] = ldg4(gnext, co) * (ldg4(scnext + (size_t)b * NMOD, co) + 1.0f);
                else gm[bj][n] = (f32x4){0.f, 0.f, 0.f, 0.f};
            }
#pragma unroll
        for (int r = 0; r < 8; ++r) {
            const int ai = r >> 2, m = r & 3; const unsigned row = rowb + ai * 128 + m * 16;
            if (r + 3 < 8) ER_LOADROW(r + 3, (r + 3) & 3);
            float ss = 0.f;
#pragma unroll
            for (int bj = 0; bj < 2; ++bj)
#pragma unroll
                for (int n = 0; n < 2; ++n) {
                    const unsigned eo = row * D + colb + CO[bj][n];
                    const f32x4 x1 = unpack4(ring[r & 3][bj][n]) + gt[bj][n] * acc[ai][bj][m][n];
                    stg2(XR, eo * 2, pack4(x1));
                    ss += (x1[0] * x1[0] + x1[1] * x1[1]) + (x1[2] * x1[2] + x1[3] * x1[3]);
                    if (gnext) stg2(XG, eo * 2, pack4(x1 * gm[bj][n]));
                }
            ssr[r] = ss;
        }
#undef ER_LOADROW
#pragma unroll
        for (int r = 0; r < 8; ++r) { const float t = quad_row_sum(ssr[r]); if (fq == 0) stf1(ssq, ((rowb + (r >> 2) * 128 + (r & 3) * 16) * 16 + u.pn * 4 + wc) * 4, t); }
    }
};
struct EpiFf1 {
    const float* ssq2; const float* shw; bf16_t* F1;
    __device__ __forceinline__ void operator()(const AccT& acc, const pg8::Unit& u, int wr, int wc, int fr, int fq) const {
        const int rowu = u.pm * 256 + wr * 64;
        const unsigned colb = (unsigned)(u.pn * 256 + wc * 32 + 4 * fq), rowb = (unsigned)(rowu + fr);
        const float* bias = shw + (size_t)batch_of(rowu) * DFF;
        f32x4 pp[2][4], bv[2][2];
#pragma unroll
        for (int ai = 0; ai < 2; ++ai)
#pragma unroll
            for (int m = 0; m < 4; ++m) pp[ai][m] = ldg4(ssq2, ((rowb + ai * 128 + m * 16) * 16 + fq * 4) * 4);
#pragma unroll
        for (int bj = 0; bj < 2; ++bj)
#pragma unroll
            for (int n = 0; n < 2; ++n) bv[bj][n] = ldg4(bias, (colb + CO[bj][n]) * 4);
        float rstd[2][4];
#pragma unroll
        for (int ai = 0; ai < 2; ++ai)
#pragma unroll
            for (int m = 0; m < 4; ++m) { const f32x4 p = pp[ai][m]; rstd[ai][m] = rsqrtf(quad_row_sum((p[0] + p[1]) + (p[2] + p[3])) * (1.0f / D) + EPS); }
#pragma unroll
        for (int ai = 0; ai < 2; ++ai)
#pragma unroll
            for (int m = 0; m < 4; ++m) {
                const unsigned row = rowb + ai * 128 + m * 16;
#pragma unroll
                for (int bj = 0; bj < 2; ++bj)
#pragma unroll
                    for (int n = 0; n < 2; ++n) {
                        f32x4 z = acc[ai][bj][m][n] * rstd[ai][m] + bv[bj][n];
                        z = __builtin_elementwise_max(z, (f32x4){0.f, 0.f, 0.f, 0.f}); z = z * z;
                        stg2(F1, (row * DFF + colb + CO[bj][n]) * 2, pack4(z));
                    }
            }
    }
};

typedef const __attribute__((address_space(4))) Params* KArgs;
__device__ __forceinline__ KArgs kargs() { KArgs k = (KArgs)__builtin_amdgcn_kernarg_segment_ptr(); asm volatile("" : "+s"(k)); return k; }
struct Ctx {
    KArgs k;
    LAS unsigned char* lds; int tid, lane, wid, G, bx;
};

__device__ __forceinline__ void gemv24_unit(const Ctx& c, int mode, const float* vsrc, int vstride, const float* W, int ldw, int n0, const float* bias, float* out, int ldo) {
    LAS float* tbl = (LAS float*)c.lds;
    __syncthreads();
    for (int i = c.tid; i < NBT * D; i += NTHREADS) {
        const int b = i >> 10, k = i & 1023; float v;
        if (mode == 0) { const float x = b < NBP ? c.k->in[I_CP][b * D + k] : c.k->in[I_CS][(b - NBP) * D + k]; v = x / (1.0f + __expf(-x)); }
        else v = vsrc[(size_t)b * vstride + k];
        tbl[k * NBT + b] = v;
    }
    __syncthreads();
    const int ks = c.tid >> 6, j = c.tid & 63;
    float acc[NBT];
#pragma unroll
    for (int b = 0; b < NBT; ++b) acc[b] = 0.f;
    const float* wp = W + (size_t)(ks * 128) * ldw + n0 + j;
#pragma unroll 8
    for (int kk = 0; kk < 128; ++kk) {
        const float w = wp[(size_t)kk * ldw];
        const LAS f32x4* t4 = (const LAS f32x4*)(tbl + (ks * 128 + kk) * NBT);
#pragma unroll
        for (int q = 0; q < 6; ++q) { const f32x4 t = t4[q]; acc[4 * q + 0] += t[0] * w; acc[4 * q + 1] += t[1] * w; acc[4 * q + 2] += t[2] * w; acc[4 * q + 3] += t[3] * w; }
    }
    __syncthreads();
    LAS float* red = (LAS float*)c.lds;
#pragma unroll
    for (int b = 0; b < NBT; ++b) red[(ks * NBT + b) * 64 + j] = acc[b];
    __syncthreads();
    for (int o = c.tid; o < NBT * 64; o += NTHREADS) {
        const int b = o >> 6, jj = o & 63; float s = bias ? bias[n0 + jj] : 0.f;
#pragma unroll
        for (int q = 0; q < 8; ++q) s += red[(q * NBT + b) * 64 + jj];
        out[(size_t)b * ldo + n0 + jj] = s;
    }
}
__device__ __forceinline__ void transpose_unit(const Ctx& c, const float* W, int K, int N, int k0, int n0, bf16_t* Wt, const float* nscale) {
    LAS float* tile = (LAS float*)c.lds;
    __syncthreads();
    { const int r = c.tid >> 4, c4 = c.tid & 15;
#pragma unroll
      for (int i = 0; i < 2; ++i) { const int kk = r + 32 * i; const f32x4 v = *(const f32x4*)(W + (size_t)(k0 + kk) * N + n0 + c4 * 4);
          tile[kk * 65 + c4 * 4 + 0] = v[0]; tile[kk * 65 + c4 * 4 + 1] = v[1]; tile[kk * 65 + c4 * 4 + 2] = v[2]; tile[kk * 65 + c4 * 4 + 3] = v[3]; } }
    __syncthreads();
    { const int nn = c.tid >> 3, k8 = c.tid & 7; const float s = nscale ? nscale[n0 + nn] : 1.0f; float f[8];
#pragma unroll
      for (int j = 0; j < 8; ++j) f[j] = tile[(k8 * 8 + j) * 65 + nn] * s;
      u32x4 w; w.x = cvt_pk_bf16(f[0], f[1]); w.y = cvt_pk_bf16(f[2], f[3]); w.z = cvt_pk_bf16(f[4], f[5]); w.w = cvt_pk_bf16(f[6], f[7]);
      *(u32x4*)(Wt + (size_t)(n0 + nn) * K + k0 + k8 * 8) = w; }
}

constexpr int NU_MOD = DEPTH * (NMOD / 64);
constexpr int T_IN = 16 * 24, T_OUT = 16 * 16, T_F1 = 16 * 64, T_F2 = 64 * 16, T_LAYER = T_IN + T_OUT + T_F1 + T_F2;
constexpr int NU_TR = DEPTH * T_LAYER, NU_WP = DEPTH * 4 * 4, NU_WS = DEPTH * 4 * 4;
constexpr int NU_I0 = NU_MOD + NU_TR + NU_WP + NU_WS;
__device__ void phase_init0(const Ctx& c) {
    float* mod = (float*)(c.k->ws + WS_MOD);
    for (int u = c.bx; u < NU_I0; u += c.G) {
        if (u < NU_MOD) {
            const int l = u / (NMOD / 64), nb = u % (NMOD / 64);
            gemv24_unit(c, 0, nullptr, 0, c.k->in[I_WADA] + (size_t)l * D * NMOD, NMOD, nb * 64, c.k->in[I_BADA] + (size_t)l * NMOD, mod + (size_t)l * NBT * NMOD, NMOD);
        } else if (u < NU_MOD + NU_TR) {
            const int v = u - NU_MOD, l = v / T_LAYER; int r = v % T_LAYER;
            if (r < T_IN) transpose_unit(c, c.k->in[I_WIN] + (size_t)l * D * DIN, D, DIN, (r / 24) * 64, (r % 24) * 64, (bf16_t*)(c.k->ws + WS_WIN_T) + (size_t)l * DIN * D, nullptr);
            else if ((r -= T_IN) < T_OUT) transpose_unit(c, c.k->in[I_WOUT] + (size_t)l * D * D, D, D, (r / 16) * 64, (r % 16) * 64, (bf16_t*)(c.k->ws + WS_WOUT_T) + (size_t)l * D * D, nullptr);
            else if ((r -= T_OUT) < T_F1) transpose_unit(c, c.k->in[I_W1] + (size_t)l * D * DFF, D, DFF, (r / 64) * 64, (r % 64) * 64, (bf16_t*)(c.k->ws + WS_W1_T) + (size_t)l * DFF * D, nullptr);
            else { r -= T_F1; transpose_unit(c, c.k->in[I_W2] + (size_t)l * DFF * D, DFF, D, (r / 16) * 64, (r % 16) * 64, (bf16_t*)(c.k->ws + WS_W2_T) + (size_t)l * D * DFF, nullptr); }
        } else if (u < NU_MOD + NU_TR + NU_WP) {
            const int v = u - NU_MOD - NU_TR, lg = v >> 2, t = v & 3, l = lg >> 2, g = lg & 3;
            transpose_unit(c, c.k->in[I_WPOOL] + (size_t)lg * 128 * 128, 128, 128, (t >> 1) * 64, (t & 1) * 64, (bf16_t*)(c.k->ws + WS_WP_T) + (size_t)lg * 128 * 128, c.k->in[I_PSCALE] + l * PW + g * 128);
        } else {
            const int v = u - NU_MOD - NU_TR - NU_WP, lh = v >> 2, t = v & 3, t0 = (t >> 1) * 64, s0 = (t & 1) * 64;
            const int tt = t0 + (c.tid >> 3), s8 = s0 + (c.tid & 7) * 8;
            const float* src = c.k->in[I_WSP] + ((size_t)lh * 128 + tt) * 128 + s8;
            const f32x4 a = *(const f32x4*)src, b = *(const f32x4*)(src + 4);
            float f[8] = {a[0], a[1], a[2], a[3], b[0], b[1], b[2], b[3]};
#pragma unroll
            for (int j = 0; j < 8; ++j) if (s8 + j > tt) f[j] = 0.f;
            u32x4 w; w.x = cvt_pk_bf16(f[0], f[1]); w.y = cvt_pk_bf16(f[2], f[3]); w.z = cvt_pk_bf16(f[4], f[5]); w.w = cvt_pk_bf16(f[6], f[7]);
            *(u32x4*)((bf16_t*)(c.k->ws + WS_WSP) + ((size_t)lh * 128 + tt) * 128 + s8) = w;
        }
    }
}
constexpr int NU_SH_L = DIN / 64 + DFF / 64;
__device__ void phase_init1(const Ctx& c) {
    const float* mod = (const float*)(c.k->ws + WS_MOD);
    for (int u = c.bx; u < DEPTH * NU_SH_L; u += c.G) {
        const int l = u / NU_SH_L, r = u % NU_SH_L;
        const float* ml = mod + (size_t)l * NBT * NMOD;
        if (r < DIN / 64) gemv24_unit(c, 1, ml + 0 * D, NMOD, c.k->in[I_WIN] + (size_t)l * D * DIN, DIN, r * 64, nullptr, (float*)(c.k->ws + WS_SHWIN) + (size_t)l * NBT * DIN, DIN);
        else gemv24_unit(c, 1, ml + 3 * D, NMOD, c.k->in[I_W1] + (size_t)l * D * DFF, DFF, (r - DIN / 64) * 64, nullptr, (float*)(c.k->ws + WS_SHW1) + (size_t)l * NBT * DFF, DFF);
    }
    bf16_t* XG = (bf16_t*)(c.k->ws + WS_XG); bf16_t* XR = (bf16_t*)(c.k->ws + WS_XR); float* ssq1 = (float*)(c.k->ws + WS_SSQ1);
    const float* gm = c.k->in[I_GMIX];
    for (int rg = c.bx; rg < MT / 32; rg += c.G) {
        const int rowb = rg * 32 + c.wid * 4, b = batch_of(rowb);
        const float* sc = mod + (size_t)b * NMOD + 1 * D;
        f32x4 x[4][4], gmul[4];
#pragma unroll
        for (int r = 0; r < 4; ++r) { const int row = rowb + r;
            const float* xr = row < MP ? c.k->in[I_XP] + (size_t)row * D : c.k->in[I_XS] + (size_t)(row - MP) * D;
#pragma unroll
            for (int i = 0; i < 4; ++i) x[r][i] = *(const f32x4*)(xr + i * 256 + c.lane * 4); }
#pragma unroll
        for (int i = 0; i < 4; ++i) { const int k = i * 256 + c.lane * 4; gmul[i] = *(const f32x4*)(gm + k) * (*(const f32x4*)(sc + k) + 1.0f); }
#pragma unroll
        for (int r = 0; r < 4; ++r) {
            float ss = 0.f;
#pragma unroll
            for (int i = 0; i < 4; ++i) { const f32x4 v = x[r][i]; ss += (v[0] * v[0] + v[1] * v[1]) + (v[2] * v[2] + v[3] * v[3]);
                *(u32x2*)(XG + (size_t)(rowb + r) * D + i * 256 + c.lane * 4) = pack4(v * gmul[i]);
                *(u32x2*)(XR + (size_t)(rowb + r) * D + i * 256 + c.lane * 4) = pack4(v); }
            ss = wave_sum(ss);
            if (c.lane < 16) ssq1[(size_t)(rowb + r) * 16 + c.lane] = c.lane == 0 ? ss : 0.f;
        }
    }
}
constexpr int TP = 272;
__device__ __forceinline__ void unpack8(u32x4 v, float* f) { f[0] = bflo(v.x); f[1] = bfhi(v.x); f[2] = bflo(v.y); f[3] = bfhi(v.y); f[4] = bflo(v.z); f[5] = bfhi(v.z); f[6] = bflo(v.w); f[7] = bfhi(v.w); }
__device__ __forceinline__ u32x4 pack8(const float* f) { u32x4 w; w.x = cvt_pk_bf16(f[0], f[1]); w.y = cvt_pk_bf16(f[2], f[3]); w.z = cvt_pk_bf16(f[4], f[5]); w.w = cvt_pk_bf16(f[6], f[7]); return w; }
__device__ void phase_mixer(const Ctx& c, int l) {
    LAS unsigned char* tA = c.lds; LAS unsigned char* tB = c.lds + 128 * TP; LAS unsigned char* tX = c.lds + 256 * TP;
    unsigned char* ws = c.k->ws; float* outp = c.k->out;
    const bf16_t* Ab = (const bf16_t*)(ws + WS_A); const bf16_t* Ub = (const bf16_t*)(ws + WS_U); const bf16_t* GVb = (const bf16_t*)(ws + WS_GV);
    bf16_t* CAT = (bf16_t*)(ws + WS_CAT); const float* stv = (const float*)(ws + WS_STV);
    const bf16_t* WpT = (const bf16_t*)(ws + WS_WP_T) + (size_t)l * 4 * 128 * 128;
    const bf16_t* Wsp = (const bf16_t*)(ws + WS_WSP) + (size_t)l * 4 * 128 * 128;
    const int lane = c.lane, wid = c.wid, i15 = lane & 15, kq = lane >> 4, c8 = c.tid & 15, r0 = c.tid >> 4;
    constexpr int NCH = MP / 128 + NBS;
    for (int u = c.bx; u < NCH * 8; u += c.G) {
        const int ct = u >> 3, j = (u + (u >> 8)) & 7;
        const bool samp = ct >= MP / 128;
        const int sb = ct - MP / 128;
        const int row0 = samp ? MP + sb * DSEQ : ct * 128, nrows = samp ? DSEQ : 128, bm = samp ? NBP + sb : (ct >> 5), tseq0 = samp ? SEQ : (ct & 31) * 128;
        const int ntb = nrows >> 4;
        bf16_t* const cbase = CAT + (size_t)row0 * D + (j < 4 ? j * 128 : 512 + (j - 4) * 128) + 16 * wid + 4 * kq;
        __syncthreads();
        if (j < 4) {
            const int g = j, w = 2 << g;
            {
                u32x4 wv[4], xv[5];
#pragma unroll
                for (int i = 0; i < 4; ++i) wv[i] = *(const u32x4*)(WpT + ((size_t)g * 128 + r0 + 32 * i) * 128 + c8 * 8);
                const bf16_t* ap = Ab + (size_t)row0 * PW + g * 128 + c8 * 8;
#pragma unroll
                for (int i = 0; i < 5; ++i) {
                    const int rr = r0 + 32 * i, t = rr - 15;
                    xv[i] = (u32x4){0u, 0u, 0u, 0u};
                    if (rr < 143 && t < nrows) {
                        if (t >= 0 || (!samp && tseq0 > 0)) xv[i] = *(const u32x4*)(ap + (ptrdiff_t)t * PW);
                        else if (samp) { const float* sp = c.k->in[I_SPOOL] + (((size_t)l * NBS + sb) * 15 + rr) * PW + g * 128 + c8 * 8;
                            const f32x4 p0 = *(const f32x4*)sp, p1 = *(const f32x4*)(sp + 4);
                            xv[i].x = cvt_pk_bf16(p0[0], p0[1]); xv[i].y = cvt_pk_bf16(p0[2], p0[3]); xv[i].z = cvt_pk_bf16(p1[0], p1[1]); xv[i].w = cvt_pk_bf16(p1[2], p1[3]); }
                    }
                }
#pragma unroll
                for (int i = 0; i < 4; ++i) *(LAS u32x4*)(tB + (r0 + 32 * i) * TP + c8 * 16) = wv[i];
#pragma unroll
                for (int i = 0; i < 5; ++i) { const int rr = r0 + 32 * i; if (rr < 143) *(LAS u32x4*)(tX + rr * TP + c8 * 16) = xv[i]; }
            }
            __syncthreads();
#pragma unroll 1
            for (int i = 0; i < 4; ++i) {
                const int t = r0 + 32 * i;
                if (t < nrows) {
                    const LAS unsigned char* xp0 = tX + (t + 15) * TP + c8 * 16;
                    float a0[8], s[8], tmp[8];
                    unpack8(*(const LAS u32x4*)xp0, a0);
#pragma unroll
                    for (int k = 0; k < 8; ++k) s[k] = a0[k];
#pragma unroll 2
                    for (int jj = 1; jj < w; ++jj) { unpack8(*(const LAS u32x4*)(xp0 - jj * TP), tmp);
#pragma unroll
                        for (int k = 0; k < 8; ++k) s[k] += tmp[k]; }
                    const int pos1 = tseq0 + t + 1; const float inv = 1.0f / (float)(pos1 < w ? pos1 : w);
                    float dd[8];
#pragma unroll
                    for (int k = 0; k < 8; ++k) dd[k] = s[k] * inv - a0[k];
                    *(LAS u32x4*)(tA + t * TP + c8 * 16) = pack8(dd);
                    float* so = nullptr;
                    if (!samp && (ct & 31) == 31 && t >= 113) so = outp + OUT_SPP + (((size_t)l * NBP + bm) * 15 + (t - 113)) * PW + g * 128 + c8 * 8;
                    if (samp && t >= 49) so = outp + OUT_SPS + (((size_t)l * NBS + sb) * 15 + (t - 49)) * PW + g * 128 + c8 * 8;
                    if (so) { *(f32x4*)so = (f32x4){a0[0], a0[1], a0[2], a0[3]}; *(f32x4*)(so + 4) = (f32x4){a0[4], a0[5], a0[6], a0[7]}; }
                }
            }
            __syncthreads();
            f32x4 acc[8];
#pragma unroll
            for (int tb = 0; tb < 8; ++tb) acc[tb] = (f32x4){0.f, 0.f, 0.f, 0.f};
#pragma unroll
            for (int kk = 0; kk < 4; ++kk) {
                const bf16x8 bf = *(const LAS bf16x8*)(tB + (16 * wid + i15) * TP + kk * 64 + kq * 16);
#pragma unroll
                for (int tb = 0; tb < 8; ++tb) if (tb < ntb) {
                    const bf16x8 af = *(const LAS bf16x8*)(tA + (16 * tb + i15) * TP + kk * 64 + kq * 16);
                    acc[tb] = __builtin_amdgcn_mfma_f32_16x16x32_bf16(bf, af, acc[tb], 0, 0, 0); }
            }
#pragma unroll
            for (int tb = 0; tb < 8; ++tb) if (tb < ntb) *(u32x2*)(cbase + (size_t)(16 * tb + i15) * D) = pack4(acc[tb]);
        } else {
            const int h = j - 4;
            u32x2 uu[8]; float bsv[8];
            {
                u32x4 wv[4], gvv[4]; float sv[4];
#pragma unroll
                for (int i = 0; i < 4; ++i) wv[i] = *(const u32x4*)(Wsp + ((size_t)h * 128 + r0 + 32 * i) * 128 + c8 * 8);
#pragma unroll
                for (int i = 0; i < 4; ++i) {
                    const int sr = r0 + 32 * i; gvv[i] = (u32x4){0u, 0u, 0u, 0u}; sv[i] = 0.f;
                    if (sr < nrows) { const int row = row0 + sr; gvv[i] = *(const u32x4*)(GVb + (size_t)row * SW + h * 128 + c8 * 8); sv[i] = stv[(size_t)row * 16 + c8]; }
                }
                const float* vg = c.k->in[I_VG] + l * SW + h * 128 + c8 * 8; const float* vb = c.k->in[I_VB] + l * SW + h * 128 + c8 * 8;
                const f32x4 g0 = *(const f32x4*)vg, g1 = *(const f32x4*)(vg + 4), b0 = *(const f32x4*)vb, b1 = *(const f32x4*)(vb + 4);
#pragma unroll
                for (int tb = 0; tb < 8; ++tb) { uu[tb] = (u32x2){0u, 0u}; bsv[tb] = 0.f;
                    if (tb < ntb) { uu[tb] = *(const u32x2*)(Ub + (size_t)(row0 + 16 * tb + i15) * SW + h * 128 + 16 * wid + 4 * kq);
                                    bsv[tb] = c.k->in[I_BSP][((size_t)l * 4 + h) * 128 + 16 * tb + i15]; } }
#pragma unroll
                for (int i = 0; i < 4; ++i) *(LAS u32x4*)(tA + (r0 + 32 * i) * TP + c8 * 16) = wv[i];
#pragma unroll
                for (int i = 0; i < 4; ++i) {
                    const int sr = r0 + 32 * i;
                    float sx = sv[i]; sx += __shfl_xor(sx, 2); sx += __shfl_xor(sx, 4); sx += __shfl_xor(sx, 8);
                    const float so_ = __shfl_xor(sx, 1);
                    const float sum = (c8 & 1) ? so_ : sx, sq = (c8 & 1) ? sx : so_;
                    u32x4 outv = (u32x4){0u, 0u, 0u, 0u};
                    if (sr < nrows) {
                        float gvf[8]; unpack8(gvv[i], gvf);
                        const float mean = sum * (1.0f / SW); float var = sq * (1.0f / SW) - mean * mean; var = var < 0.f ? 0.f : var;
                        const float rstd = rsqrtf(var + EPS);
                        float vl[8];
#pragma unroll
                        for (int k = 0; k < 4; ++k) { vl[k] = (gvf[k] - mean) * rstd * g0[k] + b0[k]; vl[4 + k] = (gvf[4 + k] - mean) * rstd * g1[k] + b1[k]; }
                        if (samp) { float* so = outp + OUT_SV + (((size_t)l * NBS + sb) * DSEQ + sr) * SW + h * 128 + c8 * 8;
                            *(f32x4*)so = (f32x4){vl[0], vl[1], vl[2], vl[3]}; *(f32x4*)(so + 4) = (f32x4){vl[4], vl[5], vl[6], vl[7]}; }
                        outv = pack8(vl);
                    }
                    *(LAS u32x4*)(tB + sr * TP + c8 * 16) = outv;
                }
            }
            __syncthreads();
            f32x4 acc[8];
#pragma unroll
            for (int tb = 0; tb < 8; ++tb) acc[tb] = (f32x4){0.f, 0.f, 0.f, 0.f};
            const int q = i15 >> 2, p = lane & 3;
#pragma unroll
            for (int kk = 0; kk < 4; ++kk) {
                LAS unsigned char* vp = tB + (32 * kk + 8 * kq + q) * TP + (16 * wid + 4 * p) * 2;
                const s16x4 lo = __builtin_amdgcn_ds_read_tr16_b64_v4i16((LAS s16x4*)vp);
                const s16x4 hi = __builtin_amdgcn_ds_read_tr16_b64_v4i16((LAS s16x4*)(vp + 4 * TP));
                const bf16x8 vf = __builtin_shufflevector(lo, hi, 0, 1, 2, 3, 4, 5, 6, 7);
#pragma unroll
                for (int tb = 0; tb < 8; ++tb) if (tb >= 2 * kk && tb < ntb) {
                    const bf16x8 af = *(const LAS bf16x8*)(tA + (16 * tb + i15) * TP + kk * 64 + kq * 16);
                    acc[tb] = __builtin_amdgcn_mfma_f32_16x16x32_bf16(vf, af, acc[tb], 0, 0, 0); }
            }
#pragma unroll
            for (int tb = 0; tb < 8; ++tb) if (tb < ntb) {
                f32x4 o = acc[tb]; const u32x2 w2 = uu[tb]; const float bs = bsv[tb];
                o = (f32x4){bflo(w2.x) * (o[0] + bs), bfhi(w2.x) * (o[1] + bs), bflo(w2.y) * (o[2] + bs), bfhi(w2.y) * (o[3] + bs)};
                *(u32x2*)(cbase + (size_t)(16 * tb + i15) * D) = pack4(o);
            }
        }
    }
}
template <class Epi>
__device__ __forceinline__ void sample_gemm(const Ctx& c, const bf16_t* A, int lda, const bf16_t* Bt, int ldb, int N, int K, const Epi& E) {
    LAS unsigned char* tA = c.lds; LAS unsigned char* tB = c.lds + 128 * TP; LAS float* red = (LAS float*)(c.lds + 256 * TP);
    const int lane = c.lane, wid = c.wid, i15 = lane & 15, kq = lane >> 4, c8 = c.tid & 15, r0 = c.tid >> 4;
    const int ntn = N >> 7, ntiles = NBS * ntn, nks = K >> 7;
    for (int tile = c.bx; tile < ntiles; tile += c.G) {
        const int sb = tile / ntn, n0 = (tile - sb * ntn) * 128;
        const bf16_t* ap = A + (size_t)(MP + sb * DSEQ + r0) * lda + c8 * 8;
        const bf16_t* bp = Bt + (size_t)(n0 + r0) * ldb + c8 * 8;
        u32x4 ra[2], rb[4];
#pragma unroll
        for (int i = 0; i < 2; ++i) ra[i] = *(const u32x4*)(ap + (size_t)(32 * i) * lda);
#pragma unroll
        for (int i = 0; i < 4; ++i) rb[i] = *(const u32x4*)(bp + (size_t)(32 * i) * ldb);
        f32x4 acc[4];
#pragma unroll
        for (int tb = 0; tb < 4; ++tb) acc[tb] = (f32x4){0.f, 0.f, 0.f, 0.f};
#pragma unroll 1
        for (int ks = 0; ks < nks; ++ks) {
            __syncthreads();
#pragma unroll
            for (int i = 0; i < 2; ++i) *(LAS u32x4*)(tA + (r0 + 32 * i) * TP + c8 * 16) = ra[i];
#pragma unroll
            for (int i = 0; i < 4; ++i) *(LAS u32x4*)(tB + (r0 + 32 * i) * TP + c8 * 16) = rb[i];
            __syncthreads();
            if (ks + 1 < nks) {
#pragma unroll
                for (int i = 0; i < 2; ++i) ra[i] = *(const u32x4*)(ap + (size_t)(32 * i) * lda + (ks + 1) * 128);
#pragma unroll
                for (int i = 0; i < 4; ++i) rb[i] = *(const u32x4*)(bp + (size_t)(32 * i) * ldb + (ks + 1) * 128);
            }
#pragma unroll
            for (int kk = 0; kk < 4; ++kk) {
                const bf16x8 bf = *(const LAS bf16x8*)(tB + (16 * wid + i15) * TP + kk * 64 + kq * 16);
#pragma unroll
                for (int tb = 0; tb < 4; ++tb) {
                    const bf16x8 af = *(const LAS bf16x8*)(tA + (16 * tb + i15) * TP + kk * 64 + kq * 16);
                    acc[tb] = __builtin_amdgcn_mfma_f32_16x16x32_bf16(bf, af, acc[tb], 0, 0, 0); }
            }
        }
        E(c, acc, sb, n0, red);
    }
    __syncthreads();
}
struct EpiInS {
    const float* ssq1; const float* shw; bf16_t* A; bf16_t* U; bf16_t* GV; float* stv;
    __device__ __forceinline__ void operator()(const Ctx& c, const f32x4 (&acc)[4], int sb, int n0, LAS float* red) const {
        const int i15 = c.lane & 15, kq = c.lane >> 4;
        const unsigned rowb = (unsigned)(MP + sb * DSEQ + i15), col = (unsigned)(n0 + 16 * c.wid + 4 * kq);
        f32x4 pp[4];
#pragma unroll
        for (int tb = 0; tb < 4; ++tb) pp[tb] = ldg4(ssq1, ((rowb + 16 * tb) * 16 + kq * 4) * 4);
        const f32x4 bv = ldg4(shw + (size_t)(NBP + sb) * DIN, col * 4);
        bf16_t* const dbase = n0 < 512 ? A : (n0 < 1024 ? U - 512 : GV - 1024);
        float s1[4], s2[4];
#pragma unroll
        for (int tb = 0; tb < 4; ++tb) {
            const f32x4 p = pp[tb]; const float rstd = rsqrtf(quad_row_sum((p[0] + p[1]) + (p[2] + p[3])) * (1.0f / D) + EPS);
            f32x4 z = acc[tb] * rstd + bv;
            if (n0 >= 512) z = gelu4(z);
            s1[tb] = (z[0] + z[1]) + (z[2] + z[3]); s2[tb] = (z[0] * z[0] + z[1] * z[1]) + (z[2] * z[2] + z[3] * z[3]);
            stg2(dbase, ((rowb + 16 * tb) * 512 + col) * 2, pack4(z));
        }
        if (n0 >= 1024) {
#pragma unroll
            for (int tb = 0; tb < 4; ++tb) { const float a = quad_row_sum(s1[tb]), b = quad_row_sum(s2[tb]);
                if (kq == 0) { red[(c.wid * 64 + 16 * tb + i15) * 2] = a; red[(c.wid * 64 + 16 * tb + i15) * 2 + 1] = b; } }
            __syncthreads();
            if (c.tid < 64) {
                float a = 0.f, b = 0.f;
#pragma unroll
                for (int w = 0; w < 8; ++w) { a += red[(w * 64 + c.tid) * 2]; b += red[(w * 64 + c.tid) * 2 + 1]; }
                float* dst = stv + (size_t)(MP + sb * DSEQ + c.tid) * 16;
                *(f32x2*)(dst + ((n0 - 1024) >> 7) * 2) = (f32x2){a, b};
                if (n0 == 1024) { *(f32x4*)(dst + 8) = (f32x4){0.f, 0.f, 0.f, 0.f}; *(f32x4*)(dst + 12) = (f32x4){0.f, 0.f, 0.f, 0.f}; }
            }
        }
    }
};
struct EpiResS {
    bf16_t* XR; const float* gate; const float* gnext; const float* scnext; bf16_t* XG; float* ssq;
    __device__ __forceinline__ void operator()(const Ctx& c, const f32x4 (&acc)[4], int sb, int n0, LAS float* red) const {
        const int i15 = c.lane & 15, kq = c.lane >> 4, b = NBP + sb;
        const unsigned rowb = (unsigned)(MP + sb * DSEQ + i15), col = (unsigned)(n0 + 16 * c.wid + 4 * kq);
        u32x2 xv[4];
#pragma unroll
        for (int tb = 0; tb < 4; ++tb) xv[tb] = ldg2(XR, ((rowb + 16 * tb) * D + col) * 2);
        const f32x4 gt = ldg4(gate + (size_t)b * NMOD, col * 4);
        f32x4 gm = (f32x4){0.f, 0.f, 0.f, 0.f};
        if (gnext) gm = ldg4(gnext, col * 4) * (ldg4(scnext + (size_t)b * NMOD, col * 4) + 1.0f);
        float ss[4];
#pragma unroll
        for (int tb = 0; tb < 4; ++tb) {
            const unsigned eo = (rowb + 16 * tb) * D + col;
            const f32x4 x1 = unpack4(xv[tb]) + gt * acc[tb];
            stg2(XR, eo * 2, pack4(x1));
            ss[tb] = (x1[0] * x1[0] + x1[1] * x1[1]) + (x1[2] * x1[2] + x1[3] * x1[3]);
            if (gnext) stg2(XG, eo * 2, pack4(x1 * gm));
        }
#pragma unroll
        for (int tb = 0; tb < 4; ++tb) { const float a = quad_row_sum(ss[tb]); if (kq == 0) red[c.wid * 64 + 16 * tb + i15] = a; }
        __syncthreads();
        if (c.tid < 64) {
            float a = 0.f;
#pragma unroll
            for (int w = 0; w < 8; ++w) a += red[w * 64 + c.tid];
            float* dst = ssq + (size_t)(MP + sb * DSEQ + c.tid) * 16;
            dst[n0 >> 7] = a;
            if (n0 == 0) { *(f32x4*)(dst + 8) = (f32x4){0.f, 0.f, 0.f, 0.f}; *(f32x4*)(dst + 12) = (f32x4){0.f, 0.f, 0.f, 0.f}; }
        }
    }
};
struct EpiFf1S {
    const float* ssq2; const float* shw; bf16_t* F1;
    __device__ __forceinline__ void operator()(const Ctx& c, const f32x4 (&acc)[4], int sb, int n0, LAS float* red) const {
        const int i15 = c.lane & 15, kq = c.lane >> 4;
        const unsigned rowb = (unsigned)(MP + sb * DSEQ + i15), col = (unsigned)(n0 + 16 * c.wid + 4 * kq);
        f32x4 pp[4];
#pragma unroll
        for (int tb = 0; tb < 4; ++tb) pp[tb] = ldg4(ssq2, ((rowb + 16 * tb) * 16 + kq * 4) * 4);
        const f32x4 bv = ldg4(shw + (size_t)(NBP + sb) * DFF, col * 4);
#pragma unroll
        for (int tb = 0; tb < 4; ++tb) {
            const f32x4 p = pp[tb]; const float rstd = rsqrtf(quad_row_sum((p[0] + p[1]) + (p[2] + p[3])) * (1.0f / D) + EPS);
            f32x4 z = acc[tb] * rstd + bv;
            z = __builtin_elementwise_max(z, (f32x4){0.f, 0.f, 0.f, 0.f}); z = z * z;
            stg2(F1, ((rowb + 16 * tb) * DFF + col) * 2, pack4(z));
        }
    }
};
__device__ void phase_final(const Ctx& c) {
    const float* ssq1 = (const float*)(c.k->ws + WS_SSQ1); const float* gf = c.k->in[I_GFIN];
    const bf16_t* XR = (const bf16_t*)(c.k->ws + WS_XR);
    f32x4 g[4];
#pragma unroll
    for (int i = 0; i < 4; ++i) g[i] = *(const f32x4*)(gf + i * 256 + c.lane * 4);
    for (int rg = c.bx; rg < MT / 64; rg += c.G) {
        const int rowb = rg * 64 + c.wid * 8;
        const bf16_t* xr = XR + (size_t)rowb * D;
        float* yr = c.k->out + OUT_Y + (size_t)rowb * D;
        u32x2 x[8][4];
        float p0 = ssq1[(size_t)rowb * 16 + c.lane], p1 = ssq1[(size_t)rowb * 16 + 64 + c.lane];
#pragma unroll
        for (int r = 0; r < 8; ++r)
#pragma unroll
            for (int i = 0; i < 4; ++i) x[r][i] = *(const u32x2*)(xr + r * D + i * 256 + c.lane * 4);
        p0 += __shfl_xor(p0, 1); p0 += __shfl_xor(p0, 2); p0 += __shfl_xor(p0, 4); p0 += __shfl_xor(p0, 8);
        p1 += __shfl_xor(p1, 1); p1 += __shfl_xor(p1, 2); p1 += __shfl_xor(p1, 4); p1 += __shfl_xor(p1, 8);
#pragma unroll
        for (int r = 0; r < 8; ++r) {
            const float rstd = rsqrtf(__shfl(r < 4 ? p0 : p1, 16 * (r & 3)) * (1.0f / D) + EPS);
#pragma unroll
            for (int i = 0; i < 4; ++i) *(f32x4*)(yr + r * D + i * 256 + c.lane * 4) = unpack4(x[r][i]) * rstd * g[i];
        }
    }
}

#define XB_TMO      128
#define XB_XCNT(j)  (256  + 64 * (j))
#define XB_XSUB(j)  (1280 + 64 * (j))
#define XB_XGEN(j)  (2304 + 64 * (j))
#define XB_TOP      3328
#define XB_TOPGEN   3392
#define XCD_BAR_WORDS 3456
#define XB_SPIN_CAP (1u << 18)

__device__ __forceinline__ unsigned xb_ld(unsigned* p)              { return __hip_atomic_load(p, __ATOMIC_RELAXED, __HIP_MEMORY_SCOPE_AGENT); }
__device__ __forceinline__ unsigned xb_add(unsigned* p, unsigned v) { return __hip_atomic_fetch_add(p, v, __ATOMIC_RELAXED, __HIP_MEMORY_SCOPE_AGENT); }
__device__ __forceinline__ unsigned xb_xcc_id() { return (unsigned)__builtin_amdgcn_s_getreg((3 << 11) | 20) & 0xFu; }
#define XB_SPIN(cond, bar) do { unsigned _sp = 0; while (cond) { __builtin_amdgcn_s_sleep(1); \
    if ((++_sp & 255u) == 0u) { if (xb_ld(&(bar)[XB_TMO])) break; if (_sp > XB_SPIN_CAP) { atomicAdd(&(bar)[XB_TMO], 1u); break; } } } } while (0)

struct XcdBarrier {
    unsigned* bar; unsigned x;
    volatile LAS unsigned* st;
};

__device__ __forceinline__ XcdBarrier xcd_barrier_post(unsigned* bar, volatile LAS unsigned* st) {
    XcdBarrier b; b.bar = bar; b.x = xb_xcc_id(); b.st = st;
    if (threadIdx.x == 0) (void)xb_add(&bar[XB_XCNT(b.x)], 1u);
    return b;
}
__device__ __forceinline__ void xcd_barrier_complete(unsigned* bar, unsigned x, unsigned& nloc, unsigned& nx) {
    const unsigned G = gridDim.x * gridDim.y * gridDim.z;
    unsigned sum, cnt, mine, sp = 0u;
    for (;;) {
        sum = 0u; cnt = 0u; mine = 0u;
#pragma unroll
        for (unsigned j = 0; j < 16; ++j) { const unsigned c = xb_ld(&bar[XB_XCNT(j)]); sum += c; cnt += (c > 0u) ? 1u : 0u; mine = (j == x) ? c : mine; }
        if (sum == G) break;
        __builtin_amdgcn_s_sleep(1);
        if ((++sp & 255u) == 0u) { if (xb_ld(&bar[XB_TMO])) break; if (sp > XB_SPIN_CAP) { atomicAdd(&bar[XB_TMO], 1u); break; } }
    }
    nloc = mine > 0u ? mine : 1u; nx = cnt > 0u ? cnt : 1u;
}

__device__ __forceinline__ void xcd_barrier(const XcdBarrier& b) {
    asm volatile("s_waitcnt vmcnt(0)" ::: "memory");
    __syncthreads();
    if (threadIdx.x == 0) {
        unsigned* bar = b.bar;
        __builtin_amdgcn_s_waitcnt(0);
        unsigned nloc = b.st[0], nx = b.st[1];
        if (nloc == 0u) { xcd_barrier_complete(bar, b.x, nloc, nx); b.st[0] = nloc; b.st[1] = nx; }
        const unsigned old = xb_add(&bar[XB_XSUB(b.x)], 1u);
        const unsigned gen = old / nloc;
        if (old + 1u == (gen + 1u) * nloc) {
            __builtin_amdgcn_fence(__ATOMIC_RELEASE, "agent");
            asm volatile("s_waitcnt vmcnt(0)" ::: "memory");
            const unsigned og = xb_add(&bar[XB_TOP], 1u);
            const unsigned tg = og / nx;
            if (og + 1u == (tg + 1u) * nx) xb_add(&bar[XB_TOPGEN], 1u);
            else XB_SPIN(xb_ld(&bar[XB_TOPGEN]) == tg, bar);
            __builtin_amdgcn_fence(__ATOMIC_ACQUIRE, "agent");
            xb_add(&bar[XB_XGEN(b.x)], 1u);
            asm volatile("s_waitcnt vmcnt(0)" ::: "memory");
        } else {
            XB_SPIN(xb_ld(&bar[XB_XGEN(b.x)]) == gen, bar);
            __builtin_amdgcn_fence(__ATOMIC_ACQUIRE, "agent");
            asm volatile("s_waitcnt vmcnt(0)" ::: "memory");
        }
    }
    __syncthreads();
}


constexpr int NPHASE = 2 + 5 * DEPTH + 1;
__global__ void __launch_bounds__(NTHREADS, 2) mk_fwd(Params p) {
    __shared__ __attribute__((aligned(16))) unsigned char shm[pg8::STAGE_BYTES + 16];
    cg::grid_group grid = cg::this_grid();
    if (threadIdx.x < 4) ((LAS unsigned*)((LAS unsigned char*)shm + pg8::STAGE_BYTES))[threadIdx.x] = 0u;
    __syncthreads();
    XcdBarrier xbar = xcd_barrier_post((unsigned*)(p.ws + WS_BAR), (volatile LAS unsigned*)((LAS unsigned char*)shm + pg8::STAGE_BYTES));
    Ctx c;
    c.k = kargs(); c.lds = (LAS unsigned char*)shm;
    c.tid = threadIdx.x; c.lane = c.tid & 63; c.wid = __builtin_amdgcn_readfirstlane(c.tid >> 6); c.G = gridDim.x; c.bx = blockIdx.x;
#ifndef PHMASK
#define PHMASK 0xffff
#endif
#define PHON(k) ((PHMASK >> (k)) & 1)
#ifndef DUPMASK
#define DUPMASK 0
#endif
#define DUPN(k) (((DUPMASK >> (k)) & 1) ? 2 : 1)
    for (int ph = p.ph_lo; ph < p.ph_hi; ++ph) {
        { int t_ = threadIdx.x; asm volatile("" : "+v"(t_)); c.tid = t_; c.lane = t_ & 63; c.wid = __builtin_amdgcn_readfirstlane(t_ >> 6); c.k = kargs(); }
        unsigned char* ws = c.k->ws;
        const float* mod = (const float*)(ws + WS_MOD);
        if (ph == 0) { for (int r_ = 0; r_ < DUPN(0); ++r_) phase_init0(c); }
        else if (ph == 1) { for (int r_ = 0; r_ < DUPN(1); ++r_) phase_init1(c); }
        else if (ph == NPHASE - 1) { if (PHON(7)) phase_final(c); }
        else {
            const int l = (ph - 2) / 5, s = (ph - 2) % 5;
            const float* modl = mod + (size_t)l * NBT * NMOD;
            pg8::StaticOrder S;
            if (s == 0 && PHON(2)) {
                pg8::Gemm g{(const bf16_t*)(ws + WS_XG), (const bf16_t*)(ws + WS_WIN_T) + (size_t)l * DIN * D, MP, DIN, D}; S.init(MP, DIN, c.G, c.bx);
                { EpiInS Es{(const float*)(ws + WS_SSQ1), (const float*)(ws + WS_SHWIN) + (size_t)l * NBT * DIN, (bf16_t*)(ws + WS_A), (bf16_t*)(ws + WS_U), (bf16_t*)(ws + WS_GV), (float*)(ws + WS_STV)};
                  sample_gemm<EpiInS>(c, g.A, D, g.Bt, D, DIN, D, Es); }
                EpiIn E{(const float*)(ws + WS_SSQ1), (const float*)(ws + WS_SHWIN) + (size_t)l * NBT * DIN, (bf16_t*)(ws + WS_A), (bf16_t*)(ws + WS_U), (bf16_t*)(ws + WS_GV), (float*)(ws + WS_STV)};
                for (int r_ = 0; r_ < DUPN(2); ++r_) pg8::gemm_phase<EpiIn>(c.lds, g, S, E);
            } else if (s == 1 && PHON(3)) {
                for (int r_ = 0; r_ < DUPN(3); ++r_) phase_mixer(c, l);
            } else if (s == 2 && PHON(4)) {
                pg8::Gemm g{(const bf16_t*)(ws + WS_CAT), (const bf16_t*)(ws + WS_WOUT_T) + (size_t)l * D * D, MP, D, D}; S.init(MP, D, c.G, c.bx);
                { EpiResS Es{(bf16_t*)(ws + WS_XR), modl + 2 * D, c.k->in[I_GFFN] + l * D, modl + 4 * D, (bf16_t*)(ws + WS_XG), (float*)(ws + WS_SSQ2)};
                  sample_gemm<EpiResS>(c, g.A, D, g.Bt, D, D, D, Es); }
                EpiRes E{(bf16_t*)(ws + WS_XR), modl + 2 * D, c.k->in[I_GFFN] + l * D, modl + 4 * D, (bf16_t*)(ws + WS_XG), (float*)(ws + WS_SSQ2)};
                pg8::gemm_phase<EpiRes>(c.lds, g, S, E);
            } else if (s == 3 && PHON(5)) {
                pg8::Gemm g{(const bf16_t*)(ws + WS_XG), (const bf16_t*)(ws + WS_W1_T) + (size_t)l * DFF * D, MP, DFF, D}; S.init(MP, DFF, c.G, c.bx);
                { EpiFf1S Es{(const float*)(ws + WS_SSQ2), (const float*)(ws + WS_SHW1) + (size_t)l * NBT * DFF, (bf16_t*)(ws + WS_F1)};
                  sample_gemm<EpiFf1S>(c, g.A, D, g.Bt, D, DFF, D, Es); }
                EpiFf1 E{(const float*)(ws + WS_SSQ2), (const float*)(ws + WS_SHW1) + (size_t)l * NBT * DFF, (bf16_t*)(ws + WS_F1)};
                for (int r_ = 0; r_ < DUPN(5); ++r_) pg8::gemm_phase<EpiFf1>(c.lds, g, S, E);
            } else if (s == 4 && PHON(6)) {
                pg8::Gemm g{(const bf16_t*)(ws + WS_F1), (const bf16_t*)(ws + WS_W2_T) + (size_t)l * D * DFF, MP, D, DFF}; S.init(MP, D, c.G, c.bx);
                const bool more = (l + 1 < DEPTH);
                { EpiResS Es{(bf16_t*)(ws + WS_XR), modl + 5 * D, more ? c.k->in[I_GMIX] + (l + 1) * D : nullptr, mod + (size_t)(more ? l + 1 : l) * NBT * NMOD + 1 * D,
                             (bf16_t*)(ws + WS_XG), (float*)(ws + WS_SSQ1)};
                  sample_gemm<EpiResS>(c, g.A, DFF, g.Bt, DFF, D, DFF, Es); }
                EpiRes E{(bf16_t*)(ws + WS_XR), modl + 5 * D, more ? c.k->in[I_GMIX] + (l + 1) * D : nullptr, mod + (size_t)(more ? l + 1 : l) * NBT * NMOD + 1 * D,
                         (bf16_t*)(ws + WS_XG), (float*)(ws + WS_SSQ1)};
                pg8::gemm_phase<EpiRes>(c.lds, g, S, E);
            }
        }
        if (ph + 1 < p.ph_hi) { if (p.ph_hi > NPHASE) grid.sync(); else xcd_barrier(xbar); }
    }
}

extern "C" void kernel_launch(void* const* d_in, const int* in_sizes, int n_in, void* d_out, int out_size, void* d_ws, size_t ws_size, hipStream_t stream) {
    static int grid_blocks = 0;
    if (!grid_blocks) {
        int dev = 0, cus = 0, per_cu = 0;
        hipGetDevice(&dev);
        hipDeviceGetAttribute(&cus, hipDeviceAttributeMultiprocessorCount, dev);
        hipOccupancyMaxActiveBlocksPerMultiprocessor(&per_cu, mk_fwd, NTHREADS, 0);
        if (per_cu < 1) per_cu = 1;
        if (per_cu > 1) per_cu = 1;
        grid_blocks = cus * per_cu;
        if (n_in != 20 || ws_size < WS_END) fprintf(stderr, "kernel_launch: unexpected n_in %d / ws_size %zu (need %zu)\n", n_in, ws_size, (size_t)WS_END);
    }
    Params p{};
    for (int i = 0; i < 20; ++i) p.in[i] = (const float*)d_in[i];
    p.out = (float*)d_out; p.ws = (unsigned char*)d_ws;
#if MK_SINGLE
    (void)hipMemsetAsync((unsigned char*)d_ws + WS_BAR, 0, WS_BAR_BYTES, stream);
    p.ph_lo = 0; p.ph_hi = NPHASE;
    { void* args[] = {&p};
      hipError_t e = hipLaunchCooperativeKernel((void*)mk_fwd, dim3(grid_blocks), dim3(NTHREADS), args, 0, stream);
      if (e != hipSuccess) fprintf(stderr, "cooperative launch failed: %s (grid %d)\n", hipGetErrorString(e), grid_blocks); }
#else
    for (int ph = 0; ph < NPHASE; ++ph) {
        p.ph_lo = ph; p.ph_hi = ph + 1;
        void* args[] = {&p};
        hipError_t e = hipLaunchCooperativeKernel((void*)mk_fwd, dim3(grid_blocks), dim3(NTHREADS), args, 0, stream);
        if (e != hipSuccess) { fprintf(stderr, "cooperative launch failed: %s (grid %d, phase %d)\n", hipGetErrorString(e), grid_blocks, ph); break; }
    }
#endif
}
```

```cpp
#include <hip/hip_runtime.h>
#include <hip/hip_cooperative_groups.h>
#include <cstdio>
namespace cg = cooperative_groups;

#ifndef MK_SINGLE
#define MK_SINGLE 1
#endif

#define LAS __attribute__((address_space(3)))
typedef unsigned short bf16_t;
typedef short bf16x8 __attribute__((ext_vector_type(8)));
typedef short s16x4 __attribute__((ext_vector_type(4)));
typedef float f32x4 __attribute__((ext_vector_type(4)));
typedef float f32x2 __attribute__((ext_vector_type(2)));
typedef unsigned u32x4 __attribute__((ext_vector_type(4)));
typedef unsigned u32x2 __attribute__((ext_vector_type(2)));

constexpr int D = 1024, NBP = 16, SEQ = 4096, MP = NBP * SEQ, NBS = 8, DSEQ = 64, MS = NBS * DSEQ, MT = MP + MS;
constexpr int DIN = 1536, DFF = 4096, DEPTH = 2, NBT = NBP + NBS, PW = 512, SW = 512, NMOD = 6 * D;
constexpr float EPS = 1e-6f;
constexpr int NTHREADS = 512;

constexpr size_t WS_WIN_T = 0;
constexpr size_t WS_WOUT_T = WS_WIN_T + (size_t)DEPTH * DIN * D * 2;
constexpr size_t WS_W1_T = WS_WOUT_T + (size_t)DEPTH * D * D * 2;
constexpr size_t WS_W2_T = WS_W1_T + (size_t)DEPTH * DFF * D * 2;
constexpr size_t WS_WP_T = WS_W2_T + (size_t)DEPTH * DFF * D * 2;
constexpr size_t WS_WSP = WS_WP_T + (size_t)DEPTH * 4 * 128 * 128 * 2;
constexpr size_t WS_MOD = WS_WSP + (size_t)DEPTH * 4 * 128 * 128 * 2;
constexpr size_t WS_SHWIN = WS_MOD + (size_t)DEPTH * NBT * NMOD * 4;
constexpr size_t WS_SHW1 = WS_SHWIN + (size_t)DEPTH * NBT * DIN * 4;
constexpr size_t WS_SSQ1 = WS_SHW1 + (size_t)DEPTH * NBT * DFF * 4;
constexpr size_t WS_SSQ2 = WS_SSQ1 + (size_t)MT * 16 * 4;
constexpr size_t WS_STV = WS_SSQ2 + (size_t)MT * 16 * 4;
constexpr size_t WS_XG = WS_STV + (size_t)MT * 16 * 4;
constexpr size_t WS_F1 = WS_XG + (size_t)MT * D * 2;
constexpr size_t WS_A = WS_F1;
constexpr size_t WS_U = WS_A + (size_t)MT * PW * 2;
constexpr size_t WS_GV = WS_U + (size_t)MT * SW * 2;
constexpr size_t WS_CAT = WS_GV + (size_t)MT * SW * 2;
constexpr size_t WS_XR = WS_F1 + (size_t)MT * DFF * 2;
constexpr size_t WS_BAR = WS_XR + (size_t)MT * D * 2;
constexpr size_t WS_BAR_BYTES = 16384;
constexpr size_t WS_END = WS_BAR + WS_BAR_BYTES;

constexpr size_t OUT_Y = 0;
constexpr size_t OUT_SPP = (size_t)MT * D;
constexpr size_t OUT_SPS = OUT_SPP + (size_t)DEPTH * NBP * 15 * PW;
constexpr size_t OUT_SV = OUT_SPS + (size_t)DEPTH * NBS * 15 * PW;

struct Params {
    const float* in[20];
    float* out;
    unsigned char* ws;
    int ph_lo, ph_hi;
};
enum { I_XP = 0, I_XS, I_SPOOL, I_CP, I_CS, I_WADA, I_BADA, I_GMIX, I_WIN, I_WPOOL, I_PSCALE, I_VG, I_VB, I_WSP, I_BSP, I_WOUT, I_GFFN, I_W1, I_W2, I_GFIN };

__device__ __forceinline__ unsigned cvt_pk_bf16(float lo, float hi) { unsigned r; asm volatile("v_cvt_pk_bf16_f32 %0, %1, %2" : "=v"(r) : "v"(lo), "v"(hi)); return r; }
__device__ __forceinline__ float bflo(unsigned w) { return __uint_as_float(w << 16); }
__device__ __forceinline__ float bfhi(unsigned w) { return __uint_as_float(w & 0xffff0000u); }
__device__ __forceinline__ int batch_of(int row) { return row < MP ? (row >> 12) : NBP + ((row - MP) >> 6); }
__device__ __forceinline__ f32x2 gelu_pk(f32x2 v) {
    const f32x2 av = __builtin_elementwise_abs(v), d = av * 0.2316418882f + 1.0f;
    f32x2 t; t.x = __builtin_amdgcn_rcpf(d.x); t.y = __builtin_amdgcn_rcpf(d.y);
    f32x2 q = t * 0.5307027145f + (-0.7265760135f); q = q * t + 0.7107068705f; q = q * t + (-0.142248368f); q = q * t + 0.127414796f; q = q * t;
    const f32x2 s = (v * v) * (-0.72134752044f);
    f32x2 e; e.x = __builtin_amdgcn_exp2f(s.x); e.y = __builtin_amdgcn_exp2f(s.y);
    const f32x2 m = v * (q * e), r = v - m;
    f32x2 o; o.x = v.x < 0.f ? m.x : r.x; o.y = v.y < 0.f ? m.y : r.y; return o;
}
__device__ __forceinline__ f32x4 gelu4(f32x4 v) { f32x2 a = gelu_pk((f32x2){v[0], v[1]}), b = gelu_pk((f32x2){v[2], v[3]}); return (f32x4){a.x, a.y, b.x, b.y}; }
__device__ __forceinline__ float wave_sum(float v) {
#pragma unroll
    for (int o = 32; o >= 1; o >>= 1) v += __shfl_xor(v, o);
    return v;
}
__device__ __forceinline__ float quad_row_sum(float v) { v += __shfl_xor(v, 16); v += __shfl_xor(v, 32); return v; }

namespace pg8 {
constexpr int BM = 256, BK = 64, HALF = 128, HTB = HALF * BK * 2, STAGE_BYTES = 8 * HTB, NXCD = 8, WGM = 8;
__device__ __forceinline__ int lds_byte(int r, int c) { const int st = (r >> 4) * 2 + (c >> 5), rr = r & 15, cc = c & 31, ob = rr * 64 + cc * 2; return st * 1024 + (ob ^ (((ob >> 9) & 1) << 5)); }
__device__ __forceinline__ void stage_rc(int b, int& R, int& C) { const int st = b / 1024, sb = b % 1024, swz = sb ^ (((sb >> 9) & 1) << 5); R = (st >> 1) * 16 + swz / 64; C = (st & 1) * 32 + (swz % 64) / 2; }
struct Unit { int pm, pn; };
struct Gemm { const bf16_t* A; const bf16_t* Bt; int M, N, K; };
struct StaticOrder {
    int nM, nN, nwg, G, c;
    __device__ void init(int M, int N, int G_, int c_) { nM = M / BM; nN = N / BM; nwg = nM * nN; G = G_; c = c_; }
    __device__ bool next(int i, Unit& u) const {
        const long L = (long)i * G + c; if (L >= nwg) return false;
        int wgid = (int)L; { const int q = nwg / NXCD, r = nwg % NXCD, xcd = wgid % NXCD, off = wgid / NXCD; wgid = (xcd < r ? xcd * (q + 1) : r * (q + 1) + (xcd - r) * q) + off; }
        const int nig = WGM * nN, gid = wgid / nig, fm = gid * WGM, gsz = (nM - fm) < WGM ? (nM - fm) : WGM;
        u.pm = fm + ((wgid % nig) % gsz); u.pn = (wgid % nig) / gsz; return true;
    }
};

template <class Epi>
__device__ __forceinline__ void gemm_phase(LAS unsigned char* lds, const Gemm g, const StaticOrder& S, const Epi& E) {
    int tid_ = threadIdx.x; asm volatile("" : "+v"(tid_));
    const int tid = tid_, wid = __builtin_amdgcn_readfirstlane(tid >> 6), lane = tid & 63, wr = wid >> 2, wc = wid & 3, fr = lane & 15, fq = lane >> 4;
    const int K = g.K, nt = K / BK;
    unsigned voffA[2], voffB[2];
#pragma unroll
    for (int i = 0; i < 2; ++i) { int R, C; stage_rc(tid * 16 + i * 8192, R, C); voffA[i] = (unsigned)(R * K + C) * 2u; voffB[i] = (unsigned)(R * K + C) * 2u; }
    const size_t kstep = (size_t)(BK * 2);
    const size_t hstep = (size_t)HALF * K * 2;
    const size_t tstep = 2 * hstep;
    const unsigned ldsw = (unsigned)wid * 1024u;
    const int aoff = lds_byte(wr * 64 + fr, fq * 8), boff = lds_byte(wc * 32 + fr, fq * 8);
#define PG8_SA(b, h) (((b) * 2 + (h)) * HTB)
#define PG8_SB(b, h) ((4 + (b) * 2 + (h)) * HTB)
#define PG8_STAGE(bufoff, gbase, voff) do { _Pragma("unroll") for (int _i = 0; _i < 2; ++_i) \
        __builtin_amdgcn_global_load_lds((const unsigned*)((const char*)(gbase) + (voff)[_i]), (LAS unsigned*)(lds + (bufoff) + ldsw + _i * 8192), 16, 0, 0); } while (0)
#define PG8_LDA(dst, b, h) do { _Pragma("unroll") for (int m = 0; m < 4; ++m) _Pragma("unroll") for (int k = 0; k < 2; ++k) dst[m][k] = *(const LAS bf16x8*)(lds + PG8_SA(b, h) + aoff + m * 2048 + k * 1024); } while (0)
#define PG8_LDB(dst, b, h) do { _Pragma("unroll") for (int n = 0; n < 2; ++n) _Pragma("unroll") for (int k = 0; k < 2; ++k) dst[n][k] = *(const LAS bf16x8*)(lds + PG8_SB(b, h) + boff + n * 2048 + k * 1024); } while (0)
#define PG8_MMA(ai, bj, At, Bt) do { __builtin_amdgcn_s_setprio(1); _Pragma("unroll") for (int m = 0; m < 4; ++m) _Pragma("unroll") for (int n = 0; n < 2; ++n) _Pragma("unroll") for (int k = 0; k < 2; ++k) \
        acc[ai][bj][m][n] = __builtin_amdgcn_mfma_f32_16x16x32_bf16(Bt[n][k], At[m][k], acc[ai][bj][m][n], 0, 0, 0); __builtin_amdgcn_s_setprio(0); } while (0)
#define PG8_WAIT_V(n) asm volatile("s_waitcnt vmcnt(" #n ")" ::: "memory")
#define PG8_WAIT_L(n) asm volatile("s_waitcnt lgkmcnt(" #n ")" ::: "memory")
#define PG8_BAR __builtin_amdgcn_s_barrier()
#define PG8_SCHED __builtin_amdgcn_sched_barrier(0)
    Unit cur, nxt; int ui = 0;
    if (!S.next(0, cur)) return;
    f32x4 acc[2][2][4][2];
#pragma unroll
    for (int a = 0; a < 2; ++a)
#pragma unroll
        for (int b = 0; b < 2; ++b)
#pragma unroll
            for (int m = 0; m < 4; ++m)
#pragma unroll
                for (int n = 0; n < 2; ++n) acc[a][b][m][n] = (f32x4){0.f, 0.f, 0.f, 0.f};
    bf16x8 At[4][2], B0[2][2], B1[2][2];
    const char* cA = (const char*)g.A + (size_t)cur.pm * tstep; const char* cB = (const char*)g.Bt + (size_t)cur.pn * tstep;
    PG8_STAGE(PG8_SB(0, 0), cB, voffB); PG8_STAGE(PG8_SA(0, 0), cA, voffA); PG8_STAGE(PG8_SB(0, 1), cB + hstep, voffB); PG8_STAGE(PG8_SA(0, 1), cA + hstep, voffA);
    if (wr == 1) PG8_BAR;
    PG8_WAIT_V(4); PG8_BAR;
    PG8_STAGE(PG8_SB(1, 0), cB + kstep, voffB); PG8_STAGE(PG8_SA(1, 0), cA + kstep, voffA); PG8_STAGE(PG8_SB(1, 1), cB + hstep + kstep, voffB);
    PG8_WAIT_V(6); PG8_BAR;
    for (;;) {
        const bool has_next = S.next(ui + 1, nxt);
        const char* nA = has_next ? (const char*)g.A + (size_t)nxt.pm * tstep : cA; const char* nB = has_next ? (const char*)g.Bt + (size_t)nxt.pn * tstep : cB;
        for (int t = 0; t < nt; t += 2) {
            const bool last = (t == nt - 2);
            const char* a1 = cA + (size_t)(t + 1) * kstep;
            const char* a2 = last ? nA : cA + (size_t)(t + 2) * kstep; const char* b2 = last ? nB : cB + (size_t)(t + 2) * kstep;
            const char* a3 = a2 + kstep; const char* b3 = b2 + kstep;
            PG8_LDB(B0, 0, 0); PG8_SCHED; PG8_LDA(At, 0, 0); PG8_STAGE(PG8_SA(1, 1), a1 + hstep, voffA);
            PG8_WAIT_L(8); PG8_BAR; PG8_WAIT_L(0); PG8_MMA(0, 0, At, B0); PG8_BAR; PG8_SCHED;
            PG8_LDB(B1, 0, 1); PG8_STAGE(PG8_SB(0, 0), b2, voffB);
            PG8_BAR; PG8_WAIT_L(0); PG8_MMA(0, 1, At, B1); PG8_BAR;
            PG8_LDA(At, 0, 1); PG8_STAGE(PG8_SA(0, 0), a2, voffA);
            PG8_BAR; PG8_WAIT_L(0); PG8_MMA(1, 0, At, B0); PG8_BAR; PG8_SCHED;
            PG8_STAGE(PG8_SB(0, 1), b2 + hstep, voffB);
            PG8_WAIT_V(6); PG8_BAR; PG8_MMA(1, 1, At, B1); PG8_BAR;
            PG8_LDB(B0, 1, 0); PG8_SCHED; PG8_LDA(At, 1, 0); PG8_STAGE(PG8_SA(0, 1), a2 + hstep, voffA);
            PG8_WAIT_L(8); PG8_BAR; PG8_WAIT_L(0); PG8_MMA(0, 0, At, B0); PG8_BAR; PG8_SCHED;
            PG8_LDB(B1, 1, 1); PG8_STAGE(PG8_SB(1, 0), b3, voffB);
            PG8_BAR; PG8_WAIT_L(0); PG8_MMA(0, 1, At, B1); PG8_BAR;
            PG8_LDA(At, 1, 1); PG8_STAGE(PG8_SA(1, 0), a3, voffA);
            PG8_BAR; PG8_WAIT_L(0); PG8_MMA(1, 0, At, B0); PG8_BAR; PG8_SCHED;
            PG8_STAGE(PG8_SB(1, 1), b3 + hstep, voffB);
            PG8_WAIT_V(6); PG8_BAR; PG8_MMA(1, 1, At, B1); PG8_BAR;
        }
        E(acc, cur, wr, wc, fr, fq);
        if (!has_next) break;
#pragma unroll
        for (int a = 0; a < 2; ++a)
#pragma unroll
            for (int b = 0; b < 2; ++b)
#pragma unroll
                for (int m = 0; m < 4; ++m)
#pragma unroll
                    for (int n = 0; n < 2; ++n) acc[a][b][m][n] = (f32x4){0.f, 0.f, 0.f, 0.f};
        cur = nxt; cA = nA; cB = nB; ++ui;
    }
    PG8_WAIT_V(0);
    if (wr == 0) PG8_BAR;
    PG8_BAR;
#undef PG8_SA
#undef PG8_SB
#undef PG8_STAGE
#undef PG8_LDA
#undef PG8_LDB
#undef PG8_MMA
#undef PG8_WAIT_V
#undef PG8_WAIT_L
#undef PG8_BAR
#undef PG8_SCHED
}
}

typedef f32x4 AccT[2][2][4][2];

__device__ __forceinline__ f32x4 ldg4(const void* base, unsigned off) { return *(const f32x4*)((const char*)base + off); }
__device__ __forceinline__ u32x2 ldg2(const void* base, unsigned off) { return *(const u32x2*)((const char*)base + off); }
__device__ __forceinline__ f32x4 unpack4(u32x2 w) { return (f32x4){bflo(w.x), bfhi(w.x), bflo(w.y), bfhi(w.y)}; }
__device__ __forceinline__ void stg4(void* base, unsigned off, f32x4 v) { *(f32x4*)((char*)base + off) = v; }
__device__ __forceinline__ void stg2(void* base, unsigned off, u32x2 v) { *(u32x2*)((char*)base + off) = v; }
__device__ __forceinline__ void stf2(void* base, unsigned off, f32x2 v) { *(f32x2*)((char*)base + off) = v; }
__device__ __forceinline__ void stf1(void* base, unsigned off, float v) { *(float*)((char*)base + off) = v; }
__device__ __forceinline__ u32x2 pack4(f32x4 z) { u32x2 w; w.x = cvt_pk_bf16(z[0], z[1]); w.y = cvt_pk_bf16(z[2], z[3]); return w; }
constexpr unsigned CO[2][2] = {{0u, 16u}, {128u, 144u}};

struct EpiIn {
    const float* ssq1; const float* shw; bf16_t* A; bf16_t* U; bf16_t* GV; float* stv;
    __device__ __forceinline__ void operator()(const AccT& acc, const pg8::Unit& u, int wr, int wc, int fr, int fq) const {
        const int rowu = u.pm * 256 + wr * 64;
        const unsigned colb = (unsigned)(u.pn * 256 + wc * 32 + 4 * fq), rowb = (unsigned)(rowu + fr);
        bf16_t* const dbase = u.pn < 2 ? A : (u.pn < 4 ? U - 512 : GV - 1024);
        const float* bias = shw + (size_t)batch_of(rowu) * DIN;
        f32x4 pp[2][4], bv[2][2];
#pragma unroll
        for (int ai = 0; ai < 2; ++ai)
#pragma unroll
            for (int m = 0; m < 4; ++m) pp[ai][m] = ldg4(ssq1, ((rowb + ai * 128 + m * 16) * 16 + fq * 4) * 4);
#pragma unroll
        for (int bj = 0; bj < 2; ++bj)
#pragma unroll
            for (int n = 0; n < 2; ++n) bv[bj][n] = ldg4(bias, (colb + CO[bj][n]) * 4);
        float rstd[2][4];
#pragma unroll
        for (int ai = 0; ai < 2; ++ai)
#pragma unroll
            for (int m = 0; m < 4; ++m) { const f32x4 p = pp[ai][m]; rstd[ai][m] = rsqrtf(quad_row_sum((p[0] + p[1]) + (p[2] + p[3])) * (1.0f / D) + EPS); }
#pragma unroll
        for (int ai = 0; ai < 2; ++ai) {
            float s1[4], s2[4];
#pragma unroll
            for (int m = 0; m < 4; ++m) {
                const unsigned row = rowb + ai * 128 + m * 16;
                float t1 = 0.f, t2 = 0.f;
#pragma unroll
                for (int bj = 0; bj < 2; ++bj)
#pragma unroll
                    for (int n = 0; n < 2; ++n) {
                        f32x4 z = acc[ai][bj][m][n] * rstd[ai][m] + bv[bj][n];
                        if (u.pn >= 2) z = gelu4(z);
                        if (u.pn >= 4) { t1 += (z[0] + z[1]) + (z[2] + z[3]); t2 += (z[0] * z[0] + z[1] * z[1]) + (z[2] * z[2] + z[3] * z[3]); }
                        stg2(dbase, (row * 512 + colb + CO[bj][n]) * 2, pack4(z));
                    }
                s1[m] = t1; s2[m] = t2;
            }
            if (u.pn >= 4) {
#pragma unroll
                for (int m = 0; m < 4; ++m) {
                    const float a = quad_row_sum(s1[m]), b = quad_row_sum(s2[m]);
                    if (fq == 0) stf2(stv, ((rowb + ai * 128 + m * 16) * 16 + ((u.pn - 4) * 4 + wc) * 2) * 4, (f32x2){a, b});
                }
            }
        }
    }
};
struct EpiRes {
    bf16_t* XR; const float* gate;
    const float* gnext; const float* scnext;
    bf16_t* XG; float* ssq;
    __device__ __forceinline__ void operator()(const AccT& acc, const pg8::Unit& u, int wr, int wc, int fr, int fq) const {
        const int rowu = u.pm * 256 + wr * 64;
        const unsigned colb = (unsigned)(u.pn * 256 + wc * 32 + 4 * fq), rowb = (unsigned)(rowu + fr);
        const int b = batch_of(rowu);
        f32x4 gt[2][2], gm[2][2];
        u32x2 ring[3][2][2];
#define ER_LOADROW(r_, slot_) do { const unsigned ro_ = (rowb + ((r_) >> 2) * 128 + ((r_) & 3) * 16) * D + colb; \
            _Pragma("unroll") for (int bj = 0; bj < 2; ++bj) _Pragma("unroll") for (int n = 0; n < 2; ++n) ring[slot_][bj][n] = ldg2(XR, (ro_ + CO[bj][n]) * 2); } while (0)
        ER_LOADROW(0, 0); ER_LOADROW(1, 1);
#pragma unroll
        for (int bj = 0; bj < 2; ++bj)
#pragma unroll
            for (int n = 0; n < 2; ++n) {
                const unsigned co = (colb + CO[bj][n]) * 4;
                gt[bj][n] = ldg4(gate + (size_t)b * NMOD, co);
                if (gnext) gm[bj][n] = ldg4(gnext, co) * (ldg4(scnext + (size_t)b * NMOD, co) + 1.0f);
                else gm[bj][n] = (f32x4){0.f, 0.f, 0.f, 0.f};
            }
#pragma unroll
        for (int r = 0; r < 8; ++r) {
            const int ai = r >> 2, m = r & 3; const unsigned row = rowb + ai * 128 + m * 16;
            if (r + 2 < 8) ER_LOADROW(r + 2, (r + 2) % 3);
            float ss = 0.f;
#pragma unroll
            for (int bj = 0; bj < 2; ++bj)
#pragma unroll
                for (int n = 0; n < 2; ++n) {
                    const unsigned eo = row * D + colb + CO[bj][n];
                    const f32x4 x1 = unpack4(ring[r % 3][bj][n]) + gt[bj][n] * acc[ai][bj][m][n];
                    stg2(XR, eo * 2, pack4(x1));
                    ss += (x1[0] * x1[0] + x1[1] * x1[1]) + (x1[2] * x1[2] + x1[3] * x1[3]);
                    if (gnext) stg2(XG, eo * 2, pack4(x1 * gm[bj][n]));
                }
            ss = quad_row_sum(ss);
            if (fq == 0) stf1(ssq, (row * 16 + u.pn * 4 + wc) * 4, ss);
        }
#undef ER_LOADROW
    }
};
struct EpiFf1 {
    const float* ssq2; const float* shw; bf16_t* F1;
    __device__ __forceinline__ void operator()(const AccT& acc, const pg8::Unit& u, int wr, int wc, int fr, int fq) const {
        const int rowu = u.pm * 256 + wr * 64;
        const unsigned colb = (unsigned)(u.pn * 256 + wc * 32 + 4 * fq), rowb = (unsigned)(rowu + fr);
        const float* bias = shw + (size_t)batch_of(rowu) * DFF;
        f32x4 pp[2][4], bv[2][2];
#pragma unroll
        for (int ai = 0; ai < 2; ++ai)
#pragma unroll
            for (int m = 0; m < 4; ++m) pp[ai][m] = ldg4(ssq2, ((rowb + ai * 128 + m * 16) * 16 + fq * 4) * 4);
#pragma unroll
        for (int bj = 0; bj < 2; ++bj)
#pragma unroll
            for (int n = 0; n < 2; ++n) bv[bj][n] = ldg4(bias, (colb + CO[bj][n]) * 4);
        float rstd[2][4];
#pragma unroll
        for (int ai = 0; ai < 2; ++ai)
#pragma unroll
            for (int m = 0; m < 4; ++m) { const f32x4 p = pp[ai][m]; rstd[ai][m] = rsqrtf(quad_row_sum((p[0] + p[1]) + (p[2] + p[3])) * (1.0f / D) + EPS); }
#pragma unroll
        for (int ai = 0; ai < 2; ++ai)
#pragma unroll
            for (int m = 0; m < 4; ++m) {
                const unsigned row = rowb + ai * 128 + m * 16;
#pragma unroll
                for (int bj = 0; bj < 2; ++bj)
#pragma unroll
                    for (int n = 0; n < 2; ++n) {
                        f32x4 z = acc[ai][bj][m][n] * rstd[ai][m] + bv[bj][n];
                        z = __builtin_elementwise_max(z, (f32x4){0.f, 0.f, 0.f, 0.f}); z = z * z;
                        stg2(F1, (row * DFF + colb + CO[bj][n]) * 2, pack4(z));
                    }
            }
    }
};

typedef const __attribute__((address_space(4))) Params* KArgs;
__device__ __forceinline__ KArgs kargs() { KArgs k = (KArgs)__builtin_amdgcn_kernarg_segment_ptr(); asm volatile("" : "+s"(k)); return k; }
struct Ctx {
    KArgs k;
    LAS unsigned char* lds; int tid, lane, wid, G, bx;
};

__device__ __forceinline__ void gemv24_unit(const Ctx& c, int mode, const float* vsrc, int vstride, const float* W, int ldw, int n0, const float* bias, float* out, int ldo) {
    LAS float* tbl = (LAS float*)c.lds;
    __syncthreads();
    for (int i = c.tid; i < NBT * D; i += NTHREADS) {
        const int b = i >> 10, k = i & 1023; float v;
        if (mode == 0) { const float x = b < NBP ? c.k->in[I_CP][b * D + k] : c.k->in[I_CS][(b - NBP) * D + k]; v = x / (1.0f + __expf(-x)); }
        else v = vsrc[(size_t)b * vstride + k];
        tbl[k * NBT + b] = v;
    }
    __syncthreads();
    const int ks = c.tid >> 6, j = c.tid & 63;
    float acc[NBT];
#pragma unroll
    for (int b = 0; b < NBT; ++b) acc[b] = 0.f;
    const float* wp = W + (size_t)(ks * 128) * ldw + n0 + j;
#pragma unroll 8
    for (int kk = 0; kk < 128; ++kk) {
        const float w = wp[(size_t)kk * ldw];
        const LAS f32x4* t4 = (const LAS f32x4*)(tbl + (ks * 128 + kk) * NBT);
#pragma unroll
        for (int q = 0; q < 6; ++q) { const f32x4 t = t4[q]; acc[4 * q + 0] += t[0] * w; acc[4 * q + 1] += t[1] * w; acc[4 * q + 2] += t[2] * w; acc[4 * q + 3] += t[3] * w; }
    }
    __syncthreads();
    LAS float* red = (LAS float*)c.lds;
#pragma unroll
    for (int b = 0; b < NBT; ++b) red[(ks * NBT + b) * 64 + j] = acc[b];
    __syncthreads();
    for (int o = c.tid; o < NBT * 64; o += NTHREADS) {
        const int b = o >> 6, jj = o & 63; float s = bias ? bias[n0 + jj] : 0.f;
#pragma unroll
        for (int q = 0; q < 8; ++q) s += red[(q * NBT + b) * 64 + jj];
        out[(size_t)b * ldo + n0 + jj] = s;
    }
}
__device__ __forceinline__ void transpose_unit(const Ctx& c, const float* W, int K, int N, int k0, int n0, bf16_t* Wt, const float* nscale) {
    LAS float* tile = (LAS float*)c.lds;
    __syncthreads();
    { const int r = c.tid >> 4, c4 = c.tid & 15;
#pragma unroll
      for (int i = 0; i < 2; ++i) { const int kk = r + 32 * i; const f32x4 v = *(const f32x4*)(W + (size_t)(k0 + kk) * N + n0 + c4 * 4);
          tile[kk * 65 + c4 * 4 + 0] = v[0]; tile[kk * 65 + c4 * 4 + 1] = v[1]; tile[kk * 65 + c4 * 4 + 2] = v[2]; tile[kk * 65 + c4 * 4 + 3] = v[3]; } }
    __syncthreads();
    { const int nn = c.tid >> 3, k8 = c.tid & 7; const float s = nscale ? nscale[n0 + nn] : 1.0f; float f[8];
#pragma unroll
      for (int j = 0; j < 8; ++j) f[j] = tile[(k8 * 8 + j) * 65 + nn] * s;
      u32x4 w; w.x = cvt_pk_bf16(f[0], f[1]); w.y = cvt_pk_bf16(f[2], f[3]); w.z = cvt_pk_bf16(f[4], f[5]); w.w = cvt_pk_bf16(f[6], f[7]);
      *(u32x4*)(Wt + (size_t)(n0 + nn) * K + k0 + k8 * 8) = w; }
}

constexpr int NU_MOD = DEPTH * (NMOD / 64);
constexpr int T_IN = 16 * 24, T_OUT = 16 * 16, T_F1 = 16 * 64, T_F2 = 64 * 16, T_LAYER = T_IN + T_OUT + T_F1 + T_F2;
constexpr int NU_TR = DEPTH * T_LAYER, NU_WP = DEPTH * 4 * 4, NU_WS = DEPTH * 4 * 4;
constexpr int NU_I0 = NU_MOD + NU_TR + NU_WP + NU_WS;
__device__ void phase_init0(const Ctx& c) {
    float* mod = (float*)(c.k->ws + WS_MOD);
    for (int u = c.bx; u < NU_I0; u += c.G) {
        if (u < NU_MOD) {
            const int l = u / (NMOD / 64), nb = u % (NMOD / 64);
            gemv24_unit(c, 0, nullptr, 0, c.k->in[I_WADA] + (size_t)l * D * NMOD, NMOD, nb * 64, c.k->in[I_BADA] + (size_t)l * NMOD, mod + (size_t)l * NBT * NMOD, NMOD);
        } else if (u < NU_MOD + NU_TR) {
            const int v = u - NU_MOD, l = v / T_LAYER; int r = v % T_LAYER;
            if (r < T_IN) transpose_unit(c, c.k->in[I_WIN] + (size_t)l * D * DIN, D, DIN, (r / 24) * 64, (r % 24) * 64, (bf16_t*)(c.k->ws + WS_WIN_T) + (size_t)l * DIN * D, nullptr);
            else if ((r -= T_IN) < T_OUT) transpose_unit(c, c.k->in[I_WOUT] + (size_t)l * D * D, D, D, (r / 16) * 64, (r % 16) * 64, (bf16_t*)(c.k->ws + WS_WOUT_T) + (size_t)l * D * D, nullptr);
            else if ((r -= T_OUT) < T_F1) transpose_unit(c, c.k->in[I_W1] + (size_t)l * D * DFF, D, DFF, (r / 64) * 64, (r % 64) * 64, (bf16_t*)(c.k->ws + WS_W1_T) + (size_t)l * DFF * D, nullptr);
            else { r -= T_F1; transpose_unit(c, c.k->in[I_W2] + (size_t)l * DFF * D, DFF, D, (r / 16) * 64, (r % 16) * 64, (bf16_t*)(c.k->ws + WS_W2_T) + (size_t)l * D * DFF, nullptr); }
        } else if (u < NU_MOD + NU_TR + NU_WP) {
            const int v = u - NU_MOD - NU_TR, lg = v >> 2, t = v & 3, l = lg >> 2, g = lg & 3;
            transpose_unit(c, c.k->in[I_WPOOL] + (size_t)lg * 128 * 128, 128, 128, (t >> 1) * 64, (t & 1) * 64, (bf16_t*)(c.k->ws + WS_WP_T) + (size_t)lg * 128 * 128, c.k->in[I_PSCALE] + l * PW + g * 128);
        } else {
            const int v = u - NU_MOD - NU_TR - NU_WP, lh = v >> 2, t = v & 3, t0 = (t >> 1) * 64, s0 = (t & 1) * 64;
            const int tt = t0 + (c.tid >> 3), s8 = s0 + (c.tid & 7) * 8;
            const float* src = c.k->in[I_WSP] + ((size_t)lh * 128 + tt) * 128 + s8;
            const f32x4 a = *(const f32x4*)src, b = *(const f32x4*)(src + 4);
            float f[8] = {a[0], a[1], a[2], a[3], b[0], b[1], b[2], b[3]};
#pragma unroll
            for (int j = 0; j < 8; ++j) if (s8 + j > tt) f[j] = 0.f;
            u32x4 w; w.x = cvt_pk_bf16(f[0], f[1]); w.y = cvt_pk_bf16(f[2], f[3]); w.z = cvt_pk_bf16(f[4], f[5]); w.w = cvt_pk_bf16(f[6], f[7]);
            *(u32x4*)((bf16_t*)(c.k->ws + WS_WSP) + ((size_t)lh * 128 + tt) * 128 + s8) = w;
        }
    }
}
constexpr int NU_SH_L = DIN / 64 + DFF / 64;
__device__ void phase_init1(const Ctx& c) {
    const float* mod = (const float*)(c.k->ws + WS_MOD);
    for (int u = c.bx; u < DEPTH * NU_SH_L; u += c.G) {
        const int l = u / NU_SH_L, r = u % NU_SH_L;
        const float* ml = mod + (size_t)l * NBT * NMOD;
        if (r < DIN / 64) gemv24_unit(c, 1, ml + 0 * D, NMOD, c.k->in[I_WIN] + (size_t)l * D * DIN, DIN, r * 64, nullptr, (float*)(c.k->ws + WS_SHWIN) + (size_t)l * NBT * DIN, DIN);
        else gemv24_unit(c, 1, ml + 3 * D, NMOD, c.k->in[I_W1] + (size_t)l * D * DFF, DFF, (r - DIN / 64) * 64, nullptr, (float*)(c.k->ws + WS_SHW1) + (size_t)l * NBT * DFF, DFF);
    }
    bf16_t* XG = (bf16_t*)(c.k->ws + WS_XG); bf16_t* XR = (bf16_t*)(c.k->ws + WS_XR); float* ssq1 = (float*)(c.k->ws + WS_SSQ1);
    const float* gm = c.k->in[I_GMIX];
    for (int rg = c.bx; rg < MT / 32; rg += c.G) {
        const int rowb = rg * 32 + c.wid * 4, b = batch_of(rowb);
        const float* sc = mod + (size_t)b * NMOD + 1 * D;
        f32x4 x[4][4], gmul[4];
#pragma unroll
        for (int r = 0; r < 4; ++r) { const int row = rowb + r;
            const float* xr = row < MP ? c.k->in[I_XP] + (size_t)row * D : c.k->in[I_XS] + (size_t)(row - MP) * D;
#pragma unroll
            for (int i = 0; i < 4; ++i) x[r][i] = *(const f32x4*)(xr + i * 256 + c.lane * 4); }
#pragma unroll
        for (int i = 0; i < 4; ++i) { const int k = i * 256 + c.lane * 4; gmul[i] = *(const f32x4*)(gm + k) * (*(const f32x4*)(sc + k) + 1.0f); }
#pragma unroll
        for (int r = 0; r < 4; ++r) {
            float ss = 0.f;
#pragma unroll
            for (int i = 0; i < 4; ++i) { const f32x4 v = x[r][i]; ss += (v[0] * v[0] + v[1] * v[1]) + (v[2] * v[2] + v[3] * v[3]);
                *(u32x2*)(XG + (size_t)(rowb + r) * D + i * 256 + c.lane * 4) = pack4(v * gmul[i]);
                *(u32x2*)(XR + (size_t)(rowb + r) * D + i * 256 + c.lane * 4) = pack4(v); }
            ss = wave_sum(ss);
            if (c.lane < 16) ssq1[(size_t)(rowb + r) * 16 + c.lane] = c.lane == 0 ? ss : 0.f;
        }
    }
}
constexpr int TP = 272;
__device__ __forceinline__ void unpack8(u32x4 v, float* f) { f[0] = bflo(v.x); f[1] = bfhi(v.x); f[2] = bflo(v.y); f[3] = bfhi(v.y); f[4] = bflo(v.z); f[5] = bfhi(v.z); f[6] = bflo(v.w); f[7] = bfhi(v.w); }
__device__ __forceinline__ u32x4 pack8(const float* f) { u32x4 w; w.x = cvt_pk_bf16(f[0], f[1]); w.y = cvt_pk_bf16(f[2], f[3]); w.z = cvt_pk_bf16(f[4], f[5]); w.w = cvt_pk_bf16(f[6], f[7]); return w; }
struct MU { int ct, j, sb, row0, nrows, bm, tseq0; bool samp; };
__device__ __forceinline__ MU mu_of(int u) {
    MU m; m.ct = u >> 3; m.j = (u + (u >> 8)) & 7;
    m.samp = m.ct >= MP / 128; m.sb = m.ct - MP / 128;
    m.row0 = m.samp ? MP + m.sb * DSEQ : m.ct * 128; m.nrows = m.samp ? DSEQ : 128; m.bm = m.samp ? NBP + m.sb : (m.ct >> 5); m.tseq0 = m.samp ? SEQ : (m.ct & 31) * 128;
    return m;
}
__device__ __forceinline__ void mix_prefetch(const Ctx& c, int l, const MU& m, u32x4 (&wv)[4], u32x4 (&dv)[5], float (&sv)[4], u32x2 (&uu)[8], float (&bsv)[8], f32x4 (&gb)[4]) {
    unsigned char* ws = c.k->ws;
    const int lane = c.lane, wid = c.wid, i15 = lane & 15, kq = lane >> 4, c8 = c.tid & 15, r0 = c.tid >> 4;
    if (m.j < 4) {
        const int g = m.j;
        const bf16_t* WpT = (const bf16_t*)(ws + WS_WP_T) + (size_t)l * 4 * 128 * 128;
#pragma unroll
        for (int i = 0; i < 4; ++i) wv[i] = *(const u32x4*)(WpT + ((size_t)g * 128 + r0 + 32 * i) * 128 + c8 * 8);
        const bf16_t* ap = (const bf16_t*)(ws + WS_A) + (size_t)m.row0 * PW + g * 128 + c8 * 8;
#pragma unroll
        for (int i = 0; i < 5; ++i) {
            const int rr = r0 + 32 * i, t = rr - 15;
            dv[i] = (u32x4){0u, 0u, 0u, 0u};
            if (rr < 143 && t < m.nrows) {
                if (t >= 0 || (!m.samp && m.tseq0 > 0)) dv[i] = *(const u32x4*)(ap + (ptrdiff_t)t * PW);
                else if (m.samp) { const float* sp = c.k->in[I_SPOOL] + (((size_t)l * NBS + m.sb) * 15 + rr) * PW + g * 128 + c8 * 8;
                    const f32x4 p0 = *(const f32x4*)sp, p1 = *(const f32x4*)(sp + 4);
                    dv[i].x = cvt_pk_bf16(p0[0], p0[1]); dv[i].y = cvt_pk_bf16(p0[2], p0[3]); dv[i].z = cvt_pk_bf16(p1[0], p1[1]); dv[i].w = cvt_pk_bf16(p1[2], p1[3]); }
            }
        }
    } else {
        const int h = m.j - 4, ntb = m.nrows >> 4;
        const bf16_t* Wsp = (const bf16_t*)(ws + WS_WSP) + (size_t)l * 4 * 128 * 128;
        const bf16_t* GVb = (const bf16_t*)(ws + WS_GV); const bf16_t* Ub = (const bf16_t*)(ws + WS_U); const float* stv = (const float*)(ws + WS_STV);
#pragma unroll
        for (int i = 0; i < 4; ++i) wv[i] = *(const u32x4*)(Wsp + ((size_t)h * 128 + r0 + 32 * i) * 128 + c8 * 8);
#pragma unroll
        for (int i = 0; i < 4; ++i) {
            const int sr = r0 + 32 * i; dv[i] = (u32x4){0u, 0u, 0u, 0u}; sv[i] = 0.f;
            if (sr < m.nrows) { const int row = m.row0 + sr; dv[i] = *(const u32x4*)(GVb + (size_t)row * SW + h * 128 + c8 * 8); sv[i] = stv[(size_t)row * 16 + c8]; }
        }
        const float* vg = c.k->in[I_VG] + l * SW + h * 128 + c8 * 8; const float* vb = c.k->in[I_VB] + l * SW + h * 128 + c8 * 8;
        gb[0] = *(const f32x4*)vg; gb[1] = *(const f32x4*)(vg + 4); gb[2] = *(const f32x4*)vb; gb[3] = *(const f32x4*)(vb + 4);
#pragma unroll
        for (int tb = 0; tb < 8; ++tb) { uu[tb] = (u32x2){0u, 0u}; bsv[tb] = 0.f;
            if (tb < ntb) { uu[tb] = *(const u32x2*)(Ub + (size_t)(m.row0 + 16 * tb + i15) * SW + h * 128 + 16 * wid + 4 * kq);
                            bsv[tb] = c.k->in[I_BSP][((size_t)l * 4 + h) * 128 + 16 * tb + i15]; } }
    }
}
__device__ void phase_mixer(const Ctx& c, int l) {
    LAS unsigned char* tA = c.lds; LAS unsigned char* tB = c.lds + 128 * TP; LAS unsigned char* tX = c.lds + 256 * TP;
    float* outp = c.k->out;
    bf16_t* CAT = (bf16_t*)(c.k->ws + WS_CAT);
    const int lane = c.lane, wid = c.wid, i15 = lane & 15, kq = lane >> 4, c8 = c.tid & 15, r0 = c.tid >> 4;
    constexpr int NU = (MP / 128 + NBS) * 8;
    u32x4 wv[4], dv[5]; float sv[4]; u32x2 uu[8]; float bsv[8]; f32x4 gb[4];
    if (c.bx < NU) { const MU m0 = mu_of(c.bx); mix_prefetch(c, l, m0, wv, dv, sv, uu, bsv, gb); }
    for (int u = c.bx; u < NU; u += c.G) {
        const MU m = mu_of(u);
        const int j = m.j, nrows = m.nrows, ntb = nrows >> 4, row0 = m.row0;
        bf16_t* const cbase = CAT + (size_t)row0 * D + (j < 4 ? j * 128 : 512 + (j - 4) * 128) + 16 * wid + 4 * kq;
        u32x2 uc[8]; float bc[8];
        __syncthreads();
        if (j < 4) {
            const int g = j, w = 2 << g;
#pragma unroll
            for (int i = 0; i < 4; ++i) *(LAS u32x4*)(tB + (r0 + 32 * i) * TP + c8 * 16) = wv[i];
#pragma unroll
            for (int i = 0; i < 5; ++i) { const int rr = r0 + 32 * i; if (rr < 143) *(LAS u32x4*)(tX + rr * TP + c8 * 16) = dv[i]; }
            __syncthreads();
#pragma unroll 1
            for (int i = 0; i < 4; ++i) {
                const int t = r0 + 32 * i;
                if (t < nrows) {
                    const LAS unsigned char* xp0 = tX + (t + 15) * TP + c8 * 16;
                    float a0[8], s[8], tmp[8];
                    unpack8(*(const LAS u32x4*)xp0, a0);
#pragma unroll
                    for (int k = 0; k < 8; ++k) s[k] = a0[k];
#pragma unroll 2
                    for (int jj = 1; jj < w; ++jj) { unpack8(*(const LAS u32x4*)(xp0 - jj * TP), tmp);
#pragma unroll
                        for (int k = 0; k < 8; ++k) s[k] += tmp[k]; }
                    const int pos1 = m.tseq0 + t + 1; const float inv = 1.0f / (float)(pos1 < w ? pos1 : w);
                    float dd[8];
#pragma unroll
                    for (int k = 0; k < 8; ++k) dd[k] = s[k] * inv - a0[k];
                    *(LAS u32x4*)(tA + t * TP + c8 * 16) = pack8(dd);
                    float* so = nullptr;
                    if (!m.samp && (m.ct & 31) == 31 && t >= 113) so = outp + OUT_SPP + (((size_t)l * NBP + m.bm) * 15 + (t - 113)) * PW + g * 128 + c8 * 8;
                    if (m.samp && t >= 49) so = outp + OUT_SPS + (((size_t)l * NBS + m.sb) * 15 + (t - 49)) * PW + g * 128 + c8 * 8;
                    if (so) { *(f32x4*)so = (f32x4){a0[0], a0[1], a0[2], a0[3]}; *(f32x4*)(so + 4) = (f32x4){a0[4], a0[5], a0[6], a0[7]}; }
                }
            }
        } else {
            const int h = j - 4;
#pragma unroll
            for (int tb = 0; tb < 8; ++tb) { uc[tb] = uu[tb]; bc[tb] = bsv[tb]; }
#pragma unroll
            for (int i = 0; i < 4; ++i) *(LAS u32x4*)(tA + (r0 + 32 * i) * TP + c8 * 16) = wv[i];
#pragma unroll
            for (int i = 0; i < 4; ++i) {
                const int sr = r0 + 32 * i;
                float sx = sv[i]; sx += __shfl_xor(sx, 2); sx += __shfl_xor(sx, 4); sx += __shfl_xor(sx, 8);
                const float so_ = __shfl_xor(sx, 1);
                const float sum = (c8 & 1) ? so_ : sx, sq = (c8 & 1) ? sx : so_;
                u32x4 outv = (u32x4){0u, 0u, 0u, 0u};
                if (sr < nrows) {
                    float gvf[8]; unpack8(dv[i], gvf);
                    const float mean = sum * (1.0f / SW); float var = sq * (1.0f / SW) - mean * mean; var = var < 0.f ? 0.f : var;
                    const float rstd = rsqrtf(var + EPS);
                    float vl[8];
#pragma unroll
                    for (int k = 0; k < 4; ++k) { vl[k] = (gvf[k] - mean) * rstd * gb[0][k] + gb[2][k]; vl[4 + k] = (gvf[4 + k] - mean) * rstd * gb[1][k] + gb[3][k]; }
                    if (m.samp) { float* so = outp + OUT_SV + (((size_t)l * NBS + m.sb) * DSEQ + sr) * SW + h * 128 + c8 * 8;
                        *(f32x4*)so = (f32x4){vl[0], vl[1], vl[2], vl[3]}; *(f32x4*)(so + 4) = (f32x4){vl[4], vl[5], vl[6], vl[7]}; }
                    outv = pack8(vl);
                }
                *(LAS u32x4*)(tB + sr * TP + c8 * 16) = outv;
            }
        }
        __syncthreads();
        if (u + c.G < NU) { const MU mn = mu_of(u + c.G); mix_prefetch(c, l, mn, wv, dv, sv, uu, bsv, gb); }
        f32x4 acc[8];
#pragma unroll
        for (int tb = 0; tb < 8; ++tb) acc[tb] = (f32x4){0.f, 0.f, 0.f, 0.f};
        if (j < 4) {
#pragma unroll
            for (int kk = 0; kk < 4; ++kk) {
                const bf16x8 bf = *(const LAS bf16x8*)(tB + (16 * wid + i15) * TP + kk * 64 + kq * 16);
#pragma unroll
                for (int tb = 0; tb < 8; ++tb) if (tb < ntb) {
                    const bf16x8 af = *(const LAS bf16x8*)(tA + (16 * tb + i15) * TP + kk * 64 + kq * 16);
                    acc[tb] = __builtin_amdgcn_mfma_f32_16x16x32_bf16(bf, af, acc[tb], 0, 0, 0); }
            }
#pragma unroll
            for (int tb = 0; tb < 8; ++tb) if (tb < ntb) *(u32x2*)(cbase + (size_t)(16 * tb + i15) * D) = pack4(acc[tb]);
        } else {
            const int q = i15 >> 2, p = lane & 3;
#pragma unroll
            for (int kk = 0; kk < 4; ++kk) {
                LAS unsigned char* vp = tB + (32 * kk + 8 * kq + q) * TP + (16 * wid + 4 * p) * 2;
                const s16x4 lo = __builtin_amdgcn_ds_read_tr16_b64_v4i16((LAS s16x4*)vp);
                const s16x4 hi = __builtin_amdgcn_ds_read_tr16_b64_v4i16((LAS s16x4*)(vp + 4 * TP));
                const bf16x8 vf = __builtin_shufflevector(lo, hi, 0, 1, 2, 3, 4, 5, 6, 7);
#pragma unroll
                for (int tb = 0; tb < 8; ++tb) if (tb >= 2 * kk && tb < ntb) {
                    const bf16x8 af = *(const LAS bf16x8*)(tA + (16 * tb + i15) * TP + kk * 64 + kq * 16);
                    acc[tb] = __builtin_amdgcn_mfma_f32_16x16x32_bf16(vf, af, acc[tb], 0, 0, 0); }
            }
#pragma unroll
            for (int tb = 0; tb < 8; ++tb) if (tb < ntb) {
                f32x4 o = acc[tb]; const u32x2 w2 = uc[tb]; const float bs = bc[tb];
                o = (f32x4){bflo(w2.x) * (o[0] + bs), bfhi(w2.x) * (o[1] + bs), bflo(w2.y) * (o[2] + bs), bfhi(w2.y) * (o[3] + bs)};
                *(u32x2*)(cbase + (size_t)(16 * tb + i15) * D) = pack4(o);
            }
        }
    }
}
template <class Epi>
__device__ __forceinline__ void sample_gemm(const Ctx& c, const bf16_t* A, int lda, const bf16_t* Bt, int ldb, int N, int K, const Epi& E) {
    LAS unsigned char* tA = c.lds; LAS unsigned char* tB = c.lds + 128 * TP; LAS float* red = (LAS float*)(c.lds + 256 * TP);
    const int lane = c.lane, wid = c.wid, i15 = lane & 15, kq = lane >> 4, c8 = c.tid & 15, r0 = c.tid >> 4;
    const int ntn = N >> 7, ntiles = NBS * ntn, nks = K >> 7;
    for (int tile = c.bx; tile < ntiles; tile += c.G) {
        const int sb = tile / ntn, n0 = (tile - sb * ntn) * 128;
        const bf16_t* ap = A + (size_t)(MP + sb * DSEQ + r0) * lda + c8 * 8;
        const bf16_t* bp = Bt + (size_t)(n0 + r0) * ldb + c8 * 8;
        u32x4 ra[2], rb[4];
#pragma unroll
        for (int i = 0; i < 2; ++i) ra[i] = *(const u32x4*)(ap + (size_t)(32 * i) * lda);
#pragma unroll
        for (int i = 0; i < 4; ++i) rb[i] = *(const u32x4*)(bp + (size_t)(32 * i) * ldb);
        f32x4 acc[4];
#pragma unroll
        for (int tb = 0; tb < 4; ++tb) acc[tb] = (f32x4){0.f, 0.f, 0.f, 0.f};
#pragma unroll 1
        for (int ks = 0; ks < nks; ++ks) {
            __syncthreads();
#pragma unroll
            for (int i = 0; i < 2; ++i) *(LAS u32x4*)(tA + (r0 + 32 * i) * TP + c8 * 16) = ra[i];
#pragma unroll
            for (int i = 0; i < 4; ++i) *(LAS u32x4*)(tB + (r0 + 32 * i) * TP + c8 * 16) = rb[i];
            __syncthreads();
            if (ks + 1 < nks) {
#pragma unroll
                for (int i = 0; i < 2; ++i) ra[i] = *(const u32x4*)(ap + (size_t)(32 * i) * lda + (ks + 1) * 128);
#pragma unroll
                for (int i = 0; i < 4; ++i) rb[i] = *(const u32x4*)(bp + (size_t)(32 * i) * ldb + (ks + 1) * 128);
            }
#pragma unroll
            for (int kk = 0; kk < 4; ++kk) {
                const bf16x8 bf = *(const LAS bf16x8*)(tB + (16 * wid + i15) * TP + kk * 64 + kq * 16);
#pragma unroll
                for (int tb = 0; tb < 4; ++tb) {
                    const bf16x8 af = *(const LAS bf16x8*)(tA + (16 * tb + i15) * TP + kk * 64 + kq * 16);
                    acc[tb] = __builtin_amdgcn_mfma_f32_16x16x32_bf16(bf, af, acc[tb], 0, 0, 0); }
            }
        }
        E(c, acc, sb, n0, red);
    }
    __syncthreads();
}
struct EpiInS {
    const float* ssq1; const float* shw; bf16_t* A; bf16_t* U; bf16_t* GV; float* stv;
    __device__ __forceinline__ void operator()(const Ctx& c, const f32x4 (&acc)[4], int sb, int n0, LAS float* red) const {
        const int i15 = c.lane & 15, kq = c.lane >> 4;
        const unsigned rowb = (unsigned)(MP + sb * DSEQ + i15), col = (unsigned)(n0 + 16 * c.wid + 4 * kq);
        f32x4 pp[4];
#pragma unroll
        for (int tb = 0; tb < 4; ++tb) pp[tb] = ldg4(ssq1, ((rowb + 16 * tb) * 16 + kq * 4) * 4);
        const f32x4 bv = ldg4(shw + (size_t)(NBP + sb) * DIN, col * 4);
        bf16_t* const dbase = n0 < 512 ? A : (n0 < 1024 ? U - 512 : GV - 1024);
        float s1[4], s2[4];
#pragma unroll
        for (int tb = 0; tb < 4; ++tb) {
            const f32x4 p = pp[tb]; const float rstd = rsqrtf(quad_row_sum((p[0] + p[1]) + (p[2] + p[3])) * (1.0f / D) + EPS);
            f32x4 z = acc[tb] * rstd + bv;
            if (n0 >= 512) z = gelu4(z);
            s1[tb] = (z[0] + z[1]) + (z[2] + z[3]); s2[tb] = (z[0] * z[0] + z[1] * z[1]) + (z[2] * z[2] + z[3] * z[3]);
            stg2(dbase, ((rowb + 16 * tb) * 512 + col) * 2, pack4(z));
        }
        if (n0 >= 1024) {
#pragma unroll
            for (int tb = 0; tb < 4; ++tb) { const float a = quad_row_sum(s1[tb]), b = quad_row_sum(s2[tb]);
                if (kq == 0) { red[(c.wid * 64 + 16 * tb + i15) * 2] = a; red[(c.wid * 64 + 16 * tb + i15) * 2 + 1] = b; } }
            __syncthreads();
            if (c.tid < 64) {
                float a = 0.f, b = 0.f;
#pragma unroll
                for (int w = 0; w < 8; ++w) { a += red[(w * 64 + c.tid) * 2]; b += red[(w * 64 + c.tid) * 2 + 1]; }
                float* dst = stv + (size_t)(MP + sb * DSEQ + c.tid) * 16;
                *(f32x2*)(dst + ((n0 - 1024) >> 7) * 2) = (f32x2){a, b};
                if (n0 == 1024) { *(f32x4*)(dst + 8) = (f32x4){0.f, 0.f, 0.f, 0.f}; *(f32x4*)(dst + 12) = (f32x4){0.f, 0.f, 0.f, 0.f}; }
            }
        }
    }
};
struct EpiResS {
    bf16_t* XR; const float* gate; const float* gnext; const float* scnext; bf16_t* XG; float* ssq;
    __device__ __forceinline__ void operator()(const Ctx& c, const f32x4 (&acc)[4], int sb, int n0, LAS float* red) const {
        const int i15 = c.lane & 15, kq = c.lane >> 4, b = NBP + sb;
        const unsigned rowb = (unsigned)(MP + sb * DSEQ + i15), col = (unsigned)(n0 + 16 * c.wid + 4 * kq);
        u32x2 xv[4];
#pragma unroll
        for (int tb = 0; tb < 4; ++tb) xv[tb] = ldg2(XR, ((rowb + 16 * tb) * D + col) * 2);
        const f32x4 gt = ldg4(gate + (size_t)b * NMOD, col * 4);
        f32x4 gm = (f32x4){0.f, 0.f, 0.f, 0.f};
        if (gnext) gm = ldg4(gnext, col * 4) * (ldg4(scnext + (size_t)b * NMOD, col * 4) + 1.0f);
        float ss[4];
#pragma unroll
        for (int tb = 0; tb < 4; ++tb) {
            const unsigned eo = (rowb + 16 * tb) * D + col;
            const f32x4 x1 = unpack4(xv[tb]) + gt * acc[tb];
            stg2(XR, eo * 2, pack4(x1));
            ss[tb] = (x1[0] * x1[0] + x1[1] * x1[1]) + (x1[2] * x1[2] + x1[3] * x1[3]);
            if (gnext) stg2(XG, eo * 2, pack4(x1 * gm));
        }
#pragma unroll
        for (int tb = 0; tb < 4; ++tb) { const float a = quad_row_sum(ss[tb]); if (kq == 0) red[c.wid * 64 + 16 * tb + i15] = a; }
        __syncthreads();
        if (c.tid < 64) {
            float a = 0.f;
#pragma unroll
            for (int w = 0; w < 8; ++w) a += red[w * 64 + c.tid];
            float* dst = ssq + (size_t)(MP + sb * DSEQ + c.tid) * 16;
            dst[n0 >> 7] = a;
            if (n0 == 0) { *(f32x4*)(dst + 8) = (f32x4){0.f, 0.f, 0.f, 0.f}; *(f32x4*)(dst + 12) = (f32x4){0.f, 0.f, 0.f, 0.f}; }
        }
    }
};
struct EpiFf1S {
    const float* ssq2; const float* shw; bf16_t* F1;
    __device__ __forceinline__ void operator()(const Ctx& c, const f32x4 (&acc)[4], int sb, int n0, LAS float* red) const {
        const int i15 = c.lane & 15, kq = c.lane >> 4;
        const unsigned rowb = (unsigned)(MP + sb * DSEQ + i15), col = (unsigned)(n0 + 16 * c.wid + 4 * kq);
        f32x4 pp[4];
#pragma unroll
        for (int tb = 0; tb < 4; ++tb) pp[tb] = ldg4(ssq2, ((rowb + 16 * tb) * 16 + kq * 4) * 4);
        const f32x4 bv = ldg4(shw + (size_t)(NBP + sb) * DFF, col * 4);
#pragma unroll
        for (int tb = 0; tb < 4; ++tb) {
            const f32x4 p = pp[tb]; const float rstd = rsqrtf(quad_row_sum((p[0] + p[1]) + (p[2] + p[3])) * (1.0f / D) + EPS);
            f32x4 z = acc[tb] * rstd + bv;
            z = __builtin_elementwise_max(z, (f32x4){0.f, 0.f, 0.f, 0.f}); z = z * z;
            stg2(F1, ((rowb + 16 * tb) * DFF + col) * 2, pack4(z));
        }
    }
};
__device__ void phase_final(const Ctx& c) {
    const float* ssq1 = (const float*)(c.k->ws + WS_SSQ1); const float* gf = c.k->in[I_GFIN];
    const bf16_t* XR = (const bf16_t*)(c.k->ws + WS_XR);
    f32x4 g[4];
#pragma unroll
    for (int i = 0; i < 4; ++i) g[i] = *(const f32x4*)(gf + i * 256 + c.lane * 4);
    for (int rg = c.bx; rg < MT / 64; rg += c.G) {
        const int rowb = rg * 64 + c.wid * 8;
        const bf16_t* xr = XR + (size_t)rowb * D;
        float* yr = c.k->out + OUT_Y + (size_t)rowb * D;
        u32x2 x[8][4];
        float p0 = ssq1[(size_t)rowb * 16 + c.lane], p1 = ssq1[(size_t)rowb * 16 + 64 + c.lane];
#pragma unroll
        for (int r = 0; r < 8; ++r)
#pragma unroll
            for (int i = 0; i < 4; ++i) x[r][i] = *(const u32x2*)(xr + r * D + i * 256 + c.lane * 4);
        p0 += __shfl_xor(p0, 1); p0 += __shfl_xor(p0, 2); p0 += __shfl_xor(p0, 4); p0 += __shfl_xor(p0, 8);
        p1 += __shfl_xor(p1, 1); p1 += __shfl_xor(p1, 2); p1 += __shfl_xor(p1, 4); p1 += __shfl_xor(p1, 8);
#pragma unroll
        for (int r = 0; r < 8; ++r) {
            const float rstd = rsqrtf(__shfl(r < 4 ? p0 : p1, 16 * (r & 3)) * (1.0f / D) + EPS);
#pragma unroll
            for (int i = 0; i < 4; ++i) *(f32x4*)(yr + r * D + i * 256 + c.lane * 4) = unpack4(x[r][i]) * rstd * g[i];
        }
    }
}

#define XB_TMO      128
#define XB_XCNT(j)  (256  + 64 * (j))
#define XB_XSUB(j)  (1280 + 64 * (j))
#define XB_XGEN(j)  (2304 + 64 * (j))
#define XB_TOP      3328
#define XB_TOPGEN   3392
#define XCD_BAR_WORDS 3456
#define XB_SPIN_CAP (1u << 18)

__device__ __forceinline__ unsigned xb_ld(unsigned* p)              { return __hip_atomic_load(p, __ATOMIC_RELAXED, __HIP_MEMORY_SCOPE_AGENT); }
__device__ __forceinline__ unsigned xb_add(unsigned* p, unsigned v) { return __hip_atomic_fetch_add(p, v, __ATOMIC_RELAXED, __HIP_MEMORY_SCOPE_AGENT); }
__device__ __forceinline__ unsigned xb_xcc_id() { return (unsigned)__builtin_amdgcn_s_getreg((3 << 11) | 20) & 0xFu; }
#define XB_SPIN(cond, bar) do { unsigned _sp = 0; while (cond) { __builtin_amdgcn_s_sleep(1); \
    if ((++_sp & 255u) == 0u) { if (xb_ld(&(bar)[XB_TMO])) break; if (_sp > XB_SPIN_CAP) { atomicAdd(&(bar)[XB_TMO], 1u); break; } } } } while (0)

struct XcdBarrier {
    unsigned* bar; unsigned x;
    volatile LAS unsigned* st;
};

__device__ __forceinline__ XcdBarrier xcd_barrier_post(unsigned* bar, volatile LAS unsigned* st) {
    XcdBarrier b; b.bar = bar; b.x = xb_xcc_id(); b.st = st;
    if (threadIdx.x == 0) (void)xb_add(&bar[XB_XCNT(b.x)], 1u);
    return b;
}
__device__ __forceinline__ void xcd_barrier_complete(unsigned* bar, unsigned x, unsigned& nloc, unsigned& nx) {
    const unsigned G = gridDim.x * gridDim.y * gridDim.z;
    unsigned sum, cnt, mine, sp = 0u;
    for (;;) {
        sum = 0u; cnt = 0u; mine = 0u;
#pragma unroll
        for (unsigned j = 0; j < 16; ++j) { const unsigned c = xb_ld(&bar[XB_XCNT(j)]); sum += c; cnt += (c > 0u) ? 1u : 0u; mine = (j == x) ? c : mine; }
        if (sum == G) break;
        __builtin_amdgcn_s_sleep(1);
        if ((++sp & 255u) == 0u) { if (xb_ld(&bar[XB_TMO])) break; if (sp > XB_SPIN_CAP) { atomicAdd(&bar[XB_TMO], 1u); break; } }
    }
    nloc = mine > 0u ? mine : 1u; nx = cnt > 0u ? cnt : 1u;
}

__device__ __forceinline__ void xcd_barrier(const XcdBarrier& b) {
    asm volatile("s_waitcnt vmcnt(0)" ::: "memory");
    __syncthreads();
    if (threadIdx.x == 0) {
        unsigned* bar = b.bar;
        __builtin_amdgcn_s_waitcnt(0);
        unsigned nloc = b.st[0], nx = b.st[1];
        if (nloc == 0u) { xcd_barrier_complete(bar, b.x, nloc, nx); b.st[0] = nloc; b.st[1] = nx; }
        const unsigned old = xb_add(&bar[XB_XSUB(b.x)], 1u);
        const unsigned gen = old / nloc;
        if (old + 1u == (gen + 1u) * nloc) {
            __builtin_amdgcn_fence(__ATOMIC_RELEASE, "agent");
            asm volatile("s_waitcnt vmcnt(0)" ::: "memory");
            const unsigned og = xb_add(&bar[XB_TOP], 1u);
            const unsigned tg = og / nx;
            if (og + 1u == (tg + 1u) * nx) xb_add(&bar[XB_TOPGEN], 1u);
            else XB_SPIN(xb_ld(&bar[XB_TOPGEN]) == tg, bar);
            __builtin_amdgcn_fence(__ATOMIC_ACQUIRE, "agent");
            xb_add(&bar[XB_XGEN(b.x)], 1u);
            asm volatile("s_waitcnt vmcnt(0)" ::: "memory");
        } else {
            XB_SPIN(xb_ld(&bar[XB_XGEN(b.x)]) == gen, bar);
            __builtin_amdgcn_fence(__ATOMIC_ACQUIRE, "agent");
            asm volatile("s_waitcnt vmcnt(0)" ::: "memory");
        }
    }
    __syncthreads();
}


constexpr int NPHASE = 2 + 5 * DEPTH + 1;
__global__ void __launch_bounds__(NTHREADS, 2) mk_fwd(Params p) {
    __shared__ __attribute__((aligned(16))) unsigned char shm[pg8::STAGE_BYTES + 16];
    cg::grid_group grid = cg::this_grid();
    if (threadIdx.x < 4) ((LAS unsigned*)((LAS unsigned char*)shm + pg8::STAGE_BYTES))[threadIdx.x] = 0u;
    __syncthreads();
    (void)xcd_barrier_post((unsigned*)(p.ws + WS_BAR), (volatile LAS unsigned*)((LAS unsigned char*)shm + pg8::STAGE_BYTES));
    Ctx c;
    c.k = kargs(); c.lds = (LAS unsigned char*)shm;
    c.tid = threadIdx.x; c.lane = c.tid & 63; c.wid = __builtin_amdgcn_readfirstlane(c.tid >> 6); c.G = gridDim.x; c.bx = blockIdx.x;
#ifndef PHMASK
#define PHMASK 0xffff
#endif
#define PHON(k) ((PHMASK >> (k)) & 1)
#ifndef DUPMASK
#define DUPMASK 0
#endif
#define DUPN(k) (((DUPMASK >> (k)) & 1) ? 2 : 1)
    for (int ph = p.ph_lo; ph < p.ph_hi; ++ph) {
        { int t_ = threadIdx.x; asm volatile("" : "+v"(t_)); c.tid = t_; c.lane = t_ & 63; c.wid = __builtin_amdgcn_readfirstlane(t_ >> 6); c.k = kargs(); }
        unsigned char* ws = c.k->ws;
        const float* mod = (const float*)(ws + WS_MOD);
        if (ph == 0) { for (int r_ = 0; r_ < DUPN(0); ++r_) phase_init0(c); }
        else if (ph == 1) { for (int r_ = 0; r_ < DUPN(1); ++r_) phase_init1(c); }
        else if (ph == NPHASE - 1) { if (PHON(7)) phase_final(c); }
        else {
            const int l = (ph - 2) / 5, s = (ph - 2) % 5;
            const float* modl = mod + (size_t)l * NBT * NMOD;
            pg8::StaticOrder S;
            if (s == 0 && PHON(2)) {
                pg8::Gemm g{(const bf16_t*)(ws + WS_XG), (const bf16_t*)(ws + WS_WIN_T) + (size_t)l * DIN * D, MP, DIN, D}; S.init(MP, DIN, c.G, c.bx);
                { EpiInS Es{(const float*)(ws + WS_SSQ1), (const float*)(ws + WS_SHWIN) + (size_t)l * NBT * DIN, (bf16_t*)(ws + WS_A), (bf16_t*)(ws + WS_U), (bf16_t*)(ws + WS_GV), (float*)(ws + WS_STV)};
                  sample_gemm<EpiInS>(c, g.A, D, g.Bt, D, DIN, D, Es); }
                EpiIn E{(const float*)(ws + WS_SSQ1), (const float*)(ws + WS_SHWIN) + (size_t)l * NBT * DIN, (bf16_t*)(ws + WS_A), (bf16_t*)(ws + WS_U), (bf16_t*)(ws + WS_GV), (float*)(ws + WS_STV)};
                for (int r_ = 0; r_ < DUPN(2); ++r_) pg8::gemm_phase<EpiIn>(c.lds, g, S, E);
            } else if (s == 1 && PHON(3)) {
                for (int r_ = 0; r_ < DUPN(3); ++r_) phase_mixer(c, l);
            } else if (s == 2 && PHON(4)) {
                pg8::Gemm g{(const bf16_t*)(ws + WS_CAT), (const bf16_t*)(ws + WS_WOUT_T) + (size_t)l * D * D, MP, D, D}; S.init(MP, D, c.G, c.bx);
                { EpiResS Es{(bf16_t*)(ws + WS_XR), modl + 2 * D, c.k->in[I_GFFN] + l * D, modl + 4 * D, (bf16_t*)(ws + WS_XG), (float*)(ws + WS_SSQ2)};
                  sample_gemm<EpiResS>(c, g.A, D, g.Bt, D, D, D, Es); }
                EpiRes E{(bf16_t*)(ws + WS_XR), modl + 2 * D, c.k->in[I_GFFN] + l * D, modl + 4 * D, (bf16_t*)(ws + WS_XG), (float*)(ws + WS_SSQ2)};
                pg8::gemm_phase<EpiRes>(c.lds, g, S, E);
            } else if (s == 3 && PHON(5)) {
                pg8::Gemm g{(const bf16_t*)(ws + WS_XG), (const bf16_t*)(ws + WS_W1_T) + (size_t)l * DFF * D, MP, DFF, D}; S.init(MP, DFF, c.G, c.bx);
                { EpiFf1S Es{(const float*)(ws + WS_SSQ2), (const float*)(ws + WS_SHW1) + (size_t)l * NBT * DFF, (bf16_t*)(ws + WS_F1)};
                  sample_gemm<EpiFf1S>(c, g.A, D, g.Bt, D, DFF, D, Es); }
                EpiFf1 E{(const float*)(ws + WS_SSQ2), (const float*)(ws + WS_SHW1) + (size_t)l * NBT * DFF, (bf16_t*)(ws + WS_F1)};
                for (int r_ = 0; r_ < DUPN(5); ++r_) pg8::gemm_phase<EpiFf1>(c.lds, g, S, E);
            } else if (s == 4 && PHON(6)) {
                pg8::Gemm g{(const bf16_t*)(ws + WS_F1), (const bf16_t*)(ws + WS_W2_T) + (size_t)l * D * DFF, MP, D, DFF}; S.init(MP, D, c.G, c.bx);
                const bool more = (l + 1 < DEPTH);
                { EpiResS Es{(bf16_t*)(ws + WS_XR), modl + 5 * D, more ? c.k->in[I_GMIX] + (l + 1) * D : nullptr, mod + (size_t)(more ? l + 1 : l) * NBT * NMOD + 1 * D,
                             (bf16_t*)(ws + WS_XG), (float*)(ws + WS_SSQ1)};
                  sample_gemm<EpiResS>(c, g.A, DFF, g.Bt, DFF, D, DFF, Es); }
                EpiRes E{(bf16_t*)(ws + WS_XR), modl + 5 * D, more ? c.k->in[I_GMIX] + (l + 1) * D : nullptr, mod + (size_t)(more ? l + 1 : l) * NBT * NMOD + 1 * D,
                         (bf16_t*)(ws + WS_XG), (float*)(ws + WS_SSQ1)};
                pg8::gemm_phase<EpiRes>(c.lds, g, S, E);
            }
        }
        if (ph + 1 < p.ph_hi) { if (p.ph_hi > NPHASE) grid.sync(); else { XcdBarrier xb; xb.bar = (unsigned*)(c.k->ws + WS_BAR); xb.x = xb_xcc_id(); xb.st = (volatile LAS unsigned*)(c.lds + pg8::STAGE_BYTES); xcd_barrier(xb); } }
    }
}

extern "C" void kernel_launch(void* const* d_in, const int* in_sizes, int n_in, void* d_out, int out_size, void* d_ws, size_t ws_size, hipStream_t stream) {
    static int grid_blocks = 0;
    if (!grid_blocks) {
        int dev = 0, cus = 0, per_cu = 0;
        hipGetDevice(&dev);
        hipDeviceGetAttribute(&cus, hipDeviceAttributeMultiprocessorCount, dev);
        hipOccupancyMaxActiveBlocksPerMultiprocessor(&per_cu, mk_fwd, NTHREADS, 0);
        if (per_cu < 1) per_cu = 1;
        if (per_cu > 1) per_cu = 1;
        grid_blocks = cus * per_cu;
        if (n_in != 20 || ws_size < WS_END) fprintf(stderr, "kernel_launch: unexpected n_in %d / ws_size %zu (need %zu)\n", n_in, ws_size, (size_t)WS_END);
    }
    Params p{};
    for (int i = 0; i < 20; ++i) p.in[i] = (const float*)d_in[i];
    p.out = (float*)d_out; p.ws = (unsigned char*)d_ws;
#if MK_SINGLE
    (void)hipMemsetAsync((unsigned char*)d_ws + WS_BAR, 0, WS_BAR_BYTES, stream);
    p.ph_lo = 0; p.ph_hi = NPHASE;
    { void* args[] = {&p};
      hipError_t e = hipLaunchCooperativeKernel((void*)mk_fwd, dim3(grid_blocks), dim3(NTHREADS), args, 0, stream);
      if (e != hipSuccess) fprintf(stderr, "cooperative launch failed: %s (grid %d)\n", hipGetErrorString(e), grid_blocks); }
#else
    for (int ph = 0; ph < NPHASE; ++ph) {
        p.ph_lo = ph; p.ph_hi = ph + 1;
        void* args[] = {&p};
        hipError_t e = hipLaunchCooperativeKernel((void*)mk_fwd, dim3(grid_blocks), dim3(NTHREADS), args, 0, stream);
        if (e != hipSuccess) { fprintf(stderr, "cooperative launch failed: %s (grid %d, phase %d)\n", hipGetErrorString(e), grid_blocks, ph); break; }
    }
#endif
}
```

```cpp
#include <hip/hip_runtime.h>
#include <hip/hip_cooperative_groups.h>
#include <cstdio>
namespace cg = cooperative_groups;

#ifndef MK_SINGLE
#define MK_SINGLE 1
#endif

#define LAS __attribute__((address_space(3)))
typedef unsigned short bf16_t;
typedef short bf16x8 __attribute__((ext_vector_type(8)));
typedef short s16x4 __attribute__((ext_vector_type(4)));
typedef float f32x4 __attribute__((ext_vector_type(4)));
typedef float f32x2 __attribute__((ext_vector_type(2)));
typedef unsigned u32x4 __attribute__((ext_vector_type(4)));
typedef unsigned u32x2 __attribute__((ext_vector_type(2)));

constexpr int D = 1024, NBP = 16, SEQ = 4096, MP = NBP * SEQ, NBS = 8, DSEQ = 64, MS = NBS * DSEQ, MT = MP + MS;
constexpr int DIN = 1536, DFF = 4096, DEPTH = 2, NBT = NBP + NBS, PW = 512, SW = 512, NMOD = 6 * D;
constexpr float EPS = 1e-6f;
constexpr int NTHREADS = 512;

constexpr size_t WS_WIN_T = 0;
constexpr size_t WS_WOUT_T = WS_WIN_T + (size_t)DEPTH * DIN * D * 2;
constexpr size_t WS_W1_T = WS_WOUT_T + (size_t)DEPTH * D * D * 2;
constexpr size_t WS_W2_T = WS_W1_T + (size_t)DEPTH * DFF * D * 2;
constexpr size_t WS_WP_T = WS_W2_T + (size_t)DEPTH * DFF * D * 2;
constexpr size_t WS_WSP = WS_WP_T + (size_t)DEPTH * 4 * 128 * 128 * 2;
constexpr size_t WS_MOD = WS_WSP + (size_t)DEPTH * 4 * 128 * 128 * 2;
constexpr size_t WS_SHWIN = WS_MOD + (size_t)DEPTH * NBT * NMOD * 4;
constexpr size_t WS_SHW1 = WS_SHWIN + (size_t)DEPTH * NBT * DIN * 4;
constexpr size_t WS_SSQ1 = WS_SHW1 + (size_t)DEPTH * NBT * DFF * 4;
constexpr size_t WS_SSQ2 = WS_SSQ1 + (size_t)MT * 16 * 4;
constexpr size_t WS_STV = WS_SSQ2 + (size_t)MT * 16 * 4;
constexpr size_t WS_XG = WS_STV + (size_t)MT * 16 * 4;
constexpr size_t WS_F1 = WS_XG + (size_t)MT * D * 2;
constexpr size_t WS_A = WS_F1;
constexpr size_t WS_U = WS_A + (size_t)MT * PW * 2;
constexpr size_t WS_GV = WS_U + (size_t)MT * SW * 2;
constexpr size_t WS_CAT = WS_GV + (size_t)MT * SW * 2;
constexpr size_t WS_XR = WS_F1 + (size_t)MT * DFF * 2;
constexpr size_t WS_BAR = WS_XR + (size_t)MT * D * 2;
constexpr size_t WS_BAR_BYTES = 16384;
constexpr size_t WS_END = WS_BAR + WS_BAR_BYTES;

constexpr size_t OUT_Y = 0;
constexpr size_t OUT_SPP = (size_t)MT * D;
constexpr size_t OUT_SPS = OUT_SPP + (size_t)DEPTH * NBP * 15 * PW;
constexpr size_t OUT_SV = OUT_SPS + (size_t)DEPTH * NBS * 15 * PW;

struct Params {
    const float* in[20];
    float* out;
    unsigned char* ws;
    int ph_lo, ph_hi;
};
enum { I_XP = 0, I_XS, I_SPOOL, I_CP, I_CS, I_WADA, I_BADA, I_GMIX, I_WIN, I_WPOOL, I_PSCALE, I_VG, I_VB, I_WSP, I_BSP, I_WOUT, I_GFFN, I_W1, I_W2, I_GFIN };

__device__ __forceinline__ unsigned cvt_pk_bf16(float lo, float hi) { unsigned r; asm volatile("v_cvt_pk_bf16_f32 %0, %1, %2" : "=v"(r) : "v"(lo), "v"(hi)); return r; }
__device__ __forceinline__ float bflo(unsigned w) { return __uint_as_float(w << 16); }
__device__ __forceinline__ float bfhi(unsigned w) { return __uint_as_float(w & 0xffff0000u); }
__device__ __forceinline__ int batch_of(int row) { return row < MP ? (row >> 12) : NBP + ((row - MP) >> 6); }
__device__ __forceinline__ f32x2 gelu_pk(f32x2 v) {
    const f32x2 av = __builtin_elementwise_abs(v), d = av * 0.2316418882f + 1.0f;
    f32x2 t; t.x = __builtin_amdgcn_rcpf(d.x); t.y = __builtin_amdgcn_rcpf(d.y);
    f32x2 q = t * 0.5307027145f + (-0.7265760135f); q = q * t + 0.7107068705f; q = q * t + (-0.142248368f); q = q * t + 0.127414796f; q = q * t;
    const f32x2 s = (v * v) * (-0.72134752044f);
    f32x2 e; e.x = __builtin_amdgcn_exp2f(s.x); e.y = __builtin_amdgcn_exp2f(s.y);
    const f32x2 m = v * (q * e), r = v - m;
    f32x2 o; o.x = v.x < 0.f ? m.x : r.x; o.y = v.y < 0.f ? m.y : r.y; return o;
}
__device__ __forceinline__ f32x4 gelu4(f32x4 v) { f32x2 a = gelu_pk((f32x2){v[0], v[1]}), b = gelu_pk((f32x2){v[2], v[3]}); return (f32x4){a.x, a.y, b.x, b.y}; }
__device__ __forceinline__ float wave_sum(float v) {
#pragma unroll
    for (int o = 32; o >= 1; o >>= 1) v += __shfl_xor(v, o);
    return v;
}
__device__ __forceinline__ float quad_row_sum(float v) { v += __shfl_xor(v, 16); v += __shfl_xor(v, 32); return v; }

namespace pg8 {
constexpr int BM = 256, BK = 64, HALF = 128, HTB = HALF * BK * 2, STAGE_BYTES = 8 * HTB, NXCD = 8, WGM = 8;
__device__ __forceinline__ int lds_byte(int r, int c) { const int st = (r >> 4) * 2 + (c >> 5), rr = r & 15, cc = c & 31, ob = rr * 64 + cc * 2; return st * 1024 + (ob ^ (((ob >> 9) & 1) << 5)); }
__device__ __forceinline__ void stage_rc(int b, int& R, int& C) { const int st = b / 1024, sb = b % 1024, swz = sb ^ (((sb >> 9) & 1) << 5); R = (st >> 1) * 16 + swz / 64; C = (st & 1) * 32 + (swz % 64) / 2; }
struct Unit { int pm, pn; };
struct Gemm { const bf16_t* A; const bf16_t* Bt; int M, N, K; };
struct StaticOrder {
    int nM, nN, nwg, G, c;
    __device__ void init(int M, int N, int G_, int c_) { nM = M / BM; nN = N / BM; nwg = nM * nN; G = G_; c = c_; }
    __device__ bool next(int i, Unit& u) const {
        const long L = (long)i * G + c; if (L >= nwg) return false;
        int wgid = (int)L; { const int q = nwg / NXCD, r = nwg % NXCD, xcd = wgid % NXCD, off = wgid / NXCD; wgid = (xcd < r ? xcd * (q + 1) : r * (q + 1) + (xcd - r) * q) + off; }
        const int nig = WGM * nN, gid = wgid / nig, fm = gid * WGM, gsz = (nM - fm) < WGM ? (nM - fm) : WGM;
        u.pm = fm + ((wgid % nig) % gsz); u.pn = (wgid % nig) / gsz; return true;
    }
};

template <class Epi>
__device__ __forceinline__ void gemm_phase(LAS unsigned char* lds, const Gemm g, const StaticOrder& S, const Epi& E) {
    int tid_ = threadIdx.x; asm volatile("" : "+v"(tid_));
    const int tid = tid_, wid = __builtin_amdgcn_readfirstlane(tid >> 6), lane = tid & 63, wr = wid >> 2, wc = wid & 3, fr = lane & 15, fq = lane >> 4;
    const int K = g.K, nt = K / BK;
    unsigned voffA[2], voffB[2];
#pragma unroll
    for (int i = 0; i < 2; ++i) { int R, C; stage_rc(tid * 16 + i * 8192, R, C); voffA[i] = (unsigned)(R * K + C) * 2u; voffB[i] = (unsigned)(R * K + C) * 2u; }
    const size_t kstep = (size_t)(BK * 2);
    const size_t hstep = (size_t)HALF * K * 2;
    const size_t tstep = 2 * hstep;
    const unsigned ldsw = (unsigned)wid * 1024u;
    const int aoff = lds_byte(wr * 64 + fr, fq * 8), boff = lds_byte(wc * 32 + fr, fq * 8);
#define PG8_SA(b, h) (((b) * 2 + (h)) * HTB)
#define PG8_SB(b, h) ((4 + (b) * 2 + (h)) * HTB)
#define PG8_STAGE(bufoff, gbase, voff) do { _Pragma("unroll") for (int _i = 0; _i < 2; ++_i) \
        __builtin_amdgcn_global_load_lds((const unsigned*)((const char*)(gbase) + (voff)[_i]), (LAS unsigned*)(lds + (bufoff) + ldsw + _i * 8192), 16, 0, 0); } while (0)
#define PG8_LDA(dst, b, h) do { _Pragma("unroll") for (int m = 0; m < 4; ++m) _Pragma("unroll") for (int k = 0; k < 2; ++k) dst[m][k] = *(const LAS bf16x8*)(lds + PG8_SA(b, h) + aoff + m * 2048 + k * 1024); } while (0)
#define PG8_LDB(dst, b, h) do { _Pragma("unroll") for (int n = 0; n < 2; ++n) _Pragma("unroll") for (int k = 0; k < 2; ++k) dst[n][k] = *(const LAS bf16x8*)(lds + PG8_SB(b, h) + boff + n * 2048 + k * 1024); } while (0)
#define PG8_MMA(ai, bj, At, Bt) do { __builtin_amdgcn_s_setprio(1); _Pragma("unroll") for (int m = 0; m < 4; ++m) _Pragma("unroll") for (int n = 0; n < 2; ++n) _Pragma("unroll") for (int k = 0; k < 2; ++k) \
        acc[ai][bj][m][n] = __builtin_amdgcn_mfma_f32_16x16x32_bf16(Bt[n][k], At[m][k], acc[ai][bj][m][n], 0, 0, 0); __builtin_amdgcn_s_setprio(0); } while (0)
#define PG8_WAIT_V(n) asm volatile("s_waitcnt vmcnt(" #n ")" ::: "memory")
#define PG8_WAIT_L(n) asm volatile("s_waitcnt lgkmcnt(" #n ")" ::: "memory")
#define PG8_BAR __builtin_amdgcn_s_barrier()
#define PG8_SCHED __builtin_amdgcn_sched_barrier(0)
    Unit cur, nxt; int ui = 0;
    if (!S.next(0, cur)) return;
    f32x4 acc[2][2][4][2];
#pragma unroll
    for (int a = 0; a < 2; ++a)
#pragma unroll
        for (int b = 0; b < 2; ++b)
#pragma unroll
            for (int m = 0; m < 4; ++m)
#pragma unroll
                for (int n = 0; n < 2; ++n) acc[a][b][m][n] = (f32x4){0.f, 0.f, 0.f, 0.f};
    bf16x8 At[4][2], B0[2][2], B1[2][2];
    const char* cA = (const char*)g.A + (size_t)cur.pm * tstep; const char* cB = (const char*)g.Bt + (size_t)cur.pn * tstep;
    PG8_STAGE(PG8_SB(0, 0), cB, voffB); PG8_STAGE(PG8_SA(0, 0), cA, voffA); PG8_STAGE(PG8_SB(0, 1), cB + hstep, voffB); PG8_STAGE(PG8_SA(0, 1), cA + hstep, voffA);
    if (wr == 1) PG8_BAR;
    PG8_WAIT_V(4); PG8_BAR;
    PG8_STAGE(PG8_SB(1, 0), cB + kstep, voffB); PG8_STAGE(PG8_SA(1, 0), cA + kstep, voffA); PG8_STAGE(PG8_SB(1, 1), cB + hstep + kstep, voffB);
    PG8_WAIT_V(6); PG8_BAR;
    for (;;) {
        const bool has_next = S.next(ui + 1, nxt);
        const char* nA = has_next ? (const char*)g.A + (size_t)nxt.pm * tstep : cA; const char* nB = has_next ? (const char*)g.Bt + (size_t)nxt.pn * tstep : cB;
        for (int t = 0; t < nt; t += 2) {
            const bool last = (t == nt - 2);
            const char* a1 = cA + (size_t)(t + 1) * kstep;
            const char* a2 = last ? nA : cA + (size_t)(t + 2) * kstep; const char* b2 = last ? nB : cB + (size_t)(t + 2) * kstep;
            const char* a3 = a2 + kstep; const char* b3 = b2 + kstep;
            PG8_LDB(B0, 0, 0); PG8_SCHED; PG8_LDA(At, 0, 0); PG8_STAGE(PG8_SA(1, 1), a1 + hstep, voffA);
            PG8_WAIT_L(8); PG8_BAR; PG8_WAIT_L(0); PG8_MMA(0, 0, At, B0); PG8_BAR; PG8_SCHED;
            PG8_LDB(B1, 0, 1); PG8_STAGE(PG8_SB(0, 0), b2, voffB);
            PG8_BAR; PG8_WAIT_L(0); PG8_MMA(0, 1, At, B1); PG8_BAR;
            PG8_LDA(At, 0, 1); PG8_STAGE(PG8_SA(0, 0), a2, voffA);
            PG8_BAR; PG8_WAIT_L(0); PG8_MMA(1, 0, At, B0); PG8_BAR; PG8_SCHED;
            PG8_STAGE(PG8_SB(0, 1), b2 + hstep, voffB);
            PG8_WAIT_V(6); PG8_BAR; PG8_MMA(1, 1, At, B1); PG8_BAR;
            PG8_LDB(B0, 1, 0); PG8_SCHED; PG8_LDA(At, 1, 0); PG8_STAGE(PG8_SA(0, 1), a2 + hstep, voffA);
            PG8_WAIT_L(8); PG8_BAR; PG8_WAIT_L(0); PG8_MMA(0, 0, At, B0); PG8_BAR; PG8_SCHED;
            PG8_LDB(B1, 1, 1); PG8_STAGE(PG8_SB(1, 0), b3, voffB);
            PG8_BAR; PG8_WAIT_L(0); PG8_MMA(0, 1, At, B1); PG8_BAR;
            PG8_LDA(At, 1, 1); PG8_STAGE(PG8_SA(1, 0), a3, voffA);
            PG8_BAR; PG8_WAIT_L(0); PG8_MMA(1, 0, At, B0); PG8_BAR; PG8_SCHED;
            PG8_STAGE(PG8_SB(1, 1), b3 + hstep, voffB);
            PG8_WAIT_V(6); PG8_BAR; PG8_MMA(1, 1, At, B1); PG8_BAR;
        }
        E(acc, cur, wr, wc, fr, fq);
        if (!has_next) break;
#pragma unroll
        for (int a = 0; a < 2; ++a)
#pragma unroll
            for (int b = 0; b < 2; ++b)
#pragma unroll
                for (int m = 0; m < 4; ++m)
#pragma unroll
                    for (int n = 0; n < 2; ++n) acc[a][b][m][n] = (f32x4){0.f, 0.f, 0.f, 0.f};
        cur = nxt; cA = nA; cB = nB; ++ui;
    }
    PG8_WAIT_V(0);
    if (wr == 0) PG8_BAR;
    PG8_BAR;
#undef PG8_SA
#undef PG8_SB
#undef PG8_STAGE
#undef PG8_LDA
#undef PG8_LDB
#undef PG8_MMA
#undef PG8_WAIT_V
#undef PG8_WAIT_L
#undef PG8_BAR
#undef PG8_SCHED
}
}

typedef f32x4 AccT[2][2][4][2];

__device__ __forceinline__ f32x4 ldg4(const void* base, unsigned off) { return *(const f32x4*)((const char*)base + off); }
__device__ __forceinline__ u32x2 ldg2(const void* base, unsigned off) { return *(const u32x2*)((const char*)base + off); }
__device__ __forceinline__ f32x4 unpack4(u32x2 w) { return (f32x4){bflo(w.x), bfhi(w.x), bflo(w.y), bfhi(w.y)}; }
__device__ __forceinline__ void stg4(void* base, unsigned off, f32x4 v) { *(f32x4*)((char*)base + off) = v; }
__device__ __forceinline__ void stg2(void* base, unsigned off, u32x2 v) { *(u32x2*)((char*)base + off) = v; }
__device__ __forceinline__ void stf2(void* base, unsigned off, f32x2 v) { *(f32x2*)((char*)base + off) = v; }
__device__ __forceinline__ void stf1(void* base, unsigned off, float v) { *(float*)((char*)base + off) = v; }
__device__ __forceinline__ u32x2 pack4(f32x4 z) { u32x2 w; w.x = cvt_pk_bf16(z[0], z[1]); w.y = cvt_pk_bf16(z[2], z[3]); return w; }
constexpr unsigned CO[2][2] = {{0u, 16u}, {128u, 144u}};

struct EpiIn {
    const float* ssq1; const float* shw; bf16_t* A; bf16_t* U; bf16_t* GV; float* stv;
    __device__ __forceinline__ void operator()(const AccT& acc, const pg8::Unit& u, int wr, int wc, int fr, int fq) const {
        const int rowu = u.pm * 256 + wr * 64;
        const unsigned colb = (unsigned)(u.pn * 256 + wc * 32 + 4 * fq), rowb = (unsigned)(rowu + fr);
        bf16_t* const dbase = u.pn < 2 ? A : (u.pn < 4 ? U - 512 : GV - 1024);
        const float* bias = shw + (size_t)batch_of(rowu) * DIN;
        f32x4 pp[2][4], bv[2][2];
#pragma unroll
        for (int ai = 0; ai < 2; ++ai)
#pragma unroll
            for (int m = 0; m < 4; ++m) pp[ai][m] = ldg4(ssq1, ((rowb + ai * 128 + m * 16) * 16 + fq * 4) * 4);
#pragma unroll
        for (int bj = 0; bj < 2; ++bj)
#pragma unroll
            for (int n = 0; n < 2; ++n) bv[bj][n] = ldg4(bias, (colb + CO[bj][n]) * 4);
        float rstd[2][4];
#pragma unroll
        for (int ai = 0; ai < 2; ++ai)
#pragma unroll
            for (int m = 0; m < 4; ++m) { const f32x4 p = pp[ai][m]; rstd[ai][m] = rsqrtf(quad_row_sum((p[0] + p[1]) + (p[2] + p[3])) * (1.0f / D) + EPS); }
#pragma unroll
        for (int ai = 0; ai < 2; ++ai) {
            float s1[4], s2[4];
#pragma unroll
            for (int m = 0; m < 4; ++m) {
                const unsigned row = rowb + ai * 128 + m * 16;
                float t1 = 0.f, t2 = 0.f;
#pragma unroll
                for (int bj = 0; bj < 2; ++bj)
#pragma unroll
                    for (int n = 0; n < 2; ++n) {
                        f32x4 z = acc[ai][bj][m][n] * rstd[ai][m] + bv[bj][n];
                        if (u.pn >= 2) z = gelu4(z);
                        if (u.pn >= 4) { t1 += (z[0] + z[1]) + (z[2] + z[3]); t2 += (z[0] * z[0] + z[1] * z[1]) + (z[2] * z[2] + z[3] * z[3]); }
                        stg2(dbase, (row * 512 + colb + CO[bj][n]) * 2, pack4(z));
                    }
                s1[m] = t1; s2[m] = t2;
            }
            if (u.pn >= 4) {
#pragma unroll
                for (int m = 0; m < 4; ++m) {
                    const float a = quad_row_sum(s1[m]), b = quad_row_sum(s2[m]);
                    if (fq == 0) stf2(stv, ((rowb + ai * 128 + m * 16) * 16 + ((u.pn - 4) * 4 + wc) * 2) * 4, (f32x2){a, b});
                }
            }
        }
    }
};
struct EpiRes {
    bf16_t* XR; const float* gate;
    const float* gnext; const float* scnext;
    bf16_t* XG; float* ssq;
    __device__ __forceinline__ void operator()(const AccT& acc, const pg8::Unit& u, int wr, int wc, int fr, int fq) const {
        const int rowu = u.pm * 256 + wr * 64;
        const unsigned colb = (unsigned)(u.pn * 256 + wc * 32 + 4 * fq), rowb = (unsigned)(rowu + fr);
        const int b = batch_of(rowu);
        f32x4 gt[2][2], gm[2][2];
        u32x2 ring[3][2][2];
#define ER_LOADROW(r_, slot_) do { const unsigned ro_ = (rowb + ((r_) >> 2) * 128 + ((r_) & 3) * 16) * D + colb; \
            _Pragma("unroll") for (int bj = 0; bj < 2; ++bj) _Pragma("unroll") for (int n = 0; n < 2; ++n) ring[slot_][bj][n] = ldg2(XR, (ro_ + CO[bj][n]) * 2); } while (0)
        ER_LOADROW(0, 0); ER_LOADROW(1, 1);
#pragma unroll
        for (int bj = 0; bj < 2; ++bj)
#pragma unroll
            for (int n = 0; n < 2; ++n) {
                const unsigned co = (colb + CO[bj][n]) * 4;
                gt[bj][n] = ldg4(gate + (size_t)b * NMOD, co);
                if (gnext) gm[bj][n] = ldg4(gnext, co) * (ldg4(scnext + (size_t)b * NMOD, co) + 1.0f);
                else gm[bj][n] = (f32x4){0.f, 0.f, 0.f, 0.f};
            }
#pragma unroll
        for (int r = 0; r < 8; ++r) {
            const int ai = r >> 2, m = r & 3; const unsigned row = rowb + ai * 128 + m * 16;
            if (r + 2 < 8) ER_LOADROW(r + 2, (r + 2) % 3);
            float ss = 0.f;
#pragma unroll
            for (int bj = 0; bj < 2; ++bj)
#pragma unroll
                for (int n = 0; n < 2; ++n) {
                    const unsigned eo = row * D + colb + CO[bj][n];
                    const f32x4 x1 = unpack4(ring[r % 3][bj][n]) + gt[bj][n] * acc[ai][bj][m][n];
                    stg2(XR, eo * 2, pack4(x1));
                    ss += (x1[0] * x1[0] + x1[1] * x1[1]) + (x1[2] * x1[2] + x1[3] * x1[3]);
                    if (gnext) stg2(XG, eo * 2, pack4(x1 * gm[bj][n]));
                }
            ss = quad_row_sum(ss);
            if (fq == 0) stf1(ssq, (row * 16 + u.pn * 4 + wc) * 4, ss);
        }
#undef ER_LOADROW
    }
};
struct EpiFf1 {
    const float* ssq2; const float* shw; bf16_t* F1;
    __device__ __forceinline__ void operator()(const AccT& acc, const pg8::Unit& u, int wr, int wc, int fr, int fq) const {
        const int rowu = u.pm * 256 + wr * 64;
        const unsigned colb = (unsigned)(u.pn * 256 + wc * 32 + 4 * fq), rowb = (unsigned)(rowu + fr);
        const float* bias = shw + (size_t)batch_of(rowu) * DFF;
        f32x4 pp[2][4], bv[2][2];
#pragma unroll
        for (int ai = 0; ai < 2; ++ai)
#pragma unroll
            for (int m = 0; m < 4; ++m) pp[ai][m] = ldg4(ssq2, ((rowb + ai * 128 + m * 16) * 16 + fq * 4) * 4);
#pragma unroll
        for (int bj = 0; bj < 2; ++bj)
#pragma unroll
            for (int n = 0; n < 2; ++n) bv[bj][n] = ldg4(bias, (colb + CO[bj][n]) * 4);
        float rstd[2][4];
#pragma unroll
        for (int ai = 0; ai < 2; ++ai)
#pragma unroll
            for (int m = 0; m < 4; ++m) { const f32x4 p = pp[ai][m]; rstd[ai][m] = rsqrtf(quad_row_sum((p[0] + p[1]) + (p[2] + p[3])) * (1.0f / D) + EPS); }
#pragma unroll
        for (int ai = 0; ai < 2; ++ai)
#pragma unroll
            for (int m = 0; m < 4; ++m) {
                const unsigned row = rowb + ai * 128 + m * 16;
#pragma unroll
                for (int bj = 0; bj < 2; ++bj)
#pragma unroll
                    for (int n = 0; n < 2; ++n) {
                        f32x4 z = acc[ai][bj][m][n] * rstd[ai][m] + bv[bj][n];
                        z = __builtin_elementwise_max(z, (f32x4){0.f, 0.f, 0.f, 0.f}); z = z * z;
                        stg2(F1, (row * DFF + colb + CO[bj][n]) * 2, pack4(z));
                    }
            }
    }
};

typedef const __attribute__((address_space(4))) Params* KArgs;
__device__ __forceinline__ KArgs kargs() { KArgs k = (KArgs)__builtin_amdgcn_kernarg_segment_ptr(); asm volatile("" : "+s"(k)); return k; }
struct Ctx {
    KArgs k;
    LAS unsigned char* lds; int tid, lane, wid, G, bx;
};

__device__ __forceinline__ void gemv24_unit(const Ctx& c, int mode, const float* vsrc, int vstride, const float* W, int ldw, int n0, const float* bias, float* out, int ldo) {
    LAS float* tbl = (LAS float*)c.lds;
    __syncthreads();
    for (int i = c.tid; i < NBT * D; i += NTHREADS) {
        const int b = i >> 10, k = i & 1023; float v;
        if (mode == 0) { const float x = b < NBP ? c.k->in[I_CP][b * D + k] : c.k->in[I_CS][(b - NBP) * D + k]; v = x / (1.0f + __expf(-x)); }
        else v = vsrc[(size_t)b * vstride + k];
        tbl[k * NBT + b] = v;
    }
    __syncthreads();
    const int ks = c.tid >> 6, j = c.tid & 63;
    float acc[NBT];
#pragma unroll
    for (int b = 0; b < NBT; ++b) acc[b] = 0.f;
    const float* wp = W + (size_t)(ks * 128) * ldw + n0 + j;
#pragma unroll 8
    for (int kk = 0; kk < 128; ++kk) {
        const float w = wp[(size_t)kk * ldw];
        const LAS f32x4* t4 = (const LAS f32x4*)(tbl + (ks * 128 + kk) * NBT);
#pragma unroll
        for (int q = 0; q < 6; ++q) { const f32x4 t = t4[q]; acc[4 * q + 0] += t[0] * w; acc[4 * q + 1] += t[1] * w; acc[4 * q + 2] += t[2] * w; acc[4 * q + 3] += t[3] * w; }
    }
    __syncthreads();
    LAS float* red = (LAS float*)c.lds;
#pragma unroll
    for (int b = 0; b < NBT; ++b) red[(ks * NBT + b) * 64 + j] = acc[b];
    __syncthreads();
    for (int o = c.tid; o < NBT * 64; o += NTHREADS) {
        const int b = o >> 6, jj = o & 63; float s = bias ? bias[n0 + jj] : 0.f;
#pragma unroll
        for (int q = 0; q < 8; ++q) s += red[(q * NBT + b) * 64 + jj];
        out[(size_t)b * ldo + n0 + jj] = s;
    }
}
__device__ __forceinline__ void transpose_unit(const Ctx& c, const float* W, int K, int N, int k0, int n0, bf16_t* Wt, const float* nscale) {
    LAS float* tile = (LAS float*)c.lds;
    __syncthreads();
    { const int r = c.tid >> 4, c4 = c.tid & 15;
#pragma unroll
      for (int i = 0; i < 2; ++i) { const int kk = r + 32 * i; const f32x4 v = *(const f32x4*)(W + (size_t)(k0 + kk) * N + n0 + c4 * 4);
          tile[kk * 65 + c4 * 4 + 0] = v[0]; tile[kk * 65 + c4 * 4 + 1] = v[1]; tile[kk * 65 + c4 * 4 + 2] = v[2]; tile[kk * 65 + c4 * 4 + 3] = v[3]; } }
    __syncthreads();
    { const int nn = c.tid >> 3, k8 = c.tid & 7; const float s = nscale ? nscale[n0 + nn] : 1.0f; float f[8];
#pragma unroll
      for (int j = 0; j < 8; ++j) f[j] = tile[(k8 * 8 + j) * 65 + nn] * s;
      u32x4 w; w.x = cvt_pk_bf16(f[0], f[1]); w.y = cvt_pk_bf16(f[2], f[3]); w.z = cvt_pk_bf16(f[4], f[5]); w.w = cvt_pk_bf16(f[6], f[7]);
      *(u32x4*)(Wt + (size_t)(n0 + nn) * K + k0 + k8 * 8) = w; }
}

constexpr int NU_MOD = DEPTH * (NMOD / 64);
constexpr int T_IN = 16 * 24, T_OUT = 16 * 16, T_F1 = 16 * 64, T_F2 = 64 * 16, T_LAYER = T_IN + T_OUT + T_F1 + T_F2;
constexpr int NU_TR = DEPTH * T_LAYER, NU_WP = DEPTH * 4 * 4, NU_WS = DEPTH * 4 * 4;
constexpr int NU_I0 = NU_MOD + NU_TR + NU_WP + NU_WS;
__device__ void phase_init0(const Ctx& c) {
    float* mod = (float*)(c.k->ws + WS_MOD);
    for (int u = c.bx; u < NU_I0; u += c.G) {
        if (u < NU_MOD) {
            const int l = u / (NMOD / 64), nb = u % (NMOD / 64);
            gemv24_unit(c, 0, nullptr, 0, c.k->in[I_WADA] + (size_t)l * D * NMOD, NMOD, nb * 64, c.k->in[I_BADA] + (size_t)l * NMOD, mod + (size_t)l * NBT * NMOD, NMOD);
        } else if (u < NU_MOD + NU_TR) {
            const int v = u - NU_MOD, l = v / T_LAYER; int r = v % T_LAYER;
            if (r < T_IN) transpose_unit(c, c.k->in[I_WIN] + (size_t)l * D * DIN, D, DIN, (r / 24) * 64, (r % 24) * 64, (bf16_t*)(c.k->ws + WS_WIN_T) + (size_t)l * DIN * D, nullptr);
            else if ((r -= T_IN) < T_OUT) transpose_unit(c, c.k->in[I_WOUT] + (size_t)l * D * D, D, D, (r / 16) * 64, (r % 16) * 64, (bf16_t*)(c.k->ws + WS_WOUT_T) + (size_t)l * D * D, nullptr);
            else if ((r -= T_OUT) < T_F1) transpose_unit(c, c.k->in[I_W1] + (size_t)l * D * DFF, D, DFF, (r / 64) * 64, (r % 64) * 64, (bf16_t*)(c.k->ws + WS_W1_T) + (size_t)l * DFF * D, nullptr);
            else { r -= T_F1; transpose_unit(c, c.k->in[I_W2] + (size_t)l * DFF * D, DFF, D, (r / 16) * 64, (r % 16) * 64, (bf16_t*)(c.k->ws + WS_W2_T) + (size_t)l * D * DFF, nullptr); }
        } else if (u < NU_MOD + NU_TR + NU_WP) {
            const int v = u - NU_MOD - NU_TR, lg = v >> 2, t = v & 3, l = lg >> 2, g = lg & 3;
            transpose_unit(c, c.k->in[I_WPOOL] + (size_t)lg * 128 * 128, 128, 128, (t >> 1) * 64, (t & 1) * 64, (bf16_t*)(c.k->ws + WS_WP_T) + (size_t)lg * 128 * 128, c.k->in[I_PSCALE] + l * PW + g * 128);
        } else {
            const int v = u - NU_MOD - NU_TR - NU_WP, lh = v >> 2, t = v & 3, t0 = (t >> 1) * 64, s0 = (t & 1) * 64;
            const int tt = t0 + (c.tid >> 3), s8 = s0 + (c.tid & 7) * 8;
            const float* src = c.k->in[I_WSP] + ((size_t)lh * 128 + tt) * 128 + s8;
            const f32x4 a = *(const f32x4*)src, b = *(const f32x4*)(src + 4);
            float f[8] = {a[0], a[1], a[2], a[3], b[0], b[1], b[2], b[3]};
#pragma unroll
            for (int j = 0; j < 8; ++j) if (s8 + j > tt) f[j] = 0.f;
            u32x4 w; w.x = cvt_pk_bf16(f[0], f[1]); w.y = cvt_pk_bf16(f[2], f[3]); w.z = cvt_pk_bf16(f[4], f[5]); w.w = cvt_pk_bf16(f[6], f[7]);
            *(u32x4*)((bf16_t*)(c.k->ws + WS_WSP) + ((size_t)lh * 128 + tt) * 128 + s8) = w;
        }
    }
}
constexpr int NU_SH_L = DIN / 64 + DFF / 64;
__device__ void phase_init1(const Ctx& c) {
    const float* mod = (const float*)(c.k->ws + WS_MOD);
    for (int u = c.bx; u < DEPTH * NU_SH_L; u += c.G) {
        const int l = u / NU_SH_L, r = u % NU_SH_L;
        const float* ml = mod + (size_t)l * NBT * NMOD;
        if (r < DIN / 64) gemv24_unit(c, 1, ml + 0 * D, NMOD, c.k->in[I_WIN] + (size_t)l * D * DIN, DIN, r * 64, nullptr, (float*)(c.k->ws + WS_SHWIN) + (size_t)l * NBT * DIN, DIN);
        else gemv24_unit(c, 1, ml + 3 * D, NMOD, c.k->in[I_W1] + (size_t)l * D * DFF, DFF, (r - DIN / 64) * 64, nullptr, (float*)(c.k->ws + WS_SHW1) + (size_t)l * NBT * DFF, DFF);
    }
    bf16_t* XG = (bf16_t*)(c.k->ws + WS_XG); bf16_t* XR = (bf16_t*)(c.k->ws + WS_XR); float* ssq1 = (float*)(c.k->ws + WS_SSQ1);
    const float* gm = c.k->in[I_GMIX];
    for (int rg = c.bx; rg < MT / 32; rg += c.G) {
        const int rowb = rg * 32 + c.wid * 4, b = batch_of(rowb);
        const float* sc = mod + (size_t)b * NMOD + 1 * D;
        f32x4 x[4][4], gmul[4];
#pragma unroll
        for (int r = 0; r < 4; ++r) { const int row = rowb + r;
            const float* xr = row < MP ? c.k->in[I_XP] + (size_t)row * D : c.k->in[I_XS] + (size_t)(row - MP) * D;
#pragma unroll
            for (int i = 0; i < 4; ++i) x[r][i] = *(const f32x4*)(xr + i * 256 + c.lane * 4); }
#pragma unroll
        for (int i = 0; i < 4; ++i) { const int k = i * 256 + c.lane * 4; gmul[i] = *(const f32x4*)(gm + k) * (*(const f32x4*)(sc + k) + 1.0f); }
#pragma unroll
        for (int r = 0; r < 4; ++r) {
            float ss = 0.f;
#pragma unroll
            for (int i = 0; i < 4; ++i) { const f32x4 v = x[r][i]; ss += (v[0] * v[0] + v[1] * v[1]) + (v[2] * v[2] + v[3] * v[3]);
                *(u32x2*)(XG + (size_t)(rowb + r) * D + i * 256 + c.lane * 4) = pack4(v * gmul[i]);
                *(u32x2*)(XR + (size_t)(rowb + r) * D + i * 256 + c.lane * 4) = pack4(v); }
            ss = wave_sum(ss);
            if (c.lane < 16) ssq1[(size_t)(rowb + r) * 16 + c.lane] = c.lane == 0 ? ss : 0.f;
        }
    }
}
constexpr int TP = 272;
__device__ __forceinline__ void unpack8(u32x4 v, float* f) { f[0] = bflo(v.x); f[1] = bfhi(v.x); f[2] = bflo(v.y); f[3] = bfhi(v.y); f[4] = bflo(v.z); f[5] = bfhi(v.z); f[6] = bflo(v.w); f[7] = bfhi(v.w); }
__device__ __forceinline__ u32x4 pack8(const float* f) { u32x4 w; w.x = cvt_pk_bf16(f[0], f[1]); w.y = cvt_pk_bf16(f[2], f[3]); w.z = cvt_pk_bf16(f[4], f[5]); w.w = cvt_pk_bf16(f[6], f[7]); return w; }
struct MU { int ct, j, sb, row0, nrows, bm, tseq0; bool samp; };
__device__ __forceinline__ MU mu_of(int u) {
    MU m; m.ct = u >> 3; m.j = (u + (u >> 8)) & 7;
    m.samp = m.ct >= MP / 128; m.sb = m.ct - MP / 128;
    m.row0 = m.samp ? MP + m.sb * DSEQ : m.ct * 128; m.nrows = m.samp ? DSEQ : 128; m.bm = m.samp ? NBP + m.sb : (m.ct >> 5); m.tseq0 = m.samp ? SEQ : (m.ct & 31) * 128;
    return m;
}
__device__ __forceinline__ void mix_prefetch(const Ctx& c, int l, const MU& m, u32x4 (&wv)[4], u32x4 (&dv)[5], float (&sv)[4], f32x4 (&gb)[4]) {
    unsigned char* ws = c.k->ws;
    const int c8 = c.tid & 15, r0 = c.tid >> 4;
    if (m.j < 4) {
        const int g = m.j;
        const bf16_t* WpT = (const bf16_t*)(ws + WS_WP_T) + (size_t)l * 4 * 128 * 128;
#pragma unroll
        for (int i = 0; i < 4; ++i) wv[i] = *(const u32x4*)(WpT + ((size_t)g * 128 + r0 + 32 * i) * 128 + c8 * 8);
        const bf16_t* ap = (const bf16_t*)(ws + WS_A) + (size_t)m.row0 * PW + g * 128 + c8 * 8;
#pragma unroll
        for (int i = 0; i < 5; ++i) {
            const int rr = r0 + 32 * i, t = rr - 15;
            dv[i] = (u32x4){0u, 0u, 0u, 0u};
            if (rr < 143 && t < m.nrows) {
                if (t >= 0 || (!m.samp && m.tseq0 > 0)) dv[i] = *(const u32x4*)(ap + (ptrdiff_t)t * PW);
                else if (m.samp) { const float* sp = c.k->in[I_SPOOL] + (((size_t)l * NBS + m.sb) * 15 + rr) * PW + g * 128 + c8 * 8;
                    const f32x4 p0 = *(const f32x4*)sp, p1 = *(const f32x4*)(sp + 4);
                    dv[i].x = cvt_pk_bf16(p0[0], p0[1]); dv[i].y = cvt_pk_bf16(p0[2], p0[3]); dv[i].z = cvt_pk_bf16(p1[0], p1[1]); dv[i].w = cvt_pk_bf16(p1[2], p1[3]); }
            }
        }
    } else {
        const int h = m.j - 4;
        const bf16_t* Wsp = (const bf16_t*)(ws + WS_WSP) + (size_t)l * 4 * 128 * 128;
        const bf16_t* GVb = (const bf16_t*)(ws + WS_GV); const float* stv = (const float*)(ws + WS_STV);
#pragma unroll
        for (int i = 0; i < 4; ++i) wv[i] = *(const u32x4*)(Wsp + ((size_t)h * 128 + r0 + 32 * i) * 128 + c8 * 8);
#pragma unroll
        for (int i = 0; i < 4; ++i) {
            const int sr = r0 + 32 * i; dv[i] = (u32x4){0u, 0u, 0u, 0u}; sv[i] = 0.f;
            if (sr < m.nrows) { const int row = m.row0 + sr; dv[i] = *(const u32x4*)(GVb + (size_t)row * SW + h * 128 + c8 * 8); sv[i] = stv[(size_t)row * 16 + c8]; }
        }
        const float* vg = c.k->in[I_VG] + l * SW + h * 128 + c8 * 8; const float* vb = c.k->in[I_VB] + l * SW + h * 128 + c8 * 8;
        gb[0] = *(const f32x4*)vg; gb[1] = *(const f32x4*)(vg + 4); gb[2] = *(const f32x4*)vb; gb[3] = *(const f32x4*)(vb + 4);
    }
}
__device__ void phase_mixer(const Ctx& c, int l) {
    LAS unsigned char* tA = c.lds; LAS unsigned char* tB = c.lds + 128 * TP; LAS unsigned char* tX = c.lds + 256 * TP;
    float* outp = c.k->out;
    bf16_t* CAT = (bf16_t*)(c.k->ws + WS_CAT);
    const int lane = c.lane, wid = c.wid, i15 = lane & 15, kq = lane >> 4, c8 = c.tid & 15, r0 = c.tid >> 4;
    constexpr int NU = (MP / 128 + NBS) * 8;
    u32x4 wv[4], dv[5]; float sv[4]; f32x4 gb[4];
    if (c.bx < NU) { const MU m0 = mu_of(c.bx); mix_prefetch(c, l, m0, wv, dv, sv, gb); }
    for (int u = c.bx; u < NU; u += c.G) {
        const MU m = mu_of(u);
        const int j = m.j, nrows = m.nrows, ntb = nrows >> 4, row0 = m.row0;
        bf16_t* const cbase = CAT + (size_t)row0 * D + (j < 4 ? j * 128 : 512 + (j - 4) * 128) + 16 * wid + 4 * kq;
        u32x2 uc[8]; float bc[8];
        __syncthreads();
        if (j < 4) {
            const int g = j, w = 2 << g;
#pragma unroll
            for (int i = 0; i < 4; ++i) *(LAS u32x4*)(tB + (r0 + 32 * i) * TP + c8 * 16) = wv[i];
#pragma unroll
            for (int i = 0; i < 5; ++i) { const int rr = r0 + 32 * i; if (rr < 143) *(LAS u32x4*)(tX + rr * TP + c8 * 16) = dv[i]; }
            __syncthreads();
#pragma unroll 1
            for (int i = 0; i < 4; ++i) {
                const int t = r0 + 32 * i;
                if (t < nrows) {
                    const LAS unsigned char* xp0 = tX + (t + 15) * TP + c8 * 16;
                    float a0[8], s[8], tmp[8];
                    unpack8(*(const LAS u32x4*)xp0, a0);
#pragma unroll
                    for (int k = 0; k < 8; ++k) s[k] = a0[k];
#pragma unroll 2
                    for (int jj = 1; jj < w; ++jj) { unpack8(*(const LAS u32x4*)(xp0 - jj * TP), tmp);
#pragma unroll
                        for (int k = 0; k < 8; ++k) s[k] += tmp[k]; }
                    const int pos1 = m.tseq0 + t + 1; const float inv = 1.0f / (float)(pos1 < w ? pos1 : w);
                    float dd[8];
#pragma unroll
                    for (int k = 0; k < 8; ++k) dd[k] = s[k] * inv - a0[k];
                    *(LAS u32x4*)(tA + t * TP + c8 * 16) = pack8(dd);
                    float* so = nullptr;
                    if (!m.samp && (m.ct & 31) == 31 && t >= 113) so = outp + OUT_SPP + (((size_t)l * NBP + m.bm) * 15 + (t - 113)) * PW + g * 128 + c8 * 8;
                    if (m.samp && t >= 49) so = outp + OUT_SPS + (((size_t)l * NBS + m.sb) * 15 + (t - 49)) * PW + g * 128 + c8 * 8;
                    if (so) { *(f32x4*)so = (f32x4){a0[0], a0[1], a0[2], a0[3]}; *(f32x4*)(so + 4) = (f32x4){a0[4], a0[5], a0[6], a0[7]}; }
                }
            }
        } else {
            const int h = j - 4;
#pragma unroll
            for (int i = 0; i < 4; ++i) *(LAS u32x4*)(tA + (r0 + 32 * i) * TP + c8 * 16) = wv[i];
#pragma unroll
            for (int i = 0; i < 4; ++i) {
                const int sr = r0 + 32 * i;
                float sx = sv[i]; sx += __shfl_xor(sx, 2); sx += __shfl_xor(sx, 4); sx += __shfl_xor(sx, 8);
                const float so_ = __shfl_xor(sx, 1);
                const float sum = (c8 & 1) ? so_ : sx, sq = (c8 & 1) ? sx : so_;
                u32x4 outv = (u32x4){0u, 0u, 0u, 0u};
                if (sr < nrows) {
                    float gvf[8]; unpack8(dv[i], gvf);
                    const float mean = sum * (1.0f / SW); float var = sq * (1.0f / SW) - mean * mean; var = var < 0.f ? 0.f : var;
                    const float rstd = rsqrtf(var + EPS);
                    float vl[8];
#pragma unroll
                    for (int k = 0; k < 4; ++k) { vl[k] = (gvf[k] - mean) * rstd * gb[0][k] + gb[2][k]; vl[4 + k] = (gvf[4 + k] - mean) * rstd * gb[1][k] + gb[3][k]; }
                    if (m.samp) { float* so = outp + OUT_SV + (((size_t)l * NBS + m.sb) * DSEQ + sr) * SW + h * 128 + c8 * 8;
                        *(f32x4*)so = (f32x4){vl[0], vl[1], vl[2], vl[3]}; *(f32x4*)(so + 4) = (f32x4){vl[4], vl[5], vl[6], vl[7]}; }
                    outv = pack8(vl);
                }
                *(LAS u32x4*)(tB + sr * TP + c8 * 16) = outv;
            }
        }
        __syncthreads();
        if (j >= 4) {
            const bf16_t* Ub = (const bf16_t*)(c.k->ws + WS_U);
#pragma unroll
            for (int tb = 0; tb < 8; ++tb) { uc[tb] = (u32x2){0u, 0u}; bc[tb] = 0.f;
                if (tb < ntb) { uc[tb] = *(const u32x2*)(Ub + (size_t)(row0 + 16 * tb + i15) * SW + (j - 4) * 128 + 16 * wid + 4 * kq);
                                bc[tb] = c.k->in[I_BSP][((size_t)l * 4 + (j - 4)) * 128 + 16 * tb + i15]; } }
        }
        if (u + c.G < NU) { const MU mn = mu_of(u + c.G); mix_prefetch(c, l, mn, wv, dv, sv, gb); }
        f32x4 acc[8];
#pragma unroll
        for (int tb = 0; tb < 8; ++tb) acc[tb] = (f32x4){0.f, 0.f, 0.f, 0.f};
        if (j < 4) {
#pragma unroll
            for (int kk = 0; kk < 4; ++kk) {
                const bf16x8 bf = *(const LAS bf16x8*)(tB + (16 * wid + i15) * TP + kk * 64 + kq * 16);
#pragma unroll
                for (int hb = 0; hb < 2; ++hb) if (4 * hb < ntb) {
                    bf16x8 af[4];
#pragma unroll
                    for (int t4 = 0; t4 < 4; ++t4) af[t4] = *(const LAS bf16x8*)(tA + (16 * (4 * hb + t4) + i15) * TP + kk * 64 + kq * 16);
                    __builtin_amdgcn_sched_barrier(0);
#pragma unroll
                    for (int t4 = 0; t4 < 4; ++t4) acc[4 * hb + t4] = __builtin_amdgcn_mfma_f32_16x16x32_bf16(bf, af[t4], acc[4 * hb + t4], 0, 0, 0);
                    __builtin_amdgcn_sched_barrier(0);
                }
            }
#pragma unroll
            for (int tb = 0; tb < 8; ++tb) if (tb < ntb) *(u32x2*)(cbase + (size_t)(16 * tb + i15) * D) = pack4(acc[tb]);
        } else {
            const int q = i15 >> 2, p = lane & 3;
#pragma unroll
            for (int kk = 0; kk < 4; ++kk) {
                LAS unsigned char* vp = tB + (32 * kk + 8 * kq + q) * TP + (16 * wid + 4 * p) * 2;
                const s16x4 lo = __builtin_amdgcn_ds_read_tr16_b64_v4i16((LAS s16x4*)vp);
                const s16x4 hi = __builtin_amdgcn_ds_read_tr16_b64_v4i16((LAS s16x4*)(vp + 4 * TP));
                const bf16x8 vf = __builtin_shufflevector(lo, hi, 0, 1, 2, 3, 4, 5, 6, 7);
#pragma unroll
                for (int hb = 0; hb < 2; ++hb) if (4 * hb + 3 >= 2 * kk && 4 * hb < ntb) {
                    bf16x8 af[4];
#pragma unroll
                    for (int t4 = 0; t4 < 4; ++t4) af[t4] = *(const LAS bf16x8*)(tA + (16 * (4 * hb + t4) + i15) * TP + kk * 64 + kq * 16);
                    __builtin_amdgcn_sched_barrier(0);
#pragma unroll
                    for (int t4 = 0; t4 < 4; ++t4) if (4 * hb + t4 >= 2 * kk) acc[4 * hb + t4] = __builtin_amdgcn_mfma_f32_16x16x32_bf16(vf, af[t4], acc[4 * hb + t4], 0, 0, 0);
                    __builtin_amdgcn_sched_barrier(0);
                }
            }
#pragma unroll
            for (int tb = 0; tb < 8; ++tb) if (tb < ntb) {
                f32x4 o = acc[tb]; const u32x2 w2 = uc[tb]; const float bs = bc[tb];
                o = (f32x4){bflo(w2.x) * (o[0] + bs), bfhi(w2.x) * (o[1] + bs), bflo(w2.y) * (o[2] + bs), bfhi(w2.y) * (o[3] + bs)};
                *(u32x2*)(cbase + (size_t)(16 * tb + i15) * D) = pack4(o);
            }
        }
    }
}
template <class Epi>
__device__ __forceinline__ void sample_gemm(const Ctx& c, const bf16_t* A, int lda, const bf16_t* Bt, int ldb, int N, int K, const Epi& E) {
    LAS unsigned char* tA = c.lds; LAS unsigned char* tB = c.lds + 128 * TP; LAS float* red = (LAS float*)(c.lds + 256 * TP);
    const int lane = c.lane, wid = c.wid, i15 = lane & 15, kq = lane >> 4, c8 = c.tid & 15, r0 = c.tid >> 4;
    const int ntn = N >> 7, ntiles = NBS * ntn, nks = K >> 7;
    for (int tile = c.bx; tile < ntiles; tile += c.G) {
        const int sb = tile / ntn, n0 = (tile - sb * ntn) * 128;
        const bf16_t* ap = A + (size_t)(MP + sb * DSEQ + r0) * lda + c8 * 8;
        const bf16_t* bp = Bt + (size_t)(n0 + r0) * ldb + c8 * 8;
        u32x4 ra[2], rb[4];
#pragma unroll
        for (int i = 0; i < 2; ++i) ra[i] = *(const u32x4*)(ap + (size_t)(32 * i) * lda);
#pragma unroll
        for (int i = 0; i < 4; ++i) rb[i] = *(const u32x4*)(bp + (size_t)(32 * i) * ldb);
        f32x4 acc[4];
#pragma unroll
        for (int tb = 0; tb < 4; ++tb) acc[tb] = (f32x4){0.f, 0.f, 0.f, 0.f};
#pragma unroll 1
        for (int ks = 0; ks < nks; ++ks) {
            __syncthreads();
#pragma unroll
            for (int i = 0; i < 2; ++i) *(LAS u32x4*)(tA + (r0 + 32 * i) * TP + c8 * 16) = ra[i];
#pragma unroll
            for (int i = 0; i < 4; ++i) *(LAS u32x4*)(tB + (r0 + 32 * i) * TP + c8 * 16) = rb[i];
            __syncthreads();
            if (ks + 1 < nks) {
#pragma unroll
                for (int i = 0; i < 2; ++i) ra[i] = *(const u32x4*)(ap + (size_t)(32 * i) * lda + (ks + 1) * 128);
#pragma unroll
                for (int i = 0; i < 4; ++i) rb[i] = *(const u32x4*)(bp + (size_t)(32 * i) * ldb + (ks + 1) * 128);
            }
#pragma unroll
            for (int k2 = 0; k2 < 2; ++k2) {
                bf16x8 bf[2], af[2][4];
#pragma unroll
                for (int q = 0; q < 2; ++q) { const int kk = 2 * k2 + q;
                    bf[q] = *(const LAS bf16x8*)(tB + (16 * wid + i15) * TP + kk * 64 + kq * 16);
#pragma unroll
                    for (int tb = 0; tb < 4; ++tb) af[q][tb] = *(const LAS bf16x8*)(tA + (16 * tb + i15) * TP + kk * 64 + kq * 16); }
                __builtin_amdgcn_sched_barrier(0);
#pragma unroll
                for (int q = 0; q < 2; ++q)
#pragma unroll
                    for (int tb = 0; tb < 4; ++tb) acc[tb] = __builtin_amdgcn_mfma_f32_16x16x32_bf16(bf[q], af[q][tb], acc[tb], 0, 0, 0);
                __builtin_amdgcn_sched_barrier(0);
            }
        }
        E(c, acc, sb, n0, red);
    }
    __syncthreads();
}
struct EpiInS {
    const float* ssq1; const float* shw; bf16_t* A; bf16_t* U; bf16_t* GV; float* stv;
    __device__ __forceinline__ void operator()(const Ctx& c, const f32x4 (&acc)[4], int sb, int n0, LAS float* red) const {
        const int i15 = c.lane & 15, kq = c.lane >> 4;
        const unsigned rowb = (unsigned)(MP + sb * DSEQ + i15), col = (unsigned)(n0 + 16 * c.wid + 4 * kq);
        f32x4 pp[4];
#pragma unroll
        for (int tb = 0; tb < 4; ++tb) pp[tb] = ldg4(ssq1, ((rowb + 16 * tb) * 16 + kq * 4) * 4);
        const f32x4 bv = ldg4(shw + (size_t)(NBP + sb) * DIN, col * 4);
        bf16_t* const dbase = n0 < 512 ? A : (n0 < 1024 ? U - 512 : GV - 1024);
        float s1[4], s2[4];
#pragma unroll
        for (int tb = 0; tb < 4; ++tb) {
            const f32x4 p = pp[tb]; const float rstd = rsqrtf(quad_row_sum((p[0] + p[1]) + (p[2] + p[3])) * (1.0f / D) + EPS);
            f32x4 z = acc[tb] * rstd + bv;
            if (n0 >= 512) z = gelu4(z);
            s1[tb] = (z[0] + z[1]) + (z[2] + z[3]); s2[tb] = (z[0] * z[0] + z[1] * z[1]) + (z[2] * z[2] + z[3] * z[3]);
            stg2(dbase, ((rowb + 16 * tb) * 512 + col) * 2, pack4(z));
        }
        if (n0 >= 1024) {
#pragma unroll
            for (int tb = 0; tb < 4; ++tb) { const float a = quad_row_sum(s1[tb]), b = quad_row_sum(s2[tb]);
                if (kq == 0) { red[(c.wid * 64 + 16 * tb + i15) * 2] = a; red[(c.wid * 64 + 16 * tb + i15) * 2 + 1] = b; } }
            __syncthreads();
            if (c.tid < 64) {
                float a = 0.f, b = 0.f;
#pragma unroll
                for (int w = 0; w < 8; ++w) { a += red[(w * 64 + c.tid) * 2]; b += red[(w * 64 + c.tid) * 2 + 1]; }
                float* dst = stv + (size_t)(MP + sb * DSEQ + c.tid) * 16;
                *(f32x2*)(dst + ((n0 - 1024) >> 7) * 2) = (f32x2){a, b};
                if (n0 == 1024) { *(f32x4*)(dst + 8) = (f32x4){0.f, 0.f, 0.f, 0.f}; *(f32x4*)(dst + 12) = (f32x4){0.f, 0.f, 0.f, 0.f}; }
            }
        }
    }
};
struct EpiResS {
    bf16_t* XR; const float* gate; const float* gnext; const float* scnext; bf16_t* XG; float* ssq;
    __device__ __forceinline__ void operator()(const Ctx& c, const f32x4 (&acc)[4], int sb, int n0, LAS float* red) const {
        const int i15 = c.lane & 15, kq = c.lane >> 4, b = NBP + sb;
        const unsigned rowb = (unsigned)(MP + sb * DSEQ + i15), col = (unsigned)(n0 + 16 * c.wid + 4 * kq);
        u32x2 xv[4];
#pragma unroll
        for (int tb = 0; tb < 4; ++tb) xv[tb] = ldg2(XR, ((rowb + 16 * tb) * D + col) * 2);
        const f32x4 gt = ldg4(gate + (size_t)b * NMOD, col * 4);
        f32x4 gm = (f32x4){0.f, 0.f, 0.f, 0.f};
        if (gnext) gm = ldg4(gnext, col * 4) * (ldg4(scnext + (size_t)b * NMOD, col * 4) + 1.0f);
        float ss[4];
#pragma unroll
        for (int tb = 0; tb < 4; ++tb) {
            const unsigned eo = (rowb + 16 * tb) * D + col;
            const f32x4 x1 = unpack4(xv[tb]) + gt * acc[tb];
            stg2(XR, eo * 2, pack4(x1));
            ss[tb] = (x1[0] * x1[0] + x1[1] * x1[1]) + (x1[2] * x1[2] + x1[3] * x1[3]);
            if (gnext) stg2(XG, eo * 2, pack4(x1 * gm));
        }
#pragma unroll
        for (int tb = 0; tb < 4; ++tb) { const float a = quad_row_sum(ss[tb]); if (kq == 0) red[c.wid * 64 + 16 * tb + i15] = a; }
        __syncthreads();
        if (c.tid < 64) {
            float a = 0.f;
#pragma unroll
            for (int w = 0; w < 8; ++w) a += red[w * 64 + c.tid];
            float* dst = ssq + (size_t)(MP + sb * DSEQ + c.tid) * 16;
            dst[n0 >> 7] = a;
            if (n0 == 0) { *(f32x4*)(dst + 8) = (f32x4){0.f, 0.f, 0.f, 0.f}; *(f32x4*)(dst + 12) = (f32x4){0.f, 0.f, 0.f, 0.f}; }
        }
    }
};
struct EpiFf1S {
    const float* ssq2; const float* shw; bf16_t* F1;
    __device__ __forceinline__ void operator()(const Ctx& c, const f32x4 (&acc)[4], int sb, int n0, LAS float* red) const {
        const int i15 = c.lane & 15, kq = c.lane >> 4;
        const unsigned rowb = (unsigned)(MP + sb * DSEQ + i15), col = (unsigned)(n0 + 16 * c.wid + 4 * kq);
        f32x4 pp[4];
#pragma unroll
        for (int tb = 0; tb < 4; ++tb) pp[tb] = ldg4(ssq2, ((rowb + 16 * tb) * 16 + kq * 4) * 4);
        const f32x4 bv = ldg4(shw + (size_t)(NBP + sb) * DFF, col * 4);
#pragma unroll
        for (int tb = 0; tb < 4; ++tb) {
            const f32x4 p = pp[tb]; const float rstd = rsqrtf(quad_row_sum((p[0] + p[1]) + (p[2] + p[3])) * (1.0f / D) + EPS);
            f32x4 z = acc[tb] * rstd + bv;
            z = __builtin_elementwise_max(z, (f32x4){0.f, 0.f, 0.f, 0.f}); z = z * z;
            stg2(F1, ((rowb + 16 * tb) * DFF + col) * 2, pack4(z));
        }
    }
};
__device__ void phase_final(const Ctx& c) {
    const float* ssq1 = (const float*)(c.k->ws + WS_SSQ1); const float* gf = c.k->in[I_GFIN];
    const bf16_t* XR = (const bf16_t*)(c.k->ws + WS_XR);
    f32x4 g[4];
#pragma unroll
    for (int i = 0; i < 4; ++i) g[i] = *(const f32x4*)(gf + i * 256 + c.lane * 4);
    for (int rg = c.bx; rg < MT / 64; rg += c.G) {
        const int rowb = rg * 64 + c.wid * 8;
        const bf16_t* xr = XR + (size_t)rowb * D;
        float* yr = c.k->out + OUT_Y + (size_t)rowb * D;
        u32x2 x[8][4];
        float p0 = ssq1[(size_t)rowb * 16 + c.lane], p1 = ssq1[(size_t)rowb * 16 + 64 + c.lane];
#pragma unroll
        for (int r = 0; r < 8; ++r)
#pragma unroll
            for (int i = 0; i < 4; ++i) x[r][i] = *(const u32x2*)(xr + r * D + i * 256 + c.lane * 4);
        p0 += __shfl_xor(p0, 1); p0 += __shfl_xor(p0, 2); p0 += __shfl_xor(p0, 4); p0 += __shfl_xor(p0, 8);
        p1 += __shfl_xor(p1, 1); p1 += __shfl_xor(p1, 2); p1 += __shfl_xor(p1, 4); p1 += __shfl_xor(p1, 8);
#pragma unroll
        for (int r = 0; r < 8; ++r) {
            const float rstd = rsqrtf(__shfl(r < 4 ? p0 : p1, 16 * (r & 3)) * (1.0f / D) + EPS);
#pragma unroll
            for (int i = 0; i < 4; ++i) *(f32x4*)(yr + r * D + i * 256 + c.lane * 4) = unpack4(x[r][i]) * rstd * g[i];
        }
    }
}

#define XB_TMO      128
#define XB_XCNT(j)  (256  + 64 * (j))
#define XB_XSUB(j)  (1280 + 64 * (j))
#define XB_XGEN(j)  (2304 + 64 * (j))
#define XB_TOP      3328
#define XB_TOPGEN   3392
#define XCD_BAR_WORDS 3456
#define XB_SPIN_CAP (1u << 18)

__device__ __forceinline__ unsigned xb_ld(unsigned* p)              { return __hip_atomic_load(p, __ATOMIC_RELAXED, __HIP_MEMORY_SCOPE_AGENT); }
__device__ __forceinline__ unsigned xb_add(unsigned* p, unsigned v) { return __hip_atomic_fetch_add(p, v, __ATOMIC_RELAXED, __HIP_MEMORY_SCOPE_AGENT); }
__device__ __forceinline__ unsigned xb_xcc_id() { return (unsigned)__builtin_amdgcn_s_getreg((3 << 11) | 20) & 0xFu; }
#define XB_SPIN(cond, bar) do { unsigned _sp = 0; while (cond) { __builtin_amdgcn_s_sleep(1); \
    if ((++_sp & 255u) == 0u) { if (xb_ld(&(bar)[XB_TMO])) break; if (_sp > XB_SPIN_CAP) { atomicAdd(&(bar)[XB_TMO], 1u); break; } } } } while (0)

struct XcdBarrier {
    unsigned* bar; unsigned x;
    volatile LAS unsigned* st;
};

__device__ __forceinline__ XcdBarrier xcd_barrier_post(unsigned* bar, volatile LAS unsigned* st) {
    XcdBarrier b; b.bar = bar; b.x = xb_xcc_id(); b.st = st;
    if (threadIdx.x == 0) (void)xb_add(&bar[XB_XCNT(b.x)], 1u);
    return b;
}
__device__ __forceinline__ void xcd_barrier_complete(unsigned* bar, unsigned x, unsigned& nloc, unsigned& nx) {
    const unsigned G = gridDim.x * gridDim.y * gridDim.z;
    unsigned sum, cnt, mine, sp = 0u;
    for (;;) {
        sum = 0u; cnt = 0u; mine = 0u;
#pragma unroll
        for (unsigned j = 0; j < 16; ++j) { const unsigned c = xb_ld(&bar[XB_XCNT(j)]); sum += c; cnt += (c > 0u) ? 1u : 0u; mine = (j == x) ? c : mine; }
        if (sum == G) break;
        __builtin_amdgcn_s_sleep(1);
        if ((++sp & 255u) == 0u) { if (xb_ld(&bar[XB_TMO])) break; if (sp > XB_SPIN_CAP) { atomicAdd(&bar[XB_TMO], 1u); break; } }
    }
    nloc = mine > 0u ? mine : 1u; nx = cnt > 0u ? cnt : 1u;
}

__device__ __forceinline__ void xcd_barrier(const XcdBarrier& b) {
    asm volatile("s_waitcnt vmcnt(0)" ::: "memory");
    __syncthreads();
    if (threadIdx.x == 0) {
        unsigned* bar = b.bar;
        __builtin_amdgcn_s_waitcnt(0);
        unsigned nloc = b.st[0], nx = b.st[1];
        if (nloc == 0u) { xcd_barrier_complete(bar, b.x, nloc, nx); b.st[0] = nloc; b.st[1] = nx; }
        const unsigned old = xb_add(&bar[XB_XSUB(b.x)], 1u);
        const unsigned gen = old / nloc;
        if (old + 1u == (gen + 1u) * nloc) {
            __builtin_amdgcn_fence(__ATOMIC_RELEASE, "agent");
            asm volatile("s_waitcnt vmcnt(0)" ::: "memory");
            const unsigned og = xb_add(&bar[XB_TOP], 1u);
            const unsigned tg = og / nx;
            if (og + 1u == (tg + 1u) * nx) xb_add(&bar[XB_TOPGEN], 1u);
            else XB_SPIN(xb_ld(&bar[XB_TOPGEN]) == tg, bar);
            __builtin_amdgcn_fence(__ATOMIC_ACQUIRE, "agent");
            xb_add(&bar[XB_XGEN(b.x)], 1u);
            asm volatile("s_waitcnt vmcnt(0)" ::: "memory");
        } else {
            XB_SPIN(xb_ld(&bar[XB_XGEN(b.x)]) == gen, bar);
            __builtin_amdgcn_fence(__ATOMIC_ACQUIRE, "agent");
            asm volatile("s_waitcnt vmcnt(0)" ::: "memory");
        }
    }
    __syncthreads();
}


constexpr int NPHASE = 2 + 5 * DEPTH + 1;
__global__ void __launch_bounds__(NTHREADS, 2) mk_fwd(Params p) {
    __shared__ __attribute__((aligned(16))) unsigned char shm[pg8::STAGE_BYTES + 16];
    cg::grid_group grid = cg::this_grid();
    if (threadIdx.x < 4) ((LAS unsigned*)((LAS unsigned char*)shm + pg8::STAGE_BYTES))[threadIdx.x] = 0u;
    __syncthreads();
    (void)xcd_barrier_post((unsigned*)(p.ws + WS_BAR), (volatile LAS unsigned*)((LAS unsigned char*)shm + pg8::STAGE_BYTES));
    Ctx c;
    c.k = kargs(); c.lds = (LAS unsigned char*)shm;
    c.tid = threadIdx.x; c.lane = c.tid & 63; c.wid = __builtin_amdgcn_readfirstlane(c.tid >> 6); c.G = gridDim.x; c.bx = blockIdx.x;
#ifndef PHMASK
#define PHMASK 0xffff
#endif
#define PHON(k) ((PHMASK >> (k)) & 1)
#ifndef DUPMASK
#define DUPMASK 0
#endif
#define DUPN(k) (((DUPMASK >> (k)) & 1) ? 2 : 1)
    for (int ph = p.ph_lo; ph < p.ph_hi; ++ph) {
        { int t_ = threadIdx.x; asm volatile("" : "+v"(t_)); c.tid = t_; c.lane = t_ & 63; c.wid = __builtin_amdgcn_readfirstlane(t_ >> 6); c.k = kargs(); }
        unsigned char* ws = c.k->ws;
        const float* mod = (const float*)(ws + WS_MOD);
        if (ph == 0) { for (int r_ = 0; r_ < DUPN(0); ++r_) phase_init0(c); }
        else if (ph == 1) { for (int r_ = 0; r_ < DUPN(1); ++r_) phase_init1(c); }
        else if (ph == NPHASE - 1) { if (PHON(7)) phase_final(c); }
        else {
            const int l = (ph - 2) / 5, s = (ph - 2) % 5;
            const float* modl = mod + (size_t)l * NBT * NMOD;
            pg8::StaticOrder S;
            if (s == 0 && PHON(2)) {
                pg8::Gemm g{(const bf16_t*)(ws + WS_XG), (const bf16_t*)(ws + WS_WIN_T) + (size_t)l * DIN * D, MP, DIN, D}; S.init(MP, DIN, c.G, c.bx);
                { EpiInS Es{(const float*)(ws + WS_SSQ1), (const float*)(ws + WS_SHWIN) + (size_t)l * NBT * DIN, (bf16_t*)(ws + WS_A), (bf16_t*)(ws + WS_U), (bf16_t*)(ws + WS_GV), (float*)(ws + WS_STV)};
                  sample_gemm<EpiInS>(c, g.A, D, g.Bt, D, DIN, D, Es); }
                EpiIn E{(const float*)(ws + WS_SSQ1), (const float*)(ws + WS_SHWIN) + (size_t)l * NBT * DIN, (bf16_t*)(ws + WS_A), (bf16_t*)(ws + WS_U), (bf16_t*)(ws + WS_GV), (float*)(ws + WS_STV)};
                for (int r_ = 0; r_ < DUPN(2); ++r_) pg8::gemm_phase<EpiIn>(c.lds, g, S, E);
            } else if (s == 1 && PHON(3)) {
                for (int r_ = 0; r_ < DUPN(3); ++r_) phase_mixer(c, l);
            } else if (s == 2 && PHON(4)) {
                pg8::Gemm g{(const bf16_t*)(ws + WS_CAT), (const bf16_t*)(ws + WS_WOUT_T) + (size_t)l * D * D, MP, D, D}; S.init(MP, D, c.G, c.bx);
                { EpiResS Es{(bf16_t*)(ws + WS_XR), modl + 2 * D, c.k->in[I_GFFN] + l * D, modl + 4 * D, (bf16_t*)(ws + WS_XG), (float*)(ws + WS_SSQ2)};
                  sample_gemm<EpiResS>(c, g.A, D, g.Bt, D, D, D, Es); }
                EpiRes E{(bf16_t*)(ws + WS_XR), modl + 2 * D, c.k->in[I_GFFN] + l * D, modl + 4 * D, (bf16_t*)(ws + WS_XG), (float*)(ws + WS_SSQ2)};
                pg8::gemm_phase<EpiRes>(c.lds, g, S, E);
            } else if (s == 3 && PHON(5)) {
                pg8::Gemm g{(const bf16_t*)(ws + WS_XG), (const bf16_t*)(ws + WS_W1_T) + (size_t)l * DFF * D, MP, DFF, D}; S.init(MP, DFF, c.G, c.bx);
                { EpiFf1S Es{(const float*)(ws + WS_SSQ2), (const float*)(ws + WS_SHW1) + (size_t)l * NBT * DFF, (bf16_t*)(ws + WS_F1)};
                  sample_gemm<EpiFf1S>(c, g.A, D, g.Bt, D, DFF, D, Es); }
                EpiFf1 E{(const float*)(ws + WS_SSQ2), (const float*)(ws + WS_SHW1) + (size_t)l * NBT * DFF, (bf16_t*)(ws + WS_F1)};
                for (int r_ = 0; r_ < DUPN(5); ++r_) pg8::gemm_phase<EpiFf1>(c.lds, g, S, E);
            } else if (s == 4 && PHON(6)) {
                pg8::Gemm g{(const bf16_t*)(ws + WS_F1), (const bf16_t*)(ws + WS_W2_T) + (size_t)l * D * DFF, MP, D, DFF}; S.init(MP, D, c.G, c.bx);
                const bool more = (l + 1 < DEPTH);
                { EpiResS Es{(bf16_t*)(ws + WS_XR), modl + 5 * D, more ? c.k->in[I_GMIX] + (l + 1) * D : nullptr, mod + (size_t)(more ? l + 1 : l) * NBT * NMOD + 1 * D,
                             (bf16_t*)(ws + WS_XG), (float*)(ws + WS_SSQ1)};
                  sample_gemm<EpiResS>(c, g.A, DFF, g.Bt, DFF, D, DFF, Es); }
                EpiRes E{(bf16_t*)(ws + WS_XR), modl + 5 * D, more ? c.k->in[I_GMIX] + (l + 1) * D : nullptr, mod + (size_t)(more ? l + 1 : l) * NBT * NMOD + 1 * D,
                         (bf16_t*)(ws + WS_XG), (float*)(ws + WS_SSQ1)};
                pg8::gemm_phase<EpiRes>(c.lds, g, S, E);
            }
        }
        if (ph + 1 < p.ph_hi) { if (p.ph_hi > NPHASE) grid.sync(); else { XcdBarrier xb; xb.bar = (unsigned*)(c.k->ws + WS_BAR); xb.x = xb_xcc_id(); xb.st = (volatile LAS unsigned*)(c.lds + pg8::STAGE_BYTES); xcd_barrier(xb); } }
    }
}

extern "C" void kernel_launch(void* const* d_in, const int* in_sizes, int n_in, void* d_out, int out_size, void* d_ws, size_t ws_size, hipStream_t stream) {
    static int grid_blocks = 0;
    if (!grid_blocks) {
        int dev = 0, cus = 0, per_cu = 0;
        hipGetDevice(&dev);
        hipDeviceGetAttribute(&cus, hipDeviceAttributeMultiprocessorCount, dev);
        hipOccupancyMaxActiveBlocksPerMultiprocessor(&per_cu, mk_fwd, NTHREADS, 0);
        if (per_cu < 1) per_cu = 1;
        if (per_cu > 1) per_cu = 1;
        grid_blocks = cus * per_cu;
        if (n_in != 20 || ws_size < WS_END) fprintf(stderr, "kernel_launch: unexpected n_in %d / ws_size %zu (need %zu)\n", n_in, ws_size, (size_t)WS_END);
    }
    Params p{};
    for (int i = 0; i < 20; ++i) p.in[i] = (const float*)d_in[i];
    p.out = (float*)d_out; p.ws = (unsigned char*)d_ws;
#if MK_SINGLE
    (void)hipMemsetAsync((unsigned char*)d_ws + WS_BAR, 0, WS_BAR_BYTES, stream);
    p.ph_lo = 0; p.ph_hi = NPHASE;
    { void* args[] = {&p};
      hipError_t e = hipLaunchCooperativeKernel((void*)mk_fwd, dim3(grid_blocks), dim3(NTHREADS), args, 0, stream);
      if (e != hipSuccess) fprintf(stderr, "cooperative launch failed: %s (grid %d)\n", hipGetErrorString(e), grid_blocks); }
#else
    for (int ph = 0; ph < NPHASE; ++ph) {
        p.ph_lo = ph; p.ph_hi = ph + 1;
        void* args[] = {&p};
        hipError_t e = hipLaunchCooperativeKernel((void*)mk_fwd, dim3(grid_blocks), dim3(NTHREADS), args, 0, stream);
        if (e != hipSuccess) { fprintf(stderr, "cooperative launch failed: %s (grid %d, phase %d)\n", hipGetErrorString(e), grid_blocks, ph); break; }
    }
#endif
}
```
